# Optimizing an MI355X kernel written in HIP

```python
import jax, jax.numpy as jnp
from jax import lax
import numpy as np

D_MODEL = 1024
BATCH = 16
SEQ = 2048
DEPTH = 4

GRID_W = 64
CTX_LEN = 256
CONV_WIDTH = 512
CONV_K = 3
N_HEADS = 8
N_KV_HEADS = 2
GROUP = N_HEADS // N_KV_HEADS
HEAD_DIM = 64
ATTN_WIDTH = N_HEADS * HEAD_DIM
KV_WIDTH = N_KV_HEADS * HEAD_DIM
WINDOW = 128
BLOCK = 128
ROPE_THETA = 10000.0
ROPE_FREQS = HEAD_DIM // 4
EPS = 1e-6
NEG = -1e30
IN_COLS = 4 * CONV_WIDTH + 2 * ATTN_WIDTH + 2 * KV_WIDTH + 2 * D_MODEL

kernel_name = "hybrid_conv_swa_dit_block"


def rms_norm(x, w):
    xf = x.astype(jnp.float32)
    y = xf * lax.rsqrt(jnp.mean(xf * xf, axis=-1, keepdims=True) + EPS)
    return (y * w.astype(jnp.float32)).astype(x.dtype)


def project(h, w_in):
    sizes = (CONV_WIDTH, CONV_WIDTH, CONV_WIDTH, CONV_WIDTH,
             ATTN_WIDTH, KV_WIDTH, KV_WIDTH, ATTN_WIDTH, D_MODEL, D_MODEL)
    points = tuple(int(p) for p in np.cumsum(sizes)[:-1])
    p = jnp.einsum('bsd,de->bse', h, w_in)
    return jnp.split(p, points, axis=-1)


def short_conv(u, w):
    L = u.shape[1]
    pad = CONV_K // 2
    up = jnp.pad(u, ((0, 0), (pad, pad), (0, 0)))
    return sum(up[:, k:k + L] * w[k] for k in range(CONV_K))


def rope_2d(x, cos, sin):
    B_, S_, H_, _ = x.shape
    xr = x.reshape(B_, S_, H_, 2, 2, ROPE_FREQS)
    x1, x2 = xr[..., 0, :], xr[..., 1, :]
    cs = cos[None, :, None]
    sn = sin[None, :, None]
    out = jnp.stack([x1 * cs - x2 * sn, x2 * cs + x1 * sn], axis=-2)
    return out.reshape(B_, S_, H_, HEAD_DIM).astype(x.dtype)


def sink_softmax(scores, sink):
    sk = jnp.broadcast_to(sink.astype(jnp.float32).reshape(N_KV_HEADS, GROUP, 1, 1),
                          scores.shape[:-1] + (1,))
    p = jax.nn.softmax(jnp.concatenate([sk, scores], axis=-1), axis=-1)
    return p[..., 1:]


def latent_attention(q, k, v, k_ctx, v_ctx, sink):
    B_, S_ = q.shape[:2]
    nb = S_ // BLOCK
    scale = HEAD_DIM ** -0.5
    k_pad = jnp.pad(k, ((0, 0), (BLOCK, BLOCK), (0, 0), (0, 0)))
    v_pad = jnp.pad(v, ((0, 0), (BLOCK, BLOCK), (0, 0), (0, 0)))
    qb = jnp.moveaxis(q.reshape(B_, nb, BLOCK, N_KV_HEADS, GROUP, HEAD_DIM), 1, 0)

    def one_block(args):
        i, q_i = args
        start = i * BLOCK
        k_i = lax.dynamic_slice_in_dim(k_pad, start, 3 * BLOCK, axis=1)
        v_i = lax.dynamic_slice_in_dim(v_pad, start, 3 * BLOCK, axis=1)
        s_loc = jnp.einsum('bqkgd,bskd->bkgqs', q_i, k_i).astype(jnp.float32) * scale
        s_ctx = jnp.einsum('bqkgd,bckd->bkgqc', q_i, k_ctx).astype(jnp.float32) * scale
        q_pos = start + jnp.arange(BLOCK)
        k_pos = start - BLOCK + jnp.arange(3 * BLOCK)
        allowed = ((jnp.abs(q_pos[:, None] - k_pos[None, :]) <= WINDOW)
                   & (k_pos[None, :] >= 0) & (k_pos[None, :] < S_))
        s_loc = jnp.where(allowed, s_loc, NEG)
        p = sink_softmax(jnp.concatenate([s_loc, s_ctx], axis=-1), sink).astype(v.dtype)
        o = (jnp.einsum('bkgqs,bskd->bqkgd', p[..., :3 * BLOCK], v_i)
             + jnp.einsum('bkgqc,bckd->bqkgd', p[..., 3 * BLOCK:], v_ctx))
        return o

    out = lax.map(one_block, (jnp.arange(nb), qb))
    return jnp.moveaxis(out, 0, 1).reshape(B_, S_, ATTN_WIDTH)


def context_attention(q_c, k_c, v_c, sink):
    B_, L_ = q_c.shape[:2]
    qg = q_c.reshape(B_, L_, N_KV_HEADS, GROUP, HEAD_DIM)
    s = jnp.einsum('bqkgd,bckd->bkgqc', qg, k_c).astype(jnp.float32) * HEAD_DIM ** -0.5
    p = sink_softmax(s, sink).astype(v_c.dtype)
    return jnp.einsum('bkgqc,bckd->bqkgd', p, v_c).reshape(B_, L_, ATTN_WIDTH)


def mixer_output(parts, attn, conv_w, w_a_out, w_b_out, w_o):
    b_g, c_g, u, z_a, _, _, _, z_b, g_a, g_b = parts
    y_a = (b_g * short_conv(c_g * u, conv_w)) * jax.nn.silu(z_a)
    y_a = jnp.einsum('bsc,cd->bsd', y_a, w_a_out)
    y_b = jnp.einsum('bsc,cd->bsd', attn * jax.nn.silu(z_b), w_b_out)
    m = jax.nn.sigmoid(g_a) * y_a + jax.nn.sigmoid(g_b) * y_b
    return jnp.einsum('bsd,de->bse', m, w_o)


def setup_inputs(seed: int = 0) -> dict:
    key = jax.random.key(seed)
    ks = jax.random.split(key, 14)
    nrm = jax.random.normal
    f32 = jnp.float32
    return {
        "x": nrm(ks[0], (BATCH, SEQ, D_MODEL), f32),
        "c": nrm(ks[1], (BATCH, D_MODEL), f32),
        "ctx": nrm(ks[2], (BATCH, CTX_LEN, D_MODEL), f32),
        "c_ctx": nrm(ks[3], (D_MODEL,), f32),
        "norm_w": 1.0 + 0.02 * nrm(ks[4], (DEPTH, D_MODEL), f32),
        "w_mod": nrm(ks[5], (DEPTH, D_MODEL, 3 * D_MODEL), f32) * (0.5 * D_MODEL ** -0.5),
        "b_mod": 0.01 * nrm(ks[6], (DEPTH, 3 * D_MODEL), f32),
        "w_in": nrm(ks[7], (DEPTH, D_MODEL, IN_COLS), f32) * D_MODEL ** -0.5,
        "conv_w": nrm(ks[8], (DEPTH, CONV_K, CONV_WIDTH), f32) * CONV_K ** -0.5,
        "w_a_out": nrm(ks[9], (DEPTH, CONV_WIDTH, D_MODEL), f32) * CONV_WIDTH ** -0.5,
        "w_b_out": nrm(ks[10], (DEPTH, ATTN_WIDTH, D_MODEL), f32) * ATTN_WIDTH ** -0.5,
        "attn_sink": 0.5 * nrm(ks[11], (DEPTH, N_HEADS), f32),
        "w_o": nrm(ks[12], (DEPTH, D_MODEL, D_MODEL), f32) * D_MODEL ** -0.5,
        "final_norm_w": 1.0 + 0.02 * nrm(ks[13], (D_MODEL,), f32),
    }


def reference(x, c, ctx, c_ctx, norm_w, w_mod, b_mod, w_in, conv_w, w_a_out, w_b_out,
              attn_sink, w_o, final_norm_w):
    B_, S_, _ = x.shape
    L_ = ctx.shape[1]
    ROWS = S_ // GRID_W
    rows = jnp.broadcast_to(jnp.arange(ROWS)[:, None], (ROWS, GRID_W)).reshape(-1)
    cols = jnp.broadcast_to(jnp.arange(GRID_W)[None, :], (ROWS, GRID_W)).reshape(-1)
    inv_freq = ROPE_THETA ** (-jnp.arange(ROPE_FREQS, dtype=jnp.float32) / ROPE_FREQS)
    ang = jnp.stack([rows.astype(jnp.float32)[:, None] * inv_freq,
                     cols.astype(jnp.float32)[:, None] * inv_freq], axis=1)
    cos, sin = jnp.cos(ang), jnp.sin(ang)

    for l in range(DEPTH):
        last = l == DEPTH - 1
        mod_x = jnp.einsum('bd,de->be', jax.nn.silu(c), w_mod[l]) + b_mod[l]
        shift_x, scale_x, gate_x = jnp.split(mod_x[:, None, :], 3, axis=-1)
        mod_c = jnp.einsum('d,de->e', jax.nn.silu(c_ctx), w_mod[l]) + b_mod[l]
        shift_c, scale_c, gate_c = jnp.split(mod_c, 3, axis=-1)

        hx = rms_norm(x, norm_w[l]) * (1.0 + scale_x) + shift_x
        hc = rms_norm(ctx, norm_w[l]) * (1.0 + scale_c) + shift_c
        px = project(hx, w_in[l])
        pc = project(hc, w_in[l])

        q_c = pc[4].reshape(B_, L_, N_HEADS, HEAD_DIM)
        k_c = pc[5].reshape(B_, L_, N_KV_HEADS, HEAD_DIM)
        v_c = pc[6].reshape(B_, L_, N_KV_HEADS, HEAD_DIM)

        q_x = rope_2d(px[4].reshape(B_, S_, N_HEADS, HEAD_DIM), cos, sin)
        k_x = rope_2d(px[5].reshape(B_, S_, N_KV_HEADS, HEAD_DIM), cos, sin)
        v_x = px[6].reshape(B_, S_, N_KV_HEADS, HEAD_DIM)
        attn_x = latent_attention(q_x, k_x, v_x, k_c, v_c, attn_sink[l])
        out_x = mixer_output(px, attn_x, conv_w[l], w_a_out[l], w_b_out[l], w_o[l])

        if not last:
            attn_c = context_attention(q_c, k_c, v_c, attn_sink[l])
            out_c = mixer_output(pc, attn_c, conv_w[l], w_a_out[l], w_b_out[l], w_o[l])
            ctx = ctx + gate_c * out_c
        x = x + gate_x * out_x

    return rms_norm(x, final_norm_w)
```

```cpp
#include <hip/hip_runtime.h>
#include <hip/hip_cooperative_groups.h>
#include <cstdio>
#include <cstdint>
namespace cg = cooperative_groups;

#ifndef PHMASK
#define PHMASK 127
#endif
#ifndef MK_COOP
#define MK_COOP 0
#endif

#define LAS __attribute__((address_space(3)))
typedef unsigned short bf16_t;
typedef short bf16x8 __attribute__((ext_vector_type(8)));
typedef short s16x4 __attribute__((ext_vector_type(4)));
typedef short v4i16_t __attribute__((ext_vector_type(4)));
typedef float f32x4 __attribute__((ext_vector_type(4)));
typedef float f32x16 __attribute__((ext_vector_type(16)));
typedef unsigned u32x4 __attribute__((ext_vector_type(4)));
typedef unsigned u32x2 __attribute__((ext_vector_type(2)));

constexpr int DM = 1024, NB = 16, SEQ = 2048, CTXL = 256, DEPTH = 4, NCOL = 5376;
constexpr int TL = NB * SEQ, TC = NB * CTXL, TT = TL + TC;
constexpr int C_B = 0, C_C = 512, C_U = 1024, C_ZA = 1536, C_Q = 2048, C_K = 2560, C_V = 2688, C_ZB = 2816, C_GA = 3328, C_GB = 4352;
constexpr float RMS_EPS = 1e-6f;
constexpr float LOG2E = 1.4426950408889634f;
constexpr float QSCALE = 0.125f * LOG2E;

constexpr size_t MiB = 1u << 20;
constexpr size_t WS_WIN_T = 1 * MiB;
constexpr size_t WS_WAB_T = 12 * MiB;
constexpr size_t WS_WO_T = 20 * MiB;
constexpr size_t WS_MOD = 28 * MiB;
constexpr size_t WS_NW1 = 29 * MiB;
constexpr size_t WS_SB = 30 * MiB;
constexpr size_t WS_ROPE = 32 * MiB;
constexpr size_t WS_SSP = 33 * MiB;
constexpr size_t WS_XCTX = 36 * MiB;
constexpr size_t WS_XS = 52 * MiB;
constexpr size_t WS_P = 124 * MiB;
constexpr size_t WS_END = WS_P + (size_t)TT * NCOL * 2;
static_assert(WS_END <= 502 * MiB, "ws map");

constexpr int LDS_BYTES = 131072 + 1024;
constexpr int NPHASE = 2 + 4 * DEPTH + 1;

struct Args { const float* in[14]; float* out; unsigned char* ws; int ph_lo, ph_hi, coop, pad; };

__device__ __forceinline__ unsigned cvt_pk_bf16(float lo, float hi) { unsigned r; asm volatile("v_cvt_pk_bf16_f32 %0, %1, %2" : "=v"(r) : "v"(lo), "v"(hi)); return r; }
__device__ __forceinline__ float bf_lo(unsigned w) { return __uint_as_float(w << 16); }
__device__ __forceinline__ float bf_hi(unsigned w) { return __uint_as_float(w & 0xffff0000u); }
__device__ __forceinline__ float fast_exp(float x) { return __builtin_amdgcn_exp2f(x * LOG2E); }
__device__ __forceinline__ float sigmoidf_(float x) { return __builtin_amdgcn_rcpf(1.0f + fast_exp(-x)); }
__device__ __forceinline__ float siluf_(float x) { return x * sigmoidf_(x); }
__device__ __forceinline__ float wave_sum(float v) {
#pragma unroll
    for (int o = 1; o < 64; o <<= 1) v += __shfl_xor(v, o);
    return v;
}
#define LDS_WAIT() asm volatile("s_waitcnt lgkmcnt(0)" ::: "memory")
#define VM_WAIT() asm volatile("s_waitcnt vmcnt(0)" ::: "memory")

namespace pg8 {
constexpr int BM = 256, BK = 64, HALF = 128, HTB = HALF * BK * 2, STAGE_BYTES = 8 * HTB, NXCD = 8, WGM = 8;
__host__ __device__ __forceinline__ int lds_byte(int r, int c) { const int st = (r >> 4) * 2 + (c >> 5), rr = r & 15, cc = c & 31, ob = rr * 64 + cc * 2; return st * 1024 + (ob ^ (((ob >> 9) & 1) << 5)); }
__host__ __device__ __forceinline__ void stage_rc(int b, int& R, int& C) { const int st = b / 1024, sb = b % 1024, swz = sb ^ (((sb >> 9) & 1) << 5); R = (st >> 1) * 16 + swz / 64; C = (st & 1) * 32 + (swz % 64) / 2; }
__host__ __device__ __forceinline__ int perm32(int rho) { const int n = rho >> 4, i = rho & 15; return 8 * (i >> 2) + 4 * n + (i & 3); }

struct Unit { int pm, pn; };
struct Gemm { const bf16_t* A; const bf16_t* Bt; int lda; int K; };

struct Order {
    int nM, nN, nwg, G, c, nextra, extra_pm0, extra_pn;
    __device__ void init(int nM_, int nN_, int G_, int c_, int nextra_ = 0, int epm0 = 0, int epn = 0) { nM = nM_; nN = nN_; nwg = nM * nN; G = G_; c = c_; nextra = nextra_; extra_pm0 = epm0; extra_pn = epn; }
    __device__ bool next(int i, Unit& u) const {
        const long L = (long)i * G + c; if (L >= nwg + nextra) return false;
        if (L >= nwg) { u.pm = extra_pm0 + (int)(L - nwg); u.pn = extra_pn; return true; }
        int wgid = (int)L; { const int q = nwg / NXCD, r = nwg % NXCD, xcd = wgid % NXCD, off = wgid / NXCD; wgid = (xcd < r ? xcd * (q + 1) : r * (q + 1) + (xcd - r) * q) + off; }
        const int nig = WGM * nN, gid = wgid / nig, fm = gid * WGM, gsz = (nM - fm) < WGM ? (nM - fm) : WGM;
        u.pm = fm + ((wgid % nig) % gsz); u.pn = (wgid % nig) / gsz; return true;
    }
};

template <class Epi, class Sched, bool ALIGN_EPI>
__device__ __forceinline__ void gemm_phase(LAS unsigned char* lds, const Gemm g, const Sched& S, const Epi& E) {
    int tid = threadIdx.x; asm volatile("" : "+v"(tid));
    const int wid = __builtin_amdgcn_readfirstlane(tid >> 6), lane = tid & 63, wr = wid >> 2, wc = wid & 3, fr = lane & 15, fq = lane >> 4;
    const int K = g.K, nt = K / BK, lda = g.lda;
    unsigned voffA[2], voffB[2];
#pragma unroll
    for (int i = 0; i < 2; ++i) { int R, C; stage_rc(tid * 16 + i * 8192, R, C); const int Rb = Epi::PERM ? ((R & ~31) + perm32(R & 31)) : R;
        voffA[i] = (unsigned)(R * lda + C) * 2u; voffB[i] = (unsigned)(Rb * K + C) * 2u; }
    const size_t kstep = (size_t)(BK * 2);
    const size_t hstepA = (size_t)HALF * lda * 2, tstepA = 2 * hstepA;
    const size_t hstepB = (size_t)HALF * K * 2, tstepB = 2 * hstepB;
    const unsigned ldsw = (unsigned)wid * 1024u;
    const int aoff = lds_byte(wr * 64 + fr, fq * 8), boff = lds_byte(wc * 32 + fr, fq * 8);
#define PG8_SA(b, h) (((b) * 2 + (h)) * HTB)
#define PG8_SB(b, h) ((4 + (b) * 2 + (h)) * HTB)
#define PG8_STAGE(bufoff, gbase, voff) do { _Pragma("unroll") for (int _i = 0; _i < 2; ++_i) \
        __builtin_amdgcn_global_load_lds((const unsigned*)((const char*)(gbase) + (voff)[_i]), (LAS unsigned*)(lds + (bufoff) + ldsw + _i * 8192), 16, 0, 0); } while (0)
#define PG8_LDA(dst, b, h) do { _Pragma("unroll") for (int m = 0; m < 4; ++m) _Pragma("unroll") for (int k = 0; k < 2; ++k) dst[m][k] = *(const LAS bf16x8*)(lds + PG8_SA(b, h) + aoff + m * 2048 + k * 1024); } while (0)
#define PG8_LDB(dst, b, h) do { _Pragma("unroll") for (int n = 0; n < 2; ++n) _Pragma("unroll") for (int k = 0; k < 2; ++k) dst[n][k] = *(const LAS bf16x8*)(lds + PG8_SB(b, h) + boff + n * 2048 + k * 1024); } while (0)
#define PG8_MMA(ai, bj, At, Bt) do { __builtin_amdgcn_s_setprio(1); _Pragma("unroll") for (int m = 0; m < 4; ++m) _Pragma("unroll") for (int n = 0; n < 2; ++n) _Pragma("unroll") for (int k = 0; k < 2; ++k) \
        acc[ai][bj][m][n] = __builtin_amdgcn_mfma_f32_16x16x32_bf16(Bt[n][k], At[m][k], acc[ai][bj][m][n], 0, 0, 0); __builtin_amdgcn_s_setprio(0); } while (0)
#define PG8_WAIT_V(n) asm volatile("s_waitcnt vmcnt(" #n ")" ::: "memory")
#define PG8_WAIT_L(n) asm volatile("s_waitcnt lgkmcnt(" #n ")" ::: "memory")
#define PG8_BAR __builtin_amdgcn_s_barrier()
#define PG8_SCHED __builtin_amdgcn_sched_barrier(0)
    Unit cur, nxt; int ui = 0;
    if (!S.next(0, cur)) return;
    f32x4 acc[2][2][4][2];
#pragma unroll
    for (int a = 0; a < 2; ++a)
#pragma unroll
        for (int b = 0; b < 2; ++b)
#pragma unroll
            for (int m = 0; m < 4; ++m)
#pragma unroll
                for (int n = 0; n < 2; ++n) acc[a][b][m][n] = (f32x4){0.f, 0.f, 0.f, 0.f};
    bf16x8 At[4][2], B0[2][2], B1[2][2];
    const char* cA = (const char*)g.A + (size_t)cur.pm * tstepA; const char* cB = (const char*)g.Bt + (size_t)cur.pn * tstepB;
    PG8_STAGE(PG8_SB(0, 0), cB, voffB); PG8_STAGE(PG8_SB(0, 1), cB + hstepB, voffB); PG8_STAGE(PG8_SA(0, 0), cA, voffA); PG8_STAGE(PG8_SA(0, 1), cA + hstepA, voffA);
    if (wr == 1) PG8_BAR;
    PG8_WAIT_V(2); PG8_BAR;
    PG8_STAGE(PG8_SB(1, 0), cB + kstep, voffB); PG8_STAGE(PG8_SA(1, 0), cA + kstep, voffA); PG8_STAGE(PG8_SB(1, 1), cB + hstepB + kstep, voffB);
    PG8_WAIT_V(6); PG8_BAR;
    for (;;) {
        const bool has_next = S.next(ui + 1, nxt);
        const char* nA = has_next ? (const char*)g.A + (size_t)nxt.pm * tstepA : cA; const char* nB = has_next ? (const char*)g.Bt + (size_t)nxt.pn * tstepB : cB;
        for (int t = 0; t < nt; t += 2) {
            if constexpr (Epi::HOOK) { if (t == (nt >> 1)) E.mid(acc, cur, wr, wc, fr, fq); }
            const bool last = (t == nt - 2);
            const char* a1 = cA + (size_t)(t + 1) * kstep;
            const char* a2 = last ? nA : cA + (size_t)(t + 2) * kstep; const char* b2 = last ? nB : cB + (size_t)(t + 2) * kstep;
            const char* a3 = a2 + kstep; const char* b3 = b2 + kstep;
            PG8_LDB(B0, 0, 0); PG8_LDB(B1, 0, 1); PG8_SCHED; PG8_LDA(At, 0, 0); PG8_STAGE(PG8_SA(1, 1), a1 + hstepA, voffA);
            PG8_WAIT_V(8); PG8_WAIT_L(0); PG8_BAR; PG8_MMA(0, 0, At, B0); PG8_MMA(0, 1, At, B1); PG8_BAR; PG8_SCHED;
            PG8_LDA(At, 0, 1); PG8_STAGE(PG8_SB(0, 0), b2, voffB); PG8_STAGE(PG8_SB(0, 1), b2 + hstepB, voffB); PG8_STAGE(PG8_SA(0, 0), a2, voffA);
            PG8_WAIT_V(8); PG8_WAIT_L(0); PG8_BAR; PG8_MMA(1, 0, At, B0); PG8_MMA(1, 1, At, B1); PG8_BAR; PG8_SCHED;
            PG8_LDB(B0, 1, 0); PG8_LDB(B1, 1, 1); PG8_SCHED; PG8_LDA(At, 1, 0); PG8_STAGE(PG8_SA(0, 1), a2 + hstepA, voffA);
            PG8_WAIT_V(8); PG8_WAIT_L(0); PG8_BAR; PG8_MMA(0, 0, At, B0); PG8_MMA(0, 1, At, B1); PG8_BAR; PG8_SCHED;
            PG8_LDA(At, 1, 1); PG8_STAGE(PG8_SB(1, 0), b3, voffB); PG8_STAGE(PG8_SB(1, 1), b3 + hstepB, voffB); PG8_STAGE(PG8_SA(1, 0), a3, voffA);
            PG8_WAIT_V(8); PG8_WAIT_L(0); PG8_BAR; PG8_MMA(1, 0, At, B0); PG8_MMA(1, 1, At, B1); PG8_BAR; PG8_SCHED;
        }
        if constexpr (ALIGN_EPI) { if (wr == 0) PG8_BAR; }
        E(acc, cur, wr, wc, fr, fq);
        if (!has_next) break;
#pragma unroll
        for (int a = 0; a < 2; ++a)
#pragma unroll
            for (int b = 0; b < 2; ++b)
#pragma unroll
                for (int m = 0; m < 4; ++m)
#pragma unroll
                    for (int n = 0; n < 2; ++n) acc[a][b][m][n] = (f32x4){0.f, 0.f, 0.f, 0.f};
        cur = nxt; cA = nA; cB = nB; ++ui;
        if constexpr (ALIGN_EPI) { if (wr == 1) PG8_BAR; }
    }
    PG8_WAIT_V(0);
    if constexpr (!ALIGN_EPI) { if (wr == 0) PG8_BAR; }
    PG8_BAR;
#undef PG8_SA
#undef PG8_SB
#undef PG8_STAGE
#undef PG8_LDA
#undef PG8_LDB
#undef PG8_MMA
#undef PG8_WAIT_V
#undef PG8_WAIT_L
#undef PG8_BAR
#undef PG8_SCHED
}
}

struct EpiG1 {
    static constexpr bool PERM = false, HOOK = false;
    bf16_t* P; const float* ssp; const float* sb; const float* ropec; const float* ropes;
    __device__ __forceinline__ void mid(f32x4 (&)[2][2][4][2], const pg8::Unit&, int, int, int, int) const {}
    __device__ __forceinline__ void operator()(const f32x4 (&acc)[2][2][4][2], const pg8::Unit& u, int wr, int wc, int fr, int fq) const {
        const bool latent = u.pm < 128;
        const int bidx = latent ? (u.pm >> 3) : 16;
        const int col0 = u.pn * 256 + wc * 32 + 4 * fq;
        const float* sbr = sb + bidx * NCOL + col0;
        f32x4 bv[2][2];
#pragma unroll
        for (int bj = 0; bj < 2; ++bj)
#pragma unroll
            for (int n = 0; n < 2; ++n) bv[bj][n] = *(const f32x4*)(sbr + bj * 128 + n * 16);
        const bool isq = (u.pn == 8 || u.pn == 9), isk = (u.pn == 10);
        const bool anyrope = latent && (isq || isk);
        const float sc = isq ? QSCALE : 1.0f;
#pragma unroll
        for (int ai = 0; ai < 2; ++ai)
#pragma unroll
            for (int m = 0; m < 4; ++m) {
                const int row = u.pm * 256 + ai * 128 + wr * 64 + m * 16 + fr;
                const f32x4* sp = (const f32x4*)(ssp + (size_t)row * 16);
                const f32x4 s4 = (sp[0] + sp[1]) + (sp[2] + sp[3]);
                const float ss = (s4[0] + s4[1]) + (s4[2] + s4[3]);
                const float rinv = 1.0f / sqrtf(ss * (1.0f / 1024.0f) + RMS_EPS);
                f32x4 cs = (f32x4){1.f, 1.f, 1.f, 1.f}, sn = (f32x4){0.f, 0.f, 0.f, 0.f};
                if (anyrope) { const int t = row & 2047; const int pos = (wc & 1) ? (t & 63) : (t >> 6);
                    cs = *(const f32x4*)(ropec + pos * 16 + 4 * fq); sn = *(const f32x4*)(ropes + pos * 16 + 4 * fq); }
                bf16_t* rowp = P + (size_t)row * NCOL + col0;
#pragma unroll
                for (int bj = 0; bj < 2; ++bj) {
                    f32x4 v0 = acc[ai][bj][m][0] * rinv + bv[bj][0], v1 = acc[ai][bj][m][1] * rinv + bv[bj][1];
                    const bool rp = anyrope && (isq || bj == 0);
                    if (rp) { const f32x4 a = v0 * cs - v1 * sn, b = v1 * cs + v0 * sn; v0 = a; v1 = b; }
                    v0 = v0 * sc; v1 = v1 * sc;
                    u32x2 w0, w1; w0.x = cvt_pk_bf16(v0[0], v0[1]); w0.y = cvt_pk_bf16(v0[2], v0[3]); w1.x = cvt_pk_bf16(v1[0], v1[1]); w1.y = cvt_pk_bf16(v1[2], v1[3]);
                    *(u32x2*)(rowp + bj * 128) = w0; *(u32x2*)(rowp + bj * 128 + 16) = w1;
                }
            }
    }
};

struct EpiG2 {
    static constexpr bool PERM = true, HOOK = true;
    bf16_t* P;
    __device__ __forceinline__ void mid(f32x4 (&acc)[2][2][4][2], const pg8::Unit& u, int wr, int wc, int fr, int fq) const {
        int col8 = u.pn * 256 + wc * 32 + 8 * fq, rbase = u.pm * 256 + wr * 64 + fr;
        asm volatile("" : "+v"(col8), "+v"(rbase));
#pragma unroll
        for (int ai = 0; ai < 2; ++ai)
#pragma unroll
            for (int m = 0; m < 4; ++m) {
                const int row = rbase + ai * 128 + m * 16;
                const bf16_t* rowp = P + (size_t)row * NCOL + col8;
#pragma unroll
                for (int bj = 0; bj < 2; ++bj) {
                    const u32x4 ga = *(const u32x4*)(rowp + C_GA + bj * 128), gb = *(const u32x4*)(rowp + C_GB + bj * 128);
#pragma unroll
                    for (int w = 0; w < 4; ++w) {
                        const float a0 = bf_lo(ga[w]), a1 = bf_hi(ga[w]), b0 = bf_lo(gb[w]), b1 = bf_hi(gb[w]);
                        const float r0 = (1.0f + fast_exp(-b0)) * __builtin_amdgcn_rcpf(1.0f + fast_exp(-a0));
                        const float r1 = (1.0f + fast_exp(-b1)) * __builtin_amdgcn_rcpf(1.0f + fast_exp(-a1));
                        acc[ai][bj][m][w >> 1][(w & 1) * 2] *= r0; acc[ai][bj][m][w >> 1][(w & 1) * 2 + 1] *= r1;
                    }
                }
                asm volatile("" ::: "memory");
            }
    }
    __device__ __forceinline__ void operator()(const f32x4 (&acc)[2][2][4][2], const pg8::Unit& u, int wr, int wc, int fr, int fq) const {
        const int col8 = u.pn * 256 + wc * 32 + 8 * fq;
#pragma unroll
        for (int ai = 0; ai < 2; ++ai)
#pragma unroll
            for (int m = 0; m < 4; ++m) {
                const int row = u.pm * 256 + ai * 128 + wr * 64 + m * 16 + fr;
                bf16_t* rowp = P + (size_t)row * NCOL + col8;
#pragma unroll
                for (int bj = 0; bj < 2; ++bj) {
                    const u32x4 gb = *(const u32x4*)(rowp + C_GB + bj * 128);
                    u32x4 o;
#pragma unroll
                    for (int w = 0; w < 4; ++w) {
                        const float s0 = sigmoidf_(bf_lo(gb[w])), s1 = sigmoidf_(bf_hi(gb[w]));
                        o[w] = cvt_pk_bf16(acc[ai][bj][m][w >> 1][(w & 1) * 2] * s0, acc[ai][bj][m][w >> 1][(w & 1) * 2 + 1] * s1);
                    }
                    *(u32x4*)(rowp + C_GA + bj * 128) = o;
                }
                asm volatile("" ::: "memory");
            }
    }
};

struct EpiG3 {
    static constexpr bool PERM = false, HOOK = false;
    const float* xin_lat; const float* xin_ctx; float* xout_lat; float* xout_ctx; const float* gate; const float* nw; bf16_t* xs; float* ssp;
    __device__ __forceinline__ void mid(f32x4 (&)[2][2][4][2], const pg8::Unit&, int, int, int, int) const {}
    __device__ __forceinline__ void operator()(const f32x4 (&acc)[2][2][4][2], const pg8::Unit& u, int wr, int wc, int fr, int fq) const {
        const bool latent = u.pm < 128;
        const int bidx = latent ? (u.pm >> 3) : 16;
        const int col0 = u.pn * 256 + wc * 32 + 4 * fq;
        f32x4 gv[2][2], nv[2][2];
#pragma unroll
        for (int bj = 0; bj < 2; ++bj)
#pragma unroll
            for (int n = 0; n < 2; ++n) { gv[bj][n] = *(const f32x4*)(gate + bidx * 3072 + col0 + bj * 128 + n * 16);
                nv[bj][n] = nw ? *(const f32x4*)(nw + bidx * 1024 + col0 + bj * 128 + n * 16) : (f32x4){0.f, 0.f, 0.f, 0.f}; }
#pragma unroll
        for (int ai = 0; ai < 2; ++ai)
#pragma unroll
            for (int m = 0; m < 4; ++m) {
                const int row = u.pm * 256 + ai * 128 + wr * 64 + m * 16 + fr;
                const float* xi = latent ? xin_lat + (size_t)row * DM : xin_ctx + (size_t)(row - TL) * DM;
                float* xo = latent ? xout_lat + (size_t)row * DM : xout_ctx + (size_t)(row - TL) * DM;
                float q = 0.f;
#pragma unroll
                for (int bj = 0; bj < 2; ++bj)
#pragma unroll
                    for (int n = 0; n < 2; ++n) {
                        const int off = col0 + bj * 128 + n * 16;
                        const f32x4 xv = *(const f32x4*)(xi + off);
                        const f32x4 xn = xv + gv[bj][n] * acc[ai][bj][m][n];
                        *(f32x4*)(xo + off) = xn;
                        q += (xn[0] * xn[0] + xn[1] * xn[1]) + (xn[2] * xn[2] + xn[3] * xn[3]);
                        if (nw) { const f32x4 h = xn * nv[bj][n]; u32x2 w; w.x = cvt_pk_bf16(h[0], h[1]); w.y = cvt_pk_bf16(h[2], h[3]); *(u32x2*)(xs + (size_t)row * DM + off) = w; }
                    }
                q += __shfl_xor(q, 16); q += __shfl_xor(q, 32);
                if (fq == 0) ssp[(size_t)row * 16 + u.pn * 4 + wc] = q;
            }
    }
};

__device__ __forceinline__ s16x4 vtr(const LAS unsigned char* p) { return __builtin_bit_cast(s16x4, __builtin_amdgcn_ds_read_tr16_b64_v4i16((LAS v4i16_t*)p)); }

__device__ __forceinline__ void attn_unit(LAS unsigned char* lds, bf16_t* P, int rowQ0, int h, int kh, int qq0, int nloc, int jlo, int keyrow_loc0, int keyrow_ctx0, float sink_l2) {
    int tid = threadIdx.x; asm volatile("" : "+v"(tid));
    const int lane = tid & 63, r32 = lane & 31, hi = lane >> 5;
    const int wid = __builtin_amdgcn_readfirstlane(tid >> 6);
    const int NT = nloc + 4;
    const size_t koff = (size_t)lane * NCOL + C_K + kh * 64 + wid * 8;
    const size_t voff = (size_t)(16 * (wid & 3) + (lane >> 2)) * NCOL + C_V + kh * 64 + (wid >> 2) * 32 + (lane & 3) * 8;
#define AT_STAGE(tt, buf) do { const int kr0_ = ((tt) < nloc) ? keyrow_loc0 + 64 * (jlo + (tt)) : keyrow_ctx0 + 64 * ((tt) - nloc); const bf16_t* tb_ = P + (size_t)kr0_ * NCOL; \
        __builtin_amdgcn_global_load_lds((const unsigned*)(tb_ + koff), (LAS unsigned*)(lds + (buf) * 16384 + wid * 1024), 16, 0, 0); \
        __builtin_amdgcn_global_load_lds((const unsigned*)(tb_ + voff), (LAS unsigned*)(lds + (buf) * 16384 + 8192 + wid * 1024), 16, 0, 0); } while (0)
    AT_STAGE(0, 0);
    bf16x8 qr[4];
    const size_t rowoff = (size_t)(rowQ0 + r32) * NCOL;
    {
        const bf16_t* qp = P + rowoff + C_Q + h * 64 + hi * 8;
#pragma unroll
        for (int d0 = 0; d0 < 4; ++d0) qr[d0] = *(const bf16x8*)(qp + d0 * 16);
    }
    f32x16 o0, o1;
#pragma unroll
    for (int i = 0; i < 16; ++i) { o0[i] = 0.f; o1[i] = 0.f; }
    float mrun = sink_l2, lrun = hi ? 0.f : 1.f;
    const int qq = qq0 + r32;
    VM_WAIT(); __syncthreads();
    for (int tt = 0; tt < NT; ++tt) {
        const int buf = tt & 1;
        if (tt + 1 < NT) AT_STAGE(tt + 1, buf ^ 1);
        const LAS unsigned char* kb = lds + buf * 16384 + hi * 1024 + r32 * 16;
        f32x16 p0, p1;
#pragma unroll
        for (int i = 0; i < 16; ++i) { p0[i] = 0.f; p1[i] = 0.f; }
#pragma unroll
        for (int d0 = 0; d0 < 4; ++d0) {
            const bf16x8 b0 = *(const LAS bf16x8*)(kb + d0 * 2048);
            const bf16x8 b1 = *(const LAS bf16x8*)(kb + d0 * 2048 + 512);
            p0 = __builtin_amdgcn_mfma_f32_32x32x16_bf16(b0, qr[d0], p0, 0, 0, 0);
            p1 = __builtin_amdgcn_mfma_f32_32x32x16_bf16(b1, qr[d0], p1, 0, 0, 0);
        }
        if (tt < nloc) {
            const int j = jlo + tt;
            if (j < 2) {
                const int lim = qq - 64 * j;
#pragma unroll
                for (int i = 0; i < 16; ++i) { const int kk = (i & 3) + 8 * (i >> 2) + 4 * hi; if (kk < lim) p0[i] = -1e30f; if (kk + 32 < lim) p1[i] = -1e30f; }
            } else if (j >= 4) {
                const int lim = qq - 64 * (j - 4);
#pragma unroll
                for (int i = 0; i < 16; ++i) { const int kk = (i & 3) + 8 * (i >> 2) + 4 * hi; if (kk > lim) p0[i] = -1e30f; if (kk + 32 > lim) p1[i] = -1e30f; }
            }
        }
        float rm = fmaxf(p0[0], p1[0]);
#pragma unroll
        for (int i = 1; i < 16; ++i) rm = fmaxf(rm, fmaxf(p0[i], p1[i]));
        rm = fmaxf(rm, __shfl_xor(rm, 32));
        const float mn = fmaxf(mrun, rm);
        const float f = __builtin_amdgcn_exp2f(mrun - mn);
        mrun = mn;
        float ps = 0.f;
#pragma unroll
        for (int i = 0; i < 16; ++i) { p0[i] = __builtin_amdgcn_exp2f(p0[i] - mn); p1[i] = __builtin_amdgcn_exp2f(p1[i] - mn); ps += p0[i] + p1[i]; }
        lrun = lrun * f + ps;
#pragma unroll
        for (int i = 0; i < 16; ++i) { o0[i] *= f; o1[i] *= f; }
        u32x4 pw[4];
#pragma unroll
        for (int w = 0; w < 4; ++w) { pw[0][w] = cvt_pk_bf16(p0[2 * w], p0[2 * w + 1]); pw[1][w] = cvt_pk_bf16(p0[8 + 2 * w], p0[8 + 2 * w + 1]);
            pw[2][w] = cvt_pk_bf16(p1[2 * w], p1[2 * w + 1]); pw[3][w] = cvt_pk_bf16(p1[8 + 2 * w], p1[8 + 2 * w + 1]); }
        const LAS unsigned char* vp = lds + buf * 16384 + 8192 + ((lane >> 4) & 1) * 32 + (lane & 3) * 8 + (4 * hi + ((lane & 15) >> 2)) * 64;
#pragma unroll
        for (int s = 0; s < 4; ++s) {
            const s16x4 l0 = vtr(vp + s * 1024), h0 = vtr(vp + s * 1024 + 512);
            const s16x4 l1 = vtr(vp + 4096 + s * 1024), h1 = vtr(vp + 4096 + s * 1024 + 512);
            const bf16x8 v0 = (bf16x8){l0[0], l0[1], l0[2], l0[3], h0[0], h0[1], h0[2], h0[3]};
            const bf16x8 v1 = (bf16x8){l1[0], l1[1], l1[2], l1[3], h1[0], h1[1], h1[2], h1[3]};
            const bf16x8 pa = __builtin_bit_cast(bf16x8, pw[s]);
            o0 = __builtin_amdgcn_mfma_f32_32x32x16_bf16(v0, pa, o0, 0, 0, 0);
            o1 = __builtin_amdgcn_mfma_f32_32x32x16_bf16(v1, pa, o1, 0, 0, 0);
        }
        VM_WAIT(); __syncthreads();
    }
#undef AT_STAGE
    lrun += __shfl_xor(lrun, 32);
    const float inv = 1.0f / lrun;
    bf16_t* op = P + rowoff + h * 64 + 4 * hi;
#pragma unroll
    for (int d0 = 0; d0 < 2; ++d0)
#pragma unroll
        for (int gq = 0; gq < 4; ++gq) {
            const int d = d0 * 32 + 8 * gq;
            const u32x2 z = *(const u32x2*)(op + C_ZB + d);
            const float z0 = bf_lo(z.x), z1 = bf_hi(z.x), z2 = bf_lo(z.y), z3 = bf_hi(z.y);
            const float a0 = (d0 ? o1[4 * gq + 0] : o0[4 * gq + 0]) * inv * siluf_(z0);
            const float a1 = (d0 ? o1[4 * gq + 1] : o0[4 * gq + 1]) * inv * siluf_(z1);
            const float a2 = (d0 ? o1[4 * gq + 2] : o0[4 * gq + 2]) * inv * siluf_(z2);
            const float a3 = (d0 ? o1[4 * gq + 3] : o0[4 * gq + 3]) * inv * siluf_(z3);
            u32x2 w; w.x = cvt_pk_bf16(a0, a1); w.y = cvt_pk_bf16(a2, a3);
            *(u32x2*)(op + C_Q + d) = w;
        }
}

struct V8 { f32x4 a, b; };
__device__ __forceinline__ V8 ld8(const bf16_t* p) { const u32x4 w = *(const u32x4*)p; V8 r; r.a = (f32x4){bf_lo(w.x), bf_hi(w.x), bf_lo(w.y), bf_hi(w.y)}; r.b = (f32x4){bf_lo(w.z), bf_hi(w.z), bf_lo(w.w), bf_hi(w.w)}; return r; }
__device__ __forceinline__ V8 cu_at(const bf16_t* P, int t, int c0) { const V8 c = ld8(P + (size_t)t * NCOL + C_C + c0), u = ld8(P + (size_t)t * NCOL + C_U + c0); V8 r; r.a = c.a * u.a; r.b = c.b * u.b; return r; }
__device__ __forceinline__ void conv_run(bf16_t* P, const float* cw, int run, int lane) {
    const int row0 = run * 16;
    int s0, s1; if (row0 < TL) { s0 = row0 & ~2047; s1 = s0 + 2048; } else { s0 = TL + ((row0 - TL) & ~255); s1 = s0 + 256; }
    const int c0 = lane * 8;
    const f32x4 w0a = *(const f32x4*)(cw + c0), w0b = *(const f32x4*)(cw + c0 + 4);
    const f32x4 w1a = *(const f32x4*)(cw + 512 + c0), w1b = *(const f32x4*)(cw + 512 + c0 + 4);
    const f32x4 w2a = *(const f32x4*)(cw + 1024 + c0), w2b = *(const f32x4*)(cw + 1024 + c0 + 4);
    const f32x4 z4 = (f32x4){0.f, 0.f, 0.f, 0.f};
    V8 prev, cur; prev.a = z4; prev.b = z4;
    if (row0 - 1 >= s0) prev = cu_at(P, row0 - 1, c0);
    cur = cu_at(P, row0, c0);
    for (int i = 0; i < 16; ++i) {
        const int t = row0 + i;
        V8 nxt; nxt.a = z4; nxt.b = z4;
        if (t + 1 < s1) nxt = cu_at(P, t + 1, c0);
        const f32x4 ca = w0a * prev.a + w1a * cur.a + w2a * nxt.a, cb = w0b * prev.b + w1b * cur.b + w2b * nxt.b;
        const V8 bg = ld8(P + (size_t)t * NCOL + C_B + c0), z = ld8(P + (size_t)t * NCOL + C_ZA + c0);
        f32x4 ya, yb;
#pragma unroll
        for (int e = 0; e < 4; ++e) { ya[e] = bg.a[e] * ca[e] * siluf_(z.a[e]); yb[e] = bg.b[e] * cb[e] * siluf_(z.b[e]); }
        u32x4 w; w.x = cvt_pk_bf16(ya[0], ya[1]); w.y = cvt_pk_bf16(ya[2], ya[3]); w.z = cvt_pk_bf16(yb[0], yb[1]); w.w = cvt_pk_bf16(yb[2], yb[3]);
        *(u32x4*)(P + (size_t)t * NCOL + C_ZA + c0) = w;
        prev = cur; cur = nxt;
    }
}

__device__ __forceinline__ void transpose_item(const float* W, int ldw, bf16_t* WT, int ldo, int koff, int nblk, LAS float* scr, int item, int lane) {
    const int kb = item / nblk, nb = item % nblk, k0 = 64 * kb, n0 = 32 * nb;
#pragma unroll 8
    for (int i = 0; i < 32; ++i) { const int kk = 2 * i + (lane >> 5); scr[kk * 33 + (lane & 31)] = W[(size_t)(k0 + kk) * ldw + n0 + (lane & 31)]; }
    LDS_WAIT(); asm volatile("" ::: "memory");
    const int c = lane & 7;
#pragma unroll
    for (int j = 0; j < 4; ++j) { const int n = (lane >> 3) + 8 * j; const LAS float* s = scr + (8 * c) * 33 + n;
        u32x4 o; o.x = cvt_pk_bf16(s[0 * 33], s[1 * 33]); o.y = cvt_pk_bf16(s[2 * 33], s[3 * 33]); o.z = cvt_pk_bf16(s[4 * 33], s[5 * 33]); o.w = cvt_pk_bf16(s[6 * 33], s[7 * 33]);
        *(u32x4*)(WT + (size_t)(n0 + n) * ldo + koff + k0 + 8 * c) = o; }
    LDS_WAIT(); asm volatile("" ::: "memory");
}

__device__ __forceinline__ void rowmat17_item(int tid, LAS unsigned char* lds, const float* W, int ldw, int col0, const float* bias, float* out, int ldo) {
    const int lane = tid & 63, wid = tid >> 6;
    const LAS float* tab = (const LAS float*)lds;
    LAS float* part = (LAS float*)(lds + 17 * 1024 * 4);
    float acc[17];
#pragma unroll
    for (int r = 0; r < 17; ++r) acc[r] = 0.f;
    const float* wp = W + (size_t)(wid * 128) * ldw + col0 + lane;
#pragma unroll 2
    for (int k = 0; k < 128; k += 4) {
        const float w0 = wp[(size_t)(k + 0) * ldw], w1 = wp[(size_t)(k + 1) * ldw], w2 = wp[(size_t)(k + 2) * ldw], w3 = wp[(size_t)(k + 3) * ldw];
#pragma unroll
        for (int r = 0; r < 17; ++r) { const f32x4 t = *(const LAS f32x4*)(tab + r * 1024 + wid * 128 + k); acc[r] += (t[0] * w0 + t[1] * w1) + (t[2] * w2 + t[3] * w3); }
    }
#pragma unroll
    for (int r = 0; r < 17; ++r) part[(wid * 17 + r) * 64 + lane] = acc[r];
    __syncthreads();
    for (int idx = tid; idx < 17 * 64; idx += 512) { const int r = idx >> 6, e = idx & 63; float s = 0.f;
#pragma unroll
        for (int w = 0; w < 8; ++w) s += part[(w * 17 + r) * 64 + e];
        if (bias) s += bias[col0 + e];
        out[(size_t)r * ldo + col0 + e] = s; }
    __syncthreads();
}

__global__ void __launch_bounds__(512, 2) fwd_kernel(Args a) {
    extern __shared__ __attribute__((aligned(16))) unsigned char lds_raw[];
    LAS unsigned char* lds = (LAS unsigned char*)lds_raw;
    const float* x_in = a.in[0]; const float* c_in = a.in[1]; const float* ctx_in = a.in[2]; const float* cctx_in = a.in[3];
    const float* norm_w = a.in[4]; const float* w_mod = a.in[5]; const float* b_mod = a.in[6]; const float* w_in = a.in[7]; const float* conv_w = a.in[8];
    const float* w_a_out = a.in[9]; const float* w_b_out = a.in[10]; const float* attn_sink = a.in[11]; const float* w_o = a.in[12]; const float* fnorm_w = a.in[13];
    unsigned char* ws = a.ws;
    bf16_t* WIN_T = (bf16_t*)(ws + WS_WIN_T); bf16_t* WAB_T = (bf16_t*)(ws + WS_WAB_T); bf16_t* WO_T = (bf16_t*)(ws + WS_WO_T);
    float* MOD = (float*)(ws + WS_MOD); float* NW1 = (float*)(ws + WS_NW1); float* SB = (float*)(ws + WS_SB);
    float* ROPEC = (float*)(ws + WS_ROPE); float* ROPES = ROPEC + 64 * 16;
    float* SSP = (float*)(ws + WS_SSP); float* XCTX = (float*)(ws + WS_XCTX);
    bf16_t* XS = (bf16_t*)(ws + WS_XS); bf16_t* P = (bf16_t*)(ws + WS_P);
    float* OUT = a.out;

    for (int ph = a.ph_lo; ph < a.ph_hi; ++ph) {
#define PH_PROLOG int tid = threadIdx.x, bx = blockIdx.x; asm volatile("" : "+v"(tid), "+s"(bx)); const int lane = tid & 63, wave = __builtin_amdgcn_readfirstlane(tid >> 6); const int G = gridDim.x; const int gw = bx * 8 + wave, NGW = G * 8; (void)lane; (void)gw; (void)NGW;
        if (ph == 0 && (PHMASK & 1)) { PH_PROLOG
            constexpr int NMOD = DEPTH * 48;
            if (bx < NMOD) {
                LAS float* tab = (LAS float*)lds;
                for (int idx = tid; idx < 17 * 1024; idx += 512) { const int r = idx >> 10, k = idx & 1023; const float v = (r < 16) ? c_in[r * 1024 + k] : cctx_in[k]; tab[idx] = siluf_(v); }
                __syncthreads();
                for (int it = bx; it < NMOD; it += G) { const int l = it / 48, ec = it % 48;
                    rowmat17_item(tid, lds, w_mod + (size_t)l * 1024 * 3072, 3072, ec * 64, b_mod + l * 3072, MOD + (size_t)l * 17 * 3072, 3072); }
            }
            __syncthreads();
            if (bx == G - 1) { for (int idx = tid; idx < 64 * 16; idx += 512) { const int pos = idx >> 4, f = idx & 15; const float invf = powf(10000.0f, -(float)f / 16.0f); const float ang = (float)pos * invf;
                    ROPEC[idx] = cosf(ang); ROPES[idx] = sinf(ang); } }
            LAS float* scr = (LAS float*)(lds + wave * 16384);
            constexpr int I_IN = 16 * 168, I_A = 8 * 32, I_O = 16 * 32;
            constexpr int NITEMS = I_IN + DEPTH * (2 * I_A + I_O);
            for (int it = gw; it < NITEMS; it += NGW) {
                int r = it;
                if (r < I_IN) { transpose_item(w_in, NCOL, WIN_T, 1024, 0, 168, scr, r, lane); continue; } r -= I_IN;
                const int l = r / (2 * I_A + I_O); r -= l * (2 * I_A + I_O);
                if (r < I_A) { transpose_item(w_a_out + (size_t)l * 512 * 1024, 1024, WAB_T + (size_t)l * 1024 * 1024, 1024, 0, 32, scr, r, lane); continue; } r -= I_A;
                if (r < I_A) { transpose_item(w_b_out + (size_t)l * 512 * 1024, 1024, WAB_T + (size_t)l * 1024 * 1024, 1024, 512, 32, scr, r, lane); continue; } r -= I_A;
                transpose_item(w_o + (size_t)l * 1024 * 1024, 1024, WO_T + (size_t)l * 1024 * 1024, 1024, 0, 32, scr, r, lane);
            }
        } else if (ph == 1 && (PHMASK & 2)) { PH_PROLOG
            constexpr int NSB = DEPTH * 84;
            { int curl = -1;
              for (int it = bx; it < NSB; it += G) { const int l = it / 84, nc = it % 84;
                if (l != curl) { __syncthreads(); LAS float* tab = (LAS float*)lds;
                    for (int idx = tid; idx < 17 * 1024; idx += 512) { const int r = idx >> 10, k = idx & 1023; tab[idx] = MOD[((size_t)l * 17 + r) * 3072 + k]; }
                    __syncthreads(); curl = l; }
                rowmat17_item(tid, lds, w_in + (size_t)l * 1024 * NCOL, NCOL, nc * 64, nullptr, SB + (size_t)l * 17 * NCOL, NCOL); } }
            for (int idx = bx * 512 + tid; idx < DEPTH * 17 * 1024; idx += G * 512) { const int k = idx & 1023, lr = idx >> 10, l = lr / 17;
                NW1[idx] = norm_w[l * 1024 + k] * (1.0f + MOD[(size_t)lr * 3072 + 1024 + k]); }
            for (int row = gw; row < TT; row += NGW) {
                const bool lat = row < TL; const int b = lat ? (row >> 11) : 16;
                const f32x4* xr = (const f32x4*)(lat ? x_in + (size_t)row * DM : ctx_in + (size_t)(row - TL) * DM) + lane;
                const f32x4* nwp = (const f32x4*)norm_w + lane; const f32x4* scp = (const f32x4*)(MOD + (size_t)b * 3072 + 1024) + lane;
                f32x4 v[4]; float s = 0.f;
#pragma unroll
                for (int j = 0; j < 4; ++j) { v[j] = xr[64 * j]; s += (v[j][0] * v[j][0] + v[j][1] * v[j][1]) + (v[j][2] * v[j][2] + v[j][3] * v[j][3]); }
                s = wave_sum(s);
                u32x2* o8 = (u32x2*)(XS + (size_t)row * DM) + lane;
#pragma unroll
                for (int j = 0; j < 4; ++j) { const f32x4 hh = v[j] * (nwp[64 * j] * (scp[64 * j] + 1.0f)); u32x2 w; w.x = cvt_pk_bf16(hh[0], hh[1]); w.y = cvt_pk_bf16(hh[2], hh[3]); o8[64 * j] = w; }
                if (lane < 16) SSP[(size_t)row * 16 + lane] = (lane == 0) ? s : 0.f;
            }
        } else if (ph == NPHASE - 1 && (PHMASK & 4)) { PH_PROLOG
            for (int row = gw; row < TL; row += NGW) {
                float s = SSP[(size_t)row * 16 + (lane & 15)];
                s += __shfl_xor(s, 1); s += __shfl_xor(s, 2); s += __shfl_xor(s, 4); s += __shfl_xor(s, 8);
                const float rinv = 1.0f / sqrtf(s * (1.0f / 1024.0f) + RMS_EPS);
                f32x4* xr = (f32x4*)(OUT + (size_t)row * DM) + lane; const f32x4* fw = (const f32x4*)fnorm_w + lane;
#pragma unroll
                for (int j = 0; j < 4; ++j) { const f32x4 v = xr[64 * j]; xr[64 * j] = v * rinv * fw[64 * j]; }
            }
        } else {
            const int l = (ph - 2) >> 2, sub = (ph - 2) & 3;
            const bool lastl = (l == DEPTH - 1);
            if (sub == 0 && (PHMASK & 8)) { PH_PROLOG
                pg8::Gemm g{XS, WIN_T, DM, DM};
                pg8::Order S; if (!lastl) S.init(TT / 256, NCOL / 256, G, bx); else S.init(TL / 256, NCOL / 256, G, bx, NB, TL / 256, 10);
                EpiG1 E{P, SSP, SB + (size_t)l * 17 * NCOL, ROPEC, ROPES};
                pg8::gemm_phase<EpiG1, pg8::Order, true>(lds, g, S, E);
            } else if (sub == 1 && (PHMASK & 16)) { PH_PROLOG
                const float* sink = attn_sink + l * 8;
                const int nlat = 1024, nctx = lastl ? 0 : 128;
                for (int ua = bx; ua < nlat + nctx; ua += G) {
                    if (ua < nlat) {
                        const int b = ua >> 6, rem = ua & 63, qblk = rem >> 2, kh = (rem >> 1) & 1, hp = rem & 1;
                        const int h = kh * 4 + hp * 2 + (wave >> 2);
                        const int jlo = (qblk == 0) ? 2 : 0, jhi = (qblk == 15) ? 4 : 6;
                        attn_unit(lds, P, b * SEQ + qblk * 128 + (wave & 3) * 32, h, kh, (wave & 3) * 32, jhi - jlo, jlo, b * SEQ + qblk * 128 - 128, TL + b * CTXL, sink[h] * LOG2E);
                    } else {
                        const int uc = ua - nlat, b = uc >> 3, h = uc & 7;
                        attn_unit(lds, P, TL + b * CTXL + wave * 32, h, h >> 2, 0, 0, 0, 0, TL + b * CTXL, sink[h] * LOG2E);
                    }
                }
                __syncthreads();
                const int nruns = (lastl ? TL : TT) / 16;
                const int ntr = lastl ? 0 : 16 * 168;
                LAS float* scr = (LAS float*)(lds + wave * 16384);
                for (int it = (NGW - 1 - gw); it < nruns + ntr; it += NGW) {
                    if (it < nruns) conv_run(P, conv_w + (size_t)l * 3 * 512, it, lane);
                    else transpose_item(w_in + (size_t)(l + 1) * 1024 * NCOL, NCOL, WIN_T, 1024, 0, 168, scr, it - nruns, lane);
                }
            } else if (sub == 2 && (PHMASK & 32)) { PH_PROLOG
                pg8::Gemm g{P + C_ZA, WAB_T + (size_t)l * 1024 * 1024, NCOL, DM};
                pg8::Order S; S.init((lastl ? TL : TT) / 256, 4, G, bx);
                EpiG2 E{P};
                pg8::gemm_phase<EpiG2, pg8::Order, true>(lds, g, S, E);
            } else if (PHMASK & 64) { PH_PROLOG
                pg8::Gemm g{P + C_GA, WO_T + (size_t)l * 1024 * 1024, NCOL, DM};
                pg8::Order S; S.init((lastl ? TL : TT) / 256, 4, G, bx);
                EpiG3 E{l == 0 ? x_in : OUT, l == 0 ? ctx_in : XCTX, OUT, XCTX, MOD + (size_t)l * 17 * 3072 + 2048, lastl ? nullptr : NW1 + (size_t)(l + 1) * 17 * 1024, XS, SSP};
                pg8::gemm_phase<EpiG3, pg8::Order, true>(lds, g, S, E);
            }
        }
        if (ph + 1 < a.ph_hi) {
#if MK_COOP
            if (a.coop) { cg::this_grid().sync(); }
#endif
            __syncthreads();
        }
    }
}

extern "C" void kernel_launch(void* const* d_in, const int* in_sizes, int n_in, void* d_out, int out_size, void* d_ws, size_t ws_size, hipStream_t stream) {
    static int grid = 0;
    if (grid == 0) {
        if (n_in != 14 || in_sizes[0] != TL * DM || out_size != TL * DM || ws_size < WS_END) {
            fprintf(stderr, "kernel_launch: unexpected shapes (n_in %d, in0 %d, out %d, ws %zu need %zu); nothing launched\n", n_in, n_in > 0 ? in_sizes[0] : -1, out_size, ws_size, (size_t)WS_END); grid = -1; return; }
        int dev = 0, cus = 0;
        if (hipGetDevice(&dev) != hipSuccess || hipDeviceGetAttribute(&cus, hipDeviceAttributeMultiprocessorCount, dev) != hipSuccess || cus <= 0) cus = 256;
        if (hipFuncSetAttribute((const void*)fwd_kernel, hipFuncAttributeMaxDynamicSharedMemorySize, LDS_BYTES) != hipSuccess) { fprintf(stderr, "kernel_launch: hipFuncSetAttribute failed\n"); grid = -1; return; }
        int per_cu = 0;
        if (hipOccupancyMaxActiveBlocksPerMultiprocessor(&per_cu, (const void*)fwd_kernel, 512, LDS_BYTES) != hipSuccess || per_cu < 1) { fprintf(stderr, "kernel_launch: occupancy query says %d\n", per_cu); (void)hipGetLastError(); }
        grid = cus;
    }
    if (grid < 0) return;
    Args a{};
    for (int i = 0; i < 14; ++i) a.in[i] = (const float*)d_in[i];
    a.out = (float*)d_out; a.ws = (unsigned char*)d_ws;
#if MK_COOP
    a.ph_lo = 0; a.ph_hi = NPHASE; a.coop = 1;
    void* args[] = {&a};
    hipError_t e = hipLaunchCooperativeKernel((const void*)fwd_kernel, dim3(grid), dim3(512), args, LDS_BYTES, stream);
    if (e != hipSuccess) fprintf(stderr, "cooperative launch failed: %s (grid %d)\n", hipGetErrorString(e), grid);
#else
    for (int ph = 0; ph < NPHASE; ++ph) {
        a.ph_lo = ph; a.ph_hi = ph + 1; a.coop = 0;
        hipLaunchKernelGGL(fwd_kernel, dim3(grid), dim3(512), LDS_BYTES, stream, a);
    }
#endif
}
```

```cpp
#include <hip/hip_runtime.h>
#include <hip/hip_cooperative_groups.h>
#include <cstdio>
#include <cstdint>
namespace cg = cooperative_groups;

#ifndef PHMASK
#define PHMASK 127
#endif
#ifndef MK_COOP
#define MK_COOP 1
#endif

#define LAS __attribute__((address_space(3)))
typedef unsigned short bf16_t;
typedef short bf16x8 __attribute__((ext_vector_type(8)));
typedef short s16x4 __attribute__((ext_vector_type(4)));
typedef short v4i16_t __attribute__((ext_vector_type(4)));
typedef float f32x4 __attribute__((ext_vector_type(4)));
typedef float f32x16 __attribute__((ext_vector_type(16)));
typedef unsigned u32x4 __attribute__((ext_vector_type(4)));
typedef unsigned u32x2 __attribute__((ext_vector_type(2)));

constexpr int DM = 1024, NB = 16, SEQ = 2048, CTXL = 256, DEPTH = 4, NCOL = 5376;
constexpr int TL = NB * SEQ, TC = NB * CTXL, TT = TL + TC;
constexpr int C_B = 0, C_C = 512, C_U = 1024, C_ZA = 1536, C_Q = 2048, C_K = 2560, C_V = 2688, C_ZB = 2816, C_GA = 3328, C_GB = 4352;
constexpr float RMS_EPS = 1e-6f;
constexpr float LOG2E = 1.4426950408889634f;
constexpr float QSCALE = 0.125f * LOG2E;

constexpr size_t MiB = 1u << 20;
constexpr size_t WS_WIN_T = 1 * MiB;
constexpr size_t WS_WAB_T = 12 * MiB;
constexpr size_t WS_WO_T = 20 * MiB;
constexpr size_t WS_MOD = 28 * MiB;
constexpr size_t WS_NW1 = 29 * MiB;
constexpr size_t WS_SB = 30 * MiB;
constexpr size_t WS_ROPE = 32 * MiB;
constexpr size_t WS_SSP = 33 * MiB;
constexpr size_t WS_XCTX = 36 * MiB;
constexpr size_t WS_XS = 52 * MiB;
constexpr size_t WS_P = 124 * MiB;
constexpr size_t WS_END = WS_P + (size_t)TT * NCOL * 2;
static_assert(WS_END <= 502 * MiB, "ws map");

constexpr int LDS_BYTES = 131072 + 1024;
constexpr int NPHASE = 2 + 4 * DEPTH + 1;

struct Args { const float* in[14]; float* out; unsigned char* ws; int ph_lo, ph_hi, coop, pad; };

__device__ __forceinline__ unsigned cvt_pk_bf16(float lo, float hi) { unsigned r; asm volatile("v_cvt_pk_bf16_f32 %0, %1, %2" : "=v"(r) : "v"(lo), "v"(hi)); return r; }
__device__ __forceinline__ float bf_lo(unsigned w) { return __uint_as_float(w << 16); }
__device__ __forceinline__ float bf_hi(unsigned w) { return __uint_as_float(w & 0xffff0000u); }
__device__ __forceinline__ float fast_exp(float x) { return __builtin_amdgcn_exp2f(x * LOG2E); }
__device__ __forceinline__ float sigmoidf_(float x) { return __builtin_amdgcn_rcpf(1.0f + fast_exp(-x)); }
__device__ __forceinline__ float siluf_(float x) { return x * sigmoidf_(x); }
__device__ __forceinline__ float wave_sum(float v) {
#pragma unroll
    for (int o = 1; o < 64; o <<= 1) v += __shfl_xor(v, o);
    return v;
}
#define LDS_WAIT() asm volatile("s_waitcnt lgkmcnt(0)" ::: "memory")
#define VM_WAIT() asm volatile("s_waitcnt vmcnt(0)" ::: "memory")

namespace pg8 {
constexpr int BM = 256, BK = 64, HALF = 128, HTB = HALF * BK * 2, STAGE_BYTES = 8 * HTB, NXCD = 8, WGM = 8;
__host__ __device__ __forceinline__ int lds_byte(int r, int c) { const int st = (r >> 4) * 2 + (c >> 5), rr = r & 15, cc = c & 31, ob = rr * 64 + cc * 2; return st * 1024 + (ob ^ (((ob >> 9) & 1) << 5)); }
__host__ __device__ __forceinline__ void stage_rc(int b, int& R, int& C) { const int st = b / 1024, sb = b % 1024, swz = sb ^ (((sb >> 9) & 1) << 5); R = (st >> 1) * 16 + swz / 64; C = (st & 1) * 32 + (swz % 64) / 2; }
__host__ __device__ __forceinline__ int perm32(int rho) { const int n = rho >> 4, i = rho & 15; return 8 * (i >> 2) + 4 * n + (i & 3); }

struct Unit { int pm, pn; };
struct Gemm { const bf16_t* A; const bf16_t* Bt; int lda; int K; };

struct Order {
    int nM, nN, nwg, G, c, nextra, extra_pm0, extra_pn;
    __device__ void init(int nM_, int nN_, int G_, int c_, int nextra_ = 0, int epm0 = 0, int epn = 0) { nM = nM_; nN = nN_; nwg = nM * nN; G = G_; c = c_; nextra = nextra_; extra_pm0 = epm0; extra_pn = epn; }
    __device__ bool next(int i, Unit& u) const {
        const long L = (long)i * G + c; if (L >= nwg + nextra) return false;
        if (L >= nwg) { u.pm = extra_pm0 + (int)(L - nwg); u.pn = extra_pn; return true; }
        int wgid = (int)L; { const int q = nwg / NXCD, r = nwg % NXCD, xcd = wgid % NXCD, off = wgid / NXCD; wgid = (xcd < r ? xcd * (q + 1) : r * (q + 1) + (xcd - r) * q) + off; }
        const int nig = WGM * nN, gid = wgid / nig, fm = gid * WGM, gsz = (nM - fm) < WGM ? (nM - fm) : WGM;
        u.pm = fm + ((wgid % nig) % gsz); u.pn = (wgid % nig) / gsz; return true;
    }
};

template <class Epi, class Sched, bool ALIGN_EPI>
__device__ __forceinline__ void gemm_phase(LAS unsigned char* lds, const Gemm g, const Sched& S, const Epi& E) {
    int tid = threadIdx.x; asm volatile("" : "+v"(tid));
    const int wid = __builtin_amdgcn_readfirstlane(tid >> 6), lane = tid & 63, wr = wid >> 2, wc = wid & 3, fr = lane & 15, fq = lane >> 4;
    const int K = g.K, nt = K / BK, lda = g.lda;
    unsigned voffA[2], voffB[2];
#pragma unroll
    for (int i = 0; i < 2; ++i) { int R, C; stage_rc(tid * 16 + i * 8192, R, C); const int Rb = Epi::PERM ? ((R & ~31) + perm32(R & 31)) : R;
        voffA[i] = (unsigned)(R * lda + C) * 2u; voffB[i] = (unsigned)(Rb * K + C) * 2u; }
    const size_t kstep = (size_t)(BK * 2);
    const size_t hstepA = (size_t)HALF * lda * 2, tstepA = 2 * hstepA;
    const size_t hstepB = (size_t)HALF * K * 2, tstepB = 2 * hstepB;
    const unsigned ldsw = (unsigned)wid * 1024u;
    const int aoff = lds_byte(wr * 64 + fr, fq * 8), boff = lds_byte(wc * 32 + fr, fq * 8);
#define PG8_SA(b, h) (((b) * 2 + (h)) * HTB)
#define PG8_SB(b, h) ((4 + (b) * 2 + (h)) * HTB)
#define PG8_STAGE(bufoff, gbase, voff) do { _Pragma("unroll") for (int _i = 0; _i < 2; ++_i) \
        __builtin_amdgcn_global_load_lds((const unsigned*)((const char*)(gbase) + (voff)[_i]), (LAS unsigned*)(lds + (bufoff) + ldsw + _i * 8192), 16, 0, 0); } while (0)
#define PG8_LDA(dst, b, h) do { _Pragma("unroll") for (int m = 0; m < 4; ++m) _Pragma("unroll") for (int k = 0; k < 2; ++k) dst[m][k] = *(const LAS bf16x8*)(lds + PG8_SA(b, h) + aoff + m * 2048 + k * 1024); } while (0)
#define PG8_LDB(dst, b, h) do { _Pragma("unroll") for (int n = 0; n < 2; ++n) _Pragma("unroll") for (int k = 0; k < 2; ++k) dst[n][k] = *(const LAS bf16x8*)(lds + PG8_SB(b, h) + boff + n * 2048 + k * 1024); } while (0)
#define PG8_MMA(ai, bj, At, Bt) do { __builtin_amdgcn_s_setprio(1); _Pragma("unroll") for (int m = 0; m < 4; ++m) _Pragma("unroll") for (int n = 0; n < 2; ++n) _Pragma("unroll") for (int k = 0; k < 2; ++k) \
        acc[ai][bj][m][n] = __builtin_amdgcn_mfma_f32_16x16x32_bf16(Bt[n][k], At[m][k], acc[ai][bj][m][n], 0, 0, 0); __builtin_amdgcn_s_setprio(0); } while (0)
#define PG8_WAIT_V(n) asm volatile("s_waitcnt vmcnt(" #n ")" ::: "memory")
#define PG8_WAIT_L(n) asm volatile("s_waitcnt lgkmcnt(" #n ")" ::: "memory")
#define PG8_BAR __builtin_amdgcn_s_barrier()
#define PG8_SCHED __builtin_amdgcn_sched_barrier(0)
    Unit cur, nxt; int ui = 0;
    if (!S.next(0, cur)) return;
    f32x4 acc[2][2][4][2];
#pragma unroll
    for (int a = 0; a < 2; ++a)
#pragma unroll
        for (int b = 0; b < 2; ++b)
#pragma unroll
            for (int m = 0; m < 4; ++m)
#pragma unroll
                for (int n = 0; n < 2; ++n) acc[a][b][m][n] = (f32x4){0.f, 0.f, 0.f, 0.f};
    bf16x8 At[4][2], B0[2][2], B1[2][2];
    const char* cA = (const char*)g.A + (size_t)cur.pm * tstepA; const char* cB = (const char*)g.Bt + (size_t)cur.pn * tstepB;
    PG8_STAGE(PG8_SB(0, 0), cB, voffB); PG8_STAGE(PG8_SB(0, 1), cB + hstepB, voffB); PG8_STAGE(PG8_SA(0, 0), cA, voffA); PG8_STAGE(PG8_SA(0, 1), cA + hstepA, voffA);
    if (wr == 1) PG8_BAR;
    PG8_WAIT_V(2); PG8_BAR;
    PG8_STAGE(PG8_SB(1, 0), cB + kstep, voffB); PG8_STAGE(PG8_SA(1, 0), cA + kstep, voffA); PG8_STAGE(PG8_SB(1, 1), cB + hstepB + kstep, voffB);
    PG8_WAIT_V(6); PG8_BAR;
    for (;;) {
        const bool has_next = S.next(ui + 1, nxt);
        const char* nA = has_next ? (const char*)g.A + (size_t)nxt.pm * tstepA : cA; const char* nB = has_next ? (const char*)g.Bt + (size_t)nxt.pn * tstepB : cB;
        for (int t = 0; t < nt; t += 2) {
            if constexpr (Epi::HOOK) { if (t == (nt >> 1)) E.mid(acc, cur, wr, wc, fr, fq); }
            const bool last = (t == nt - 2);
            const char* a1 = cA + (size_t)(t + 1) * kstep;
            const char* a2 = last ? nA : cA + (size_t)(t + 2) * kstep; const char* b2 = last ? nB : cB + (size_t)(t + 2) * kstep;
            const char* a3 = a2 + kstep; const char* b3 = b2 + kstep;
            PG8_LDB(B0, 0, 0); PG8_LDB(B1, 0, 1); PG8_SCHED; PG8_LDA(At, 0, 0); PG8_STAGE(PG8_SA(1, 1), a1 + hstepA, voffA);
            PG8_WAIT_V(8); PG8_WAIT_L(0); PG8_BAR; PG8_MMA(0, 0, At, B0); PG8_MMA(0, 1, At, B1); PG8_BAR; PG8_SCHED;
            PG8_LDA(At, 0, 1); PG8_STAGE(PG8_SB(0, 0), b2, voffB); PG8_STAGE(PG8_SB(0, 1), b2 + hstepB, voffB); PG8_STAGE(PG8_SA(0, 0), a2, voffA);
            PG8_WAIT_V(8); PG8_WAIT_L(0); PG8_BAR; PG8_MMA(1, 0, At, B0); PG8_MMA(1, 1, At, B1); PG8_BAR; PG8_SCHED;
            PG8_LDB(B0, 1, 0); PG8_LDB(B1, 1, 1); PG8_SCHED; PG8_LDA(At, 1, 0); PG8_STAGE(PG8_SA(0, 1), a2 + hstepA, voffA);
            PG8_WAIT_V(8); PG8_WAIT_L(0); PG8_BAR; PG8_MMA(0, 0, At, B0); PG8_MMA(0, 1, At, B1); PG8_BAR; PG8_SCHED;
            PG8_LDA(At, 1, 1); PG8_STAGE(PG8_SB(1, 0), b3, voffB); PG8_STAGE(PG8_SB(1, 1), b3 + hstepB, voffB); PG8_STAGE(PG8_SA(1, 0), a3, voffA);
            PG8_WAIT_V(8); PG8_WAIT_L(0); PG8_BAR; PG8_MMA(1, 0, At, B0); PG8_MMA(1, 1, At, B1); PG8_BAR; PG8_SCHED;
        }
        if constexpr (ALIGN_EPI) { if (wr == 0) PG8_BAR; }
        E(acc, cur, wr, wc, fr, fq);
        if (!has_next) break;
#pragma unroll
        for (int a = 0; a < 2; ++a)
#pragma unroll
            for (int b = 0; b < 2; ++b)
#pragma unroll
                for (int m = 0; m < 4; ++m)
#pragma unroll
                    for (int n = 0; n < 2; ++n) acc[a][b][m][n] = (f32x4){0.f, 0.f, 0.f, 0.f};
        cur = nxt; cA = nA; cB = nB; ++ui;
        if constexpr (ALIGN_EPI) { if (wr == 1) PG8_BAR; }
    }
    PG8_WAIT_V(0);
    if constexpr (!ALIGN_EPI) { if (wr == 0) PG8_BAR; }
    PG8_BAR;
#undef PG8_SA
#undef PG8_SB
#undef PG8_STAGE
#undef PG8_LDA
#undef PG8_LDB
#undef PG8_MMA
#undef PG8_WAIT_V
#undef PG8_WAIT_L
#undef PG8_BAR
#undef PG8_SCHED
}
}

struct EpiG1 {
    static constexpr bool PERM = false, HOOK = false;
    bf16_t* P; const float* ssp; const float* sb; const float* ropec; const float* ropes;
    __device__ __forceinline__ void mid(f32x4 (&)[2][2][4][2], const pg8::Unit&, int, int, int, int) const {}
    __device__ __forceinline__ void operator()(const f32x4 (&acc)[2][2][4][2], const pg8::Unit& u, int wr, int wc, int fr, int fq) const {
        const bool latent = u.pm < 128;
        const int bidx = latent ? (u.pm >> 3) : 16;
        const int col0 = u.pn * 256 + wc * 32 + 4 * fq;
        const float* sbr = sb + bidx * NCOL + col0;
        f32x4 bv[2][2];
#pragma unroll
        for (int bj = 0; bj < 2; ++bj)
#pragma unroll
            for (int n = 0; n < 2; ++n) bv[bj][n] = *(const f32x4*)(sbr + bj * 128 + n * 16);
        const bool isq = (u.pn == 8 || u.pn == 9), isk = (u.pn == 10);
        const bool anyrope = latent && (isq || isk);
        const float sc = isq ? QSCALE : 1.0f;
#pragma unroll
        for (int ai = 0; ai < 2; ++ai)
#pragma unroll
            for (int m = 0; m < 4; ++m) {
                const int row = u.pm * 256 + ai * 128 + wr * 64 + m * 16 + fr;
                const f32x4* sp = (const f32x4*)(ssp + (size_t)row * 16);
                const f32x4 s4 = (sp[0] + sp[1]) + (sp[2] + sp[3]);
                const float ss = (s4[0] + s4[1]) + (s4[2] + s4[3]);
                const float rinv = 1.0f / sqrtf(ss * (1.0f / 1024.0f) + RMS_EPS);
                f32x4 cs = (f32x4){1.f, 1.f, 1.f, 1.f}, sn = (f32x4){0.f, 0.f, 0.f, 0.f};
                if (anyrope) { const int t = row & 2047; const int pos = (wc & 1) ? (t & 63) : (t >> 6);
                    cs = *(const f32x4*)(ropec + pos * 16 + 4 * fq); sn = *(const f32x4*)(ropes + pos * 16 + 4 * fq); }
                bf16_t* rowp = P + (size_t)row * NCOL + col0;
#pragma unroll
                for (int bj = 0; bj < 2; ++bj) {
                    f32x4 v0 = acc[ai][bj][m][0] * rinv + bv[bj][0], v1 = acc[ai][bj][m][1] * rinv + bv[bj][1];
                    const bool rp = anyrope && (isq || bj == 0);
                    if (rp) { const f32x4 a = v0 * cs - v1 * sn, b = v1 * cs + v0 * sn; v0 = a; v1 = b; }
                    v0 = v0 * sc; v1 = v1 * sc;
                    u32x2 w0, w1; w0.x = cvt_pk_bf16(v0[0], v0[1]); w0.y = cvt_pk_bf16(v0[2], v0[3]); w1.x = cvt_pk_bf16(v1[0], v1[1]); w1.y = cvt_pk_bf16(v1[2], v1[3]);
                    *(u32x2*)(rowp + bj * 128) = w0; *(u32x2*)(rowp + bj * 128 + 16) = w1;
                }
            }
    }
};

struct EpiG2 {
    static constexpr bool PERM = true, HOOK = true;
    bf16_t* P;
    __device__ __forceinline__ void mid(f32x4 (&acc)[2][2][4][2], const pg8::Unit& u, int wr, int wc, int fr, int fq) const {
        int col8 = u.pn * 256 + wc * 32 + 8 * fq, rbase = u.pm * 256 + wr * 64 + fr;
        asm volatile("" : "+v"(col8), "+v"(rbase));
#pragma unroll
        for (int ai = 0; ai < 2; ++ai)
#pragma unroll
            for (int m = 0; m < 4; ++m) {
                const int row = rbase + ai * 128 + m * 16;
                const bf16_t* rowp = P + (size_t)row * NCOL + col8;
#pragma unroll
                for (int bj = 0; bj < 2; ++bj) {
                    const u32x4 ga = *(const u32x4*)(rowp + C_GA + bj * 128), gb = *(const u32x4*)(rowp + C_GB + bj * 128);
#pragma unroll
                    for (int w = 0; w < 4; ++w) {
                        const float a0 = bf_lo(ga[w]), a1 = bf_hi(ga[w]), b0 = bf_lo(gb[w]), b1 = bf_hi(gb[w]);
                        const float r0 = (1.0f + fast_exp(-b0)) * __builtin_amdgcn_rcpf(1.0f + fast_exp(-a0));
                        const float r1 = (1.0f + fast_exp(-b1)) * __builtin_amdgcn_rcpf(1.0f + fast_exp(-a1));
                        acc[ai][bj][m][w >> 1][(w & 1) * 2] *= r0; acc[ai][bj][m][w >> 1][(w & 1) * 2 + 1] *= r1;
                    }
                }
                asm volatile("" ::: "memory");
            }
    }
    __device__ __forceinline__ void operator()(const f32x4 (&acc)[2][2][4][2], const pg8::Unit& u, int wr, int wc, int fr, int fq) const {
        const int col8 = u.pn * 256 + wc * 32 + 8 * fq;
#pragma unroll
        for (int ai = 0; ai < 2; ++ai)
#pragma unroll
            for (int m = 0; m < 4; ++m) {
                const int row = u.pm * 256 + ai * 128 + wr * 64 + m * 16 + fr;
                bf16_t* rowp = P + (size_t)row * NCOL + col8;
#pragma unroll
                for (int bj = 0; bj < 2; ++bj) {
                    const u32x4 gb = *(const u32x4*)(rowp + C_GB + bj * 128);
                    u32x4 o;
#pragma unroll
                    for (int w = 0; w < 4; ++w) {
                        const float s0 = sigmoidf_(bf_lo(gb[w])), s1 = sigmoidf_(bf_hi(gb[w]));
                        o[w] = cvt_pk_bf16(acc[ai][bj][m][w >> 1][(w & 1) * 2] * s0, acc[ai][bj][m][w >> 1][(w & 1) * 2 + 1] * s1);
                    }
                    *(u32x4*)(rowp + C_GA + bj * 128) = o;
                }
                asm volatile("" ::: "memory");
            }
    }
};

struct EpiG3 {
    static constexpr bool PERM = false, HOOK = false;
    const float* xin_lat; const float* xin_ctx; float* xout_lat; float* xout_ctx; const float* gate; const float* nw; bf16_t* xs; float* ssp;
    __device__ __forceinline__ void mid(f32x4 (&)[2][2][4][2], const pg8::Unit&, int, int, int, int) const {}
    __device__ __forceinline__ void operator()(const f32x4 (&acc)[2][2][4][2], const pg8::Unit& u, int wr, int wc, int fr, int fq) const {
        const bool latent = u.pm < 128;
        const int bidx = latent ? (u.pm >> 3) : 16;
        const int col0 = u.pn * 256 + wc * 32 + 4 * fq;
        f32x4 gv[2][2], nv[2][2];
#pragma unroll
        for (int bj = 0; bj < 2; ++bj)
#pragma unroll
            for (int n = 0; n < 2; ++n) { gv[bj][n] = *(const f32x4*)(gate + bidx * 3072 + col0 + bj * 128 + n * 16);
                nv[bj][n] = nw ? *(const f32x4*)(nw + bidx * 1024 + col0 + bj * 128 + n * 16) : (f32x4){0.f, 0.f, 0.f, 0.f}; }
#pragma unroll
        for (int ai = 0; ai < 2; ++ai)
#pragma unroll
            for (int m = 0; m < 4; ++m) {
                const int row = u.pm * 256 + ai * 128 + wr * 64 + m * 16 + fr;
                const float* xi = latent ? xin_lat + (size_t)row * DM : xin_ctx + (size_t)(row - TL) * DM;
                float* xo = latent ? xout_lat + (size_t)row * DM : xout_ctx + (size_t)(row - TL) * DM;
                float q = 0.f;
#pragma unroll
                for (int bj = 0; bj < 2; ++bj)
#pragma unroll
                    for (int n = 0; n < 2; ++n) {
                        const int off = col0 + bj * 128 + n * 16;
                        const f32x4 xv = *(const f32x4*)(xi + off);
                        const f32x4 xn = xv + gv[bj][n] * acc[ai][bj][m][n];
                        *(f32x4*)(xo + off) = xn;
                        q += (xn[0] * xn[0] + xn[1] * xn[1]) + (xn[2] * xn[2] + xn[3] * xn[3]);
                        if (nw) { const f32x4 h = xn * nv[bj][n]; u32x2 w; w.x = cvt_pk_bf16(h[0], h[1]); w.y = cvt_pk_bf16(h[2], h[3]); *(u32x2*)(xs + (size_t)row * DM + off) = w; }
                    }
                q += __shfl_xor(q, 16); q += __shfl_xor(q, 32);
                if (fq == 0) ssp[(size_t)row * 16 + u.pn * 4 + wc] = q;
            }
    }
};

__device__ __forceinline__ s16x4 vtr(const LAS unsigned char* p) { return __builtin_bit_cast(s16x4, __builtin_amdgcn_ds_read_tr16_b64_v4i16((LAS v4i16_t*)p)); }

__device__ __forceinline__ void attn_unit(LAS unsigned char* lds, bf16_t* P, int rowQ0, int h, int kh, int qq0, int nloc, int jlo, int keyrow_loc0, int keyrow_ctx0, float sink_l2) {
    int tid = threadIdx.x; asm volatile("" : "+v"(tid));
    const int lane = tid & 63, r32 = lane & 31, hi = lane >> 5;
    const int wid = __builtin_amdgcn_readfirstlane(tid >> 6);
    const int NT = nloc + 4;
    const size_t koff = (size_t)lane * NCOL + C_K + kh * 64 + wid * 8;
    const size_t voff = (size_t)(16 * (wid & 3) + (lane >> 2)) * NCOL + C_V + kh * 64 + (wid >> 2) * 32 + (lane & 3) * 8;
#define AT_STAGE(tt, buf) do { const int kr0_ = ((tt) < nloc) ? keyrow_loc0 + 64 * (jlo + (tt)) : keyrow_ctx0 + 64 * ((tt) - nloc); const bf16_t* tb_ = P + (size_t)kr0_ * NCOL; \
        __builtin_amdgcn_global_load_lds((const unsigned*)(tb_ + koff), (LAS unsigned*)(lds + (buf) * 16384 + wid * 1024), 16, 0, 0); \
        __builtin_amdgcn_global_load_lds((const unsigned*)(tb_ + voff), (LAS unsigned*)(lds + (buf) * 16384 + 8192 + wid * 1024), 16, 0, 0); } while (0)
    AT_STAGE(0, 0);
    bf16x8 qr[4];
    const size_t rowoff = (size_t)(rowQ0 + r32) * NCOL;
    {
        const bf16_t* qp = P + rowoff + C_Q + h * 64 + hi * 8;
#pragma unroll
        for (int d0 = 0; d0 < 4; ++d0) qr[d0] = *(const bf16x8*)(qp + d0 * 16);
    }
    f32x16 o0, o1;
#pragma unroll
    for (int i = 0; i < 16; ++i) { o0[i] = 0.f; o1[i] = 0.f; }
    float mrun = sink_l2, lrun = hi ? 0.f : 1.f;
    const int qq = qq0 + r32;
    VM_WAIT(); __syncthreads();
    for (int tt = 0; tt < NT; ++tt) {
        const int buf = tt & 1;
        if (tt + 1 < NT) AT_STAGE(tt + 1, buf ^ 1);
        const LAS unsigned char* kb = lds + buf * 16384 + hi * 1024 + r32 * 16;
        f32x16 p0, p1;
#pragma unroll
        for (int i = 0; i < 16; ++i) { p0[i] = 0.f; p1[i] = 0.f; }
#pragma unroll
        for (int d0 = 0; d0 < 4; ++d0) {
            const bf16x8 b0 = *(const LAS bf16x8*)(kb + d0 * 2048);
            const bf16x8 b1 = *(const LAS bf16x8*)(kb + d0 * 2048 + 512);
            p0 = __builtin_amdgcn_mfma_f32_32x32x16_bf16(b0, qr[d0], p0, 0, 0, 0);
            p1 = __builtin_amdgcn_mfma_f32_32x32x16_bf16(b1, qr[d0], p1, 0, 0, 0);
        }
        if (tt < nloc) {
            const int j = jlo + tt;
            if (j < 2) {
                const int lim = qq - 64 * j;
#pragma unroll
                for (int i = 0; i < 16; ++i) { const int kk = (i & 3) + 8 * (i >> 2) + 4 * hi; if (kk < lim) p0[i] = -1e30f; if (kk + 32 < lim) p1[i] = -1e30f; }
            } else if (j >= 4) {
                const int lim = qq - 64 * (j - 4);
#pragma unroll
                for (int i = 0; i < 16; ++i) { const int kk = (i & 3) + 8 * (i >> 2) + 4 * hi; if (kk > lim) p0[i] = -1e30f; if (kk + 32 > lim) p1[i] = -1e30f; }
            }
        }
        float rm = fmaxf(p0[0], p1[0]);
#pragma unroll
        for (int i = 1; i < 16; ++i) rm = fmaxf(rm, fmaxf(p0[i], p1[i]));
        rm = fmaxf(rm, __shfl_xor(rm, 32));
        const float mn = fmaxf(mrun, rm);
        const float f = __builtin_amdgcn_exp2f(mrun - mn);
        mrun = mn;
        float ps = 0.f;
#pragma unroll
        for (int i = 0; i < 16; ++i) { p0[i] = __builtin_amdgcn_exp2f(p0[i] - mn); p1[i] = __builtin_amdgcn_exp2f(p1[i] - mn); ps += p0[i] + p1[i]; }
        lrun = lrun * f + ps;
#pragma unroll
        for (int i = 0; i < 16; ++i) { o0[i] *= f; o1[i] *= f; }
        u32x4 pw[4];
#pragma unroll
        for (int w = 0; w < 4; ++w) { pw[0][w] = cvt_pk_bf16(p0[2 * w], p0[2 * w + 1]); pw[1][w] = cvt_pk_bf16(p0[8 + 2 * w], p0[8 + 2 * w + 1]);
            pw[2][w] = cvt_pk_bf16(p1[2 * w], p1[2 * w + 1]); pw[3][w] = cvt_pk_bf16(p1[8 + 2 * w], p1[8 + 2 * w + 1]); }
        const LAS unsigned char* vp = lds + buf * 16384 + 8192 + ((lane >> 4) & 1) * 32 + (lane & 3) * 8 + (4 * hi + ((lane & 15) >> 2)) * 64;
#pragma unroll
        for (int s = 0; s < 4; ++s) {
            const s16x4 l0 = vtr(vp + s * 1024), h0 = vtr(vp + s * 1024 + 512);
            const s16x4 l1 = vtr(vp + 4096 + s * 1024), h1 = vtr(vp + 4096 + s * 1024 + 512);
            const bf16x8 v0 = (bf16x8){l0[0], l0[1], l0[2], l0[3], h0[0], h0[1], h0[2], h0[3]};
            const bf16x8 v1 = (bf16x8){l1[0], l1[1], l1[2], l1[3], h1[0], h1[1], h1[2], h1[3]};
            const bf16x8 pa = __builtin_bit_cast(bf16x8, pw[s]);
            o0 = __builtin_amdgcn_mfma_f32_32x32x16_bf16(v0, pa, o0, 0, 0, 0);
            o1 = __builtin_amdgcn_mfma_f32_32x32x16_bf16(v1, pa, o1, 0, 0, 0);
        }
        VM_WAIT(); __syncthreads();
    }
#undef AT_STAGE
    lrun += __shfl_xor(lrun, 32);
    const float inv = 1.0f / lrun;
    bf16_t* op = P + rowoff + h * 64 + 4 * hi;
#pragma unroll
    for (int d0 = 0; d0 < 2; ++d0)
#pragma unroll
        for (int gq = 0; gq < 4; ++gq) {
            const int d = d0 * 32 + 8 * gq;
            const u32x2 z = *(const u32x2*)(op + C_ZB + d);
            const float z0 = bf_lo(z.x), z1 = bf_hi(z.x), z2 = bf_lo(z.y), z3 = bf_hi(z.y);
            const float a0 = (d0 ? o1[4 * gq + 0] : o0[4 * gq + 0]) * inv * siluf_(z0);
            const float a1 = (d0 ? o1[4 * gq + 1] : o0[4 * gq + 1]) * inv * siluf_(z1);
            const float a2 = (d0 ? o1[4 * gq + 2] : o0[4 * gq + 2]) * inv * siluf_(z2);
            const float a3 = (d0 ? o1[4 * gq + 3] : o0[4 * gq + 3]) * inv * siluf_(z3);
            u32x2 w; w.x = cvt_pk_bf16(a0, a1); w.y = cvt_pk_bf16(a2, a3);
            *(u32x2*)(op + C_Q + d) = w;
        }
}

struct V8 { f32x4 a, b; };
__device__ __forceinline__ V8 ld8(const bf16_t* p) { const u32x4 w = *(const u32x4*)p; V8 r; r.a = (f32x4){bf_lo(w.x), bf_hi(w.x), bf_lo(w.y), bf_hi(w.y)}; r.b = (f32x4){bf_lo(w.z), bf_hi(w.z), bf_lo(w.w), bf_hi(w.w)}; return r; }
__device__ __forceinline__ V8 cu_at(const bf16_t* P, int t, int c0) { const V8 c = ld8(P + (size_t)t * NCOL + C_C + c0), u = ld8(P + (size_t)t * NCOL + C_U + c0); V8 r; r.a = c.a * u.a; r.b = c.b * u.b; return r; }
__device__ __forceinline__ void conv_run(bf16_t* P, const float* cw, int run, int lane) {
    const int row0 = run * 16;
    int s0, s1; if (row0 < TL) { s0 = row0 & ~2047; s1 = s0 + 2048; } else { s0 = TL + ((row0 - TL) & ~255); s1 = s0 + 256; }
    const int c0 = lane * 8;
    const f32x4 w0a = *(const f32x4*)(cw + c0), w0b = *(const f32x4*)(cw + c0 + 4);
    const f32x4 w1a = *(const f32x4*)(cw + 512 + c0), w1b = *(const f32x4*)(cw + 512 + c0 + 4);
    const f32x4 w2a = *(const f32x4*)(cw + 1024 + c0), w2b = *(const f32x4*)(cw + 1024 + c0 + 4);
    const f32x4 z4 = (f32x4){0.f, 0.f, 0.f, 0.f};
    V8 prev, cur; prev.a = z4; prev.b = z4;
    if (row0 - 1 >= s0) prev = cu_at(P, row0 - 1, c0);
    cur = cu_at(P, row0, c0);
    for (int i = 0; i < 16; ++i) {
        const int t = row0 + i;
        V8 nxt; nxt.a = z4; nxt.b = z4;
        if (t + 1 < s1) nxt = cu_at(P, t + 1, c0);
        const f32x4 ca = w0a * prev.a + w1a * cur.a + w2a * nxt.a, cb = w0b * prev.b + w1b * cur.b + w2b * nxt.b;
        const V8 bg = ld8(P + (size_t)t * NCOL + C_B + c0), z = ld8(P + (size_t)t * NCOL + C_ZA + c0);
        f32x4 ya, yb;
#pragma unroll
        for (int e = 0; e < 4; ++e) { ya[e] = bg.a[e] * ca[e] * siluf_(z.a[e]); yb[e] = bg.b[e] * cb[e] * siluf_(z.b[e]); }
        u32x4 w; w.x = cvt_pk_bf16(ya[0], ya[1]); w.y = cvt_pk_bf16(ya[2], ya[3]); w.z = cvt_pk_bf16(yb[0], yb[1]); w.w = cvt_pk_bf16(yb[2], yb[3]);
        *(u32x4*)(P + (size_t)t * NCOL + C_ZA + c0) = w;
        prev = cur; cur = nxt;
    }
}

__device__ __forceinline__ void transpose_item(const float* W, int ldw, bf16_t* WT, int ldo, int koff, int nblk, LAS float* scr, int item, int lane) {
    const int kb = item / nblk, nb = item % nblk, k0 = 64 * kb, n0 = 32 * nb;
#pragma unroll 8
    for (int i = 0; i < 32; ++i) { const int kk = 2 * i + (lane >> 5); scr[kk * 33 + (lane & 31)] = W[(size_t)(k0 + kk) * ldw + n0 + (lane & 31)]; }
    LDS_WAIT(); asm volatile("" ::: "memory");
    const int c = lane & 7;
#pragma unroll
    for (int j = 0; j < 4; ++j) { const int n = (lane >> 3) + 8 * j; const LAS float* s = scr + (8 * c) * 33 + n;
        u32x4 o; o.x = cvt_pk_bf16(s[0 * 33], s[1 * 33]); o.y = cvt_pk_bf16(s[2 * 33], s[3 * 33]); o.z = cvt_pk_bf16(s[4 * 33], s[5 * 33]); o.w = cvt_pk_bf16(s[6 * 33], s[7 * 33]);
        *(u32x4*)(WT + (size_t)(n0 + n) * ldo + koff + k0 + 8 * c) = o; }
    LDS_WAIT(); asm volatile("" ::: "memory");
}

__device__ __forceinline__ void rowmat17_item(int tid, LAS unsigned char* lds, const float* W, int ldw, int col0, const float* bias, float* out, int ldo) {
    const int lane = tid & 63, wid = tid >> 6;
    const LAS float* tab = (const LAS float*)lds;
    LAS float* part = (LAS float*)(lds + 17 * 1024 * 4);
    float acc[17];
#pragma unroll
    for (int r = 0; r < 17; ++r) acc[r] = 0.f;
    const float* wp = W + (size_t)(wid * 128) * ldw + col0 + lane;
#pragma unroll 2
    for (int k = 0; k < 128; k += 4) {
        const float w0 = wp[(size_t)(k + 0) * ldw], w1 = wp[(size_t)(k + 1) * ldw], w2 = wp[(size_t)(k + 2) * ldw], w3 = wp[(size_t)(k + 3) * ldw];
#pragma unroll
        for (int r = 0; r < 17; ++r) { const f32x4 t = *(const LAS f32x4*)(tab + r * 1024 + wid * 128 + k); acc[r] += (t[0] * w0 + t[1] * w1) + (t[2] * w2 + t[3] * w3); }
    }
#pragma unroll
    for (int r = 0; r < 17; ++r) part[(wid * 17 + r) * 64 + lane] = acc[r];
    __syncthreads();
    for (int idx = tid; idx < 17 * 64; idx += 512) { const int r = idx >> 6, e = idx & 63; float s = 0.f;
#pragma unroll
        for (int w = 0; w < 8; ++w) s += part[(w * 17 + r) * 64 + e];
        if (bias) s += bias[col0 + e];
        out[(size_t)r * ldo + col0 + e] = s; }
    __syncthreads();
}

__global__ void __launch_bounds__(512, 2) fwd_kernel(Args a) {
    extern __shared__ __attribute__((aligned(16))) unsigned char lds_raw[];
    LAS unsigned char* lds = (LAS unsigned char*)lds_raw;
    const float* x_in = a.in[0]; const float* c_in = a.in[1]; const float* ctx_in = a.in[2]; const float* cctx_in = a.in[3];
    const float* norm_w = a.in[4]; const float* w_mod = a.in[5]; const float* b_mod = a.in[6]; const float* w_in = a.in[7]; const float* conv_w = a.in[8];
    const float* w_a_out = a.in[9]; const float* w_b_out = a.in[10]; const float* attn_sink = a.in[11]; const float* w_o = a.in[12]; const float* fnorm_w = a.in[13];
    unsigned char* ws = a.ws;
    bf16_t* WIN_T = (bf16_t*)(ws + WS_WIN_T); bf16_t* WAB_T = (bf16_t*)(ws + WS_WAB_T); bf16_t* WO_T = (bf16_t*)(ws + WS_WO_T);
    float* MOD = (float*)(ws + WS_MOD); float* NW1 = (float*)(ws + WS_NW1); float* SB = (float*)(ws + WS_SB);
    float* ROPEC = (float*)(ws + WS_ROPE); float* ROPES = ROPEC + 64 * 16;
    float* SSP = (float*)(ws + WS_SSP); float* XCTX = (float*)(ws + WS_XCTX);
    bf16_t* XS = (bf16_t*)(ws + WS_XS); bf16_t* P = (bf16_t*)(ws + WS_P);
    float* OUT = a.out;

    for (int ph = a.ph_lo; ph < a.ph_hi; ++ph) {
#define PH_PROLOG int tid = threadIdx.x, bx = blockIdx.x; asm volatile("" : "+v"(tid), "+s"(bx)); const int lane = tid & 63, wave = __builtin_amdgcn_readfirstlane(tid >> 6); const int G = gridDim.x; const int gw = bx * 8 + wave, NGW = G * 8; (void)lane; (void)gw; (void)NGW;
        if (ph == 0 && (PHMASK & 1)) { PH_PROLOG
            constexpr int NMOD = DEPTH * 48;
            if (bx < NMOD) {
                LAS float* tab = (LAS float*)lds;
                for (int idx = tid; idx < 17 * 1024; idx += 512) { const int r = idx >> 10, k = idx & 1023; const float v = (r < 16) ? c_in[r * 1024 + k] : cctx_in[k]; tab[idx] = siluf_(v); }
                __syncthreads();
                for (int it = bx; it < NMOD; it += G) { const int l = it / 48, ec = it % 48;
                    rowmat17_item(tid, lds, w_mod + (size_t)l * 1024 * 3072, 3072, ec * 64, b_mod + l * 3072, MOD + (size_t)l * 17 * 3072, 3072); }
            }
            __syncthreads();
            if (bx == G - 1) { for (int idx = tid; idx < 64 * 16; idx += 512) { const int pos = idx >> 4, f = idx & 15; const float invf = powf(10000.0f, -(float)f / 16.0f); const float ang = (float)pos * invf;
                    ROPEC[idx] = cosf(ang); ROPES[idx] = sinf(ang); } }
            LAS float* scr = (LAS float*)(lds + wave * 16384);
            constexpr int I_IN = 16 * 168, I_A = 8 * 32, I_O = 16 * 32;
            constexpr int NITEMS = I_IN + DEPTH * (2 * I_A + I_O);
            for (int it = gw; it < NITEMS; it += NGW) {
                int r = it;
                if (r < I_IN) { transpose_item(w_in, NCOL, WIN_T, 1024, 0, 168, scr, r, lane); continue; } r -= I_IN;
                const int l = r / (2 * I_A + I_O); r -= l * (2 * I_A + I_O);
                if (r < I_A) { transpose_item(w_a_out + (size_t)l * 512 * 1024, 1024, WAB_T + (size_t)l * 1024 * 1024, 1024, 0, 32, scr, r, lane); continue; } r -= I_A;
                if (r < I_A) { transpose_item(w_b_out + (size_t)l * 512 * 1024, 1024, WAB_T + (size_t)l * 1024 * 1024, 1024, 512, 32, scr, r, lane); continue; } r -= I_A;
                transpose_item(w_o + (size_t)l * 1024 * 1024, 1024, WO_T + (size_t)l * 1024 * 1024, 1024, 0, 32, scr, r, lane);
            }
        } else if (ph == 1 && (PHMASK & 2)) { PH_PROLOG
            constexpr int NSB = DEPTH * 84;
            { int curl = -1;
              for (int it = bx; it < NSB; it += G) { const int l = it / 84, nc = it % 84;
                if (l != curl) { __syncthreads(); LAS float* tab = (LAS float*)lds;
                    for (int idx = tid; idx < 17 * 1024; idx += 512) { const int r = idx >> 10, k = idx & 1023; tab[idx] = MOD[((size_t)l * 17 + r) * 3072 + k]; }
                    __syncthreads(); curl = l; }
                rowmat17_item(tid, lds, w_in + (size_t)l * 1024 * NCOL, NCOL, nc * 64, nullptr, SB + (size_t)l * 17 * NCOL, NCOL); } }
            for (int idx = bx * 512 + tid; idx < DEPTH * 17 * 1024; idx += G * 512) { const int k = idx & 1023, lr = idx >> 10, l = lr / 17;
                NW1[idx] = norm_w[l * 1024 + k] * (1.0f + MOD[(size_t)lr * 3072 + 1024 + k]); }
            for (int row = gw; row < TT; row += NGW) {
                const bool lat = row < TL; const int b = lat ? (row >> 11) : 16;
                const f32x4* xr = (const f32x4*)(lat ? x_in + (size_t)row * DM : ctx_in + (size_t)(row - TL) * DM) + lane;
                const f32x4* nwp = (const f32x4*)norm_w + lane; const f32x4* scp = (const f32x4*)(MOD + (size_t)b * 3072 + 1024) + lane;
                f32x4 v[4]; float s = 0.f;
#pragma unroll
                for (int j = 0; j < 4; ++j) { v[j] = xr[64 * j]; s += (v[j][0] * v[j][0] + v[j][1] * v[j][1]) + (v[j][2] * v[j][2] + v[j][3] * v[j][3]); }
                s = wave_sum(s);
                u32x2* o8 = (u32x2*)(XS + (size_t)row * DM) + lane;
#pragma unroll
                for (int j = 0; j < 4; ++j) { const f32x4 hh = v[j] * (nwp[64 * j] * (scp[64 * j] + 1.0f)); u32x2 w; w.x = cvt_pk_bf16(hh[0], hh[1]); w.y = cvt_pk_bf16(hh[2], hh[3]); o8[64 * j] = w; }
                if (lane < 16) SSP[(size_t)row * 16 + lane] = (lane == 0) ? s : 0.f;
            }
        } else if (ph == NPHASE - 1 && (PHMASK & 4)) { PH_PROLOG
            for (int row = gw; row < TL; row += NGW) {
                float s = SSP[(size_t)row * 16 + (lane & 15)];
                s += __shfl_xor(s, 1); s += __shfl_xor(s, 2); s += __shfl_xor(s, 4); s += __shfl_xor(s, 8);
                const float rinv = 1.0f / sqrtf(s * (1.0f / 1024.0f) + RMS_EPS);
                f32x4* xr = (f32x4*)(OUT + (size_t)row * DM) + lane; const f32x4* fw = (const f32x4*)fnorm_w + lane;
#pragma unroll
                for (int j = 0; j < 4; ++j) { const f32x4 v = xr[64 * j]; xr[64 * j] = v * rinv * fw[64 * j]; }
            }
        } else {
            const int l = (ph - 2) >> 2, sub = (ph - 2) & 3;
            const bool lastl = (l == DEPTH - 1);
            if (sub == 0 && (PHMASK & 8)) { PH_PROLOG
                pg8::Gemm g{XS, WIN_T, DM, DM};
                pg8::Order S; if (!lastl) S.init(TT / 256, NCOL / 256, G, bx); else S.init(TL / 256, NCOL / 256, G, bx, NB, TL / 256, 10);
                EpiG1 E{P, SSP, SB + (size_t)l * 17 * NCOL, ROPEC, ROPES};
                pg8::gemm_phase<EpiG1, pg8::Order, true>(lds, g, S, E);
            } else if (sub == 1 && (PHMASK & 16)) { PH_PROLOG
                const float* sink = attn_sink + l * 8;
                const int nlat = 1024, nctx = lastl ? 0 : 128;
                for (int ua = bx; ua < nlat + nctx; ua += G) {
                    if (ua < nlat) {
                        const int b = ua >> 6, rem = ua & 63, qblk = rem >> 2, kh = (rem >> 1) & 1, hp = rem & 1;
                        const int h = kh * 4 + hp * 2 + (wave >> 2);
                        const int jlo = (qblk == 0) ? 2 : 0, jhi = (qblk == 15) ? 4 : 6;
                        attn_unit(lds, P, b * SEQ + qblk * 128 + (wave & 3) * 32, h, kh, (wave & 3) * 32, jhi - jlo, jlo, b * SEQ + qblk * 128 - 128, TL + b * CTXL, sink[h] * LOG2E);
                    } else {
                        const int uc = ua - nlat, b = uc >> 3, h = uc & 7;
                        attn_unit(lds, P, TL + b * CTXL + wave * 32, h, h >> 2, 0, 0, 0, 0, TL + b * CTXL, sink[h] * LOG2E);
                    }
                }
                __syncthreads();
                const int nruns = (lastl ? TL : TT) / 16;
                const int ntr = lastl ? 0 : 16 * 168;
                LAS float* scr = (LAS float*)(lds + wave * 16384);
                for (int it = (NGW - 1 - gw); it < nruns + ntr; it += NGW) {
                    if (it < nruns) conv_run(P, conv_w + (size_t)l * 3 * 512, it, lane);
                    else transpose_item(w_in + (size_t)(l + 1) * 1024 * NCOL, NCOL, WIN_T, 1024, 0, 168, scr, it - nruns, lane);
                }
            } else if (sub == 2 && (PHMASK & 32)) { PH_PROLOG
                pg8::Gemm g{P + C_ZA, WAB_T + (size_t)l * 1024 * 1024, NCOL, DM};
                pg8::Order S; S.init((lastl ? TL : TT) / 256, 4, G, bx);
                EpiG2 E{P};
                pg8::gemm_phase<EpiG2, pg8::Order, true>(lds, g, S, E);
            } else if (PHMASK & 64) { PH_PROLOG
                pg8::Gemm g{P + C_GA, WO_T + (size_t)l * 1024 * 1024, NCOL, DM};
                pg8::Order S; S.init((lastl ? TL : TT) / 256, 4, G, bx);
                EpiG3 E{l == 0 ? x_in : OUT, l == 0 ? ctx_in : XCTX, OUT, XCTX, MOD + (size_t)l * 17 * 3072 + 2048, lastl ? nullptr : NW1 + (size_t)(l + 1) * 17 * 1024, XS, SSP};
                pg8::gemm_phase<EpiG3, pg8::Order, true>(lds, g, S, E);
            }
        }
        if (ph + 1 < a.ph_hi) {
#if MK_COOP
            if (a.coop) { cg::this_grid().sync(); }
#endif
            __syncthreads();
        }
    }
}

extern "C" void kernel_launch(void* const* d_in, const int* in_sizes, int n_in, void* d_out, int out_size, void* d_ws, size_t ws_size, hipStream_t stream) {
    static int grid = 0;
    if (grid == 0) {
        if (n_in != 14 || in_sizes[0] != TL * DM || out_size != TL * DM || ws_size < WS_END) {
            fprintf(stderr, "kernel_launch: unexpected shapes (n_in %d, in0 %d, out %d, ws %zu need %zu); nothing launched\n", n_in, n_in > 0 ? in_sizes[0] : -1, out_size, ws_size, (size_t)WS_END); grid = -1; return; }
        int dev = 0, cus = 0;
        if (hipGetDevice(&dev) != hipSuccess || hipDeviceGetAttribute(&cus, hipDeviceAttributeMultiprocessorCount, dev) != hipSuccess || cus <= 0) cus = 256;
        if (hipFuncSetAttribute((const void*)fwd_kernel, hipFuncAttributeMaxDynamicSharedMemorySize, LDS_BYTES) != hipSuccess) { fprintf(stderr, "kernel_launch: hipFuncSetAttribute failed\n"); grid = -1; return; }
        int per_cu = 0;
        if (hipOccupancyMaxActiveBlocksPerMultiprocessor(&per_cu, (const void*)fwd_kernel, 512, LDS_BYTES) != hipSuccess || per_cu < 1) { fprintf(stderr, "kernel_launch: occupancy query says %d\n", per_cu); (void)hipGetLastError(); }
        grid = cus;
    }
    if (grid < 0) return;
    Args a{};
    for (int i = 0; i < 14; ++i) a.in[i] = (const float*)d_in[i];
    a.out = (float*)d_out; a.ws = (unsigned char*)d_ws;
#if MK_COOP
    a.ph_lo = 0; a.ph_hi = NPHASE; a.coop = 1;
    void* args[] = {&a};
    hipError_t e = hipLaunchCooperativeKernel((const void*)fwd_kernel, dim3(grid), dim3(512), args, LDS_BYTES, stream);
    if (e != hipSuccess) fprintf(stderr, "cooperative launch failed: %s (grid %d)\n", hipGetErrorString(e), grid);
#else
    for (int ph = 0; ph < NPHASE; ++ph) {
        a.ph_lo = ph; a.ph_hi = ph + 1; a.coop = 0;
        hipLaunchKernelGGL(fwd_kernel, dim3(grid), dim3(512), LDS_BYTES, stream, a);
    }
#endif
}
```

```cpp
#include <hip/hip_runtime.h>
#include <hip/hip_cooperative_groups.h>
#include <cstdio>
#include <cstdint>
namespace cg = cooperative_groups;

#ifndef PHMASK
#define PHMASK 127
#endif
#ifndef PROBE_SKIP
#define PROBE_SKIP 0
#endif
#ifndef DUP_MASK
#define DUP_MASK 0
#endif
#ifndef MK_COOP
#define MK_COOP 1
#endif

#define LAS __attribute__((address_space(3)))
typedef unsigned short bf16_t;
typedef short bf16x8 __attribute__((ext_vector_type(8)));
typedef short s16x4 __attribute__((ext_vector_type(4)));
typedef short v4i16_t __attribute__((ext_vector_type(4)));
typedef float f32x4 __attribute__((ext_vector_type(4)));
typedef float f32x16 __attribute__((ext_vector_type(16)));
typedef unsigned u32x4 __attribute__((ext_vector_type(4)));
typedef unsigned u32x2 __attribute__((ext_vector_type(2)));

constexpr int DM = 1024, NB = 16, SEQ = 2048, CTXL = 256, DEPTH = 4, NCOL = 5376;
constexpr int TL = NB * SEQ, TC = NB * CTXL, TT = TL + TC;
constexpr int C_B = 0, C_C = 512, C_U = 1024, C_ZA = 1536, C_Q = 2048, C_K = 2560, C_V = 2688, C_ZB = 2816, C_GA = 3328, C_GB = 4352;
constexpr float RMS_EPS = 1e-6f;
constexpr float LOG2E = 1.4426950408889634f;
constexpr float QSCALE = 0.125f * LOG2E;

constexpr size_t MiB = 1u << 20;
constexpr size_t WS_CTL = 0, CTL_ZERO_BYTES = 65536;
constexpr size_t WS_WIN_T = 1 * MiB;
constexpr size_t WS_WAB_T = 12 * MiB;
constexpr size_t WS_WO_T = 20 * MiB;
constexpr size_t WS_MOD = 28 * MiB;
constexpr size_t WS_NW1 = 29 * MiB;
constexpr size_t WS_SB = 30 * MiB;
constexpr size_t WS_ROPE = 32 * MiB;
constexpr size_t WS_SSP = 33 * MiB;
constexpr size_t WS_XCTX = 36 * MiB;
constexpr size_t WS_XS = 52 * MiB;
constexpr size_t WS_P = 124 * MiB;
constexpr size_t WS_END = WS_P + (size_t)TT * NCOL * 2;
static_assert(WS_END <= 502 * MiB, "ws map");

constexpr int LDS_BYTES = 131072 + 1024;
constexpr int NPHASE = 2 + 4 * DEPTH + 1;

struct Args { const float* in[14]; float* out; unsigned char* ws; int ph_lo, ph_hi, coop, pad; };

__device__ __forceinline__ unsigned cvt_pk_bf16(float lo, float hi) { unsigned r; asm volatile("v_cvt_pk_bf16_f32 %0, %1, %2" : "=v"(r) : "v"(lo), "v"(hi)); return r; }
__device__ __forceinline__ float bf_lo(unsigned w) { return __uint_as_float(w << 16); }
__device__ __forceinline__ float bf_hi(unsigned w) { return __uint_as_float(w & 0xffff0000u); }
__device__ __forceinline__ float fast_exp(float x) { return __builtin_amdgcn_exp2f(x * LOG2E); }
__device__ __forceinline__ float sigmoidf_(float x) { return __builtin_amdgcn_rcpf(1.0f + fast_exp(-x)); }
__device__ __forceinline__ float siluf_(float x) { return x * sigmoidf_(x); }
__device__ __forceinline__ float wave_sum(float v) {
#pragma unroll
    for (int o = 1; o < 64; o <<= 1) v += __shfl_xor(v, o);
    return v;
}
#define LDS_WAIT() asm volatile("s_waitcnt lgkmcnt(0)" ::: "memory")
#define VM_WAIT() asm volatile("s_waitcnt vmcnt(0)" ::: "memory")

namespace pg8 {
constexpr int BM = 256, BK = 64, HALF = 128, HTB = HALF * BK * 2, STAGE_BYTES = 8 * HTB, NXCD = 8, WGM = 8;
__host__ __device__ __forceinline__ int lds_byte(int r, int c) { const int st = (r >> 4) * 2 + (c >> 5), rr = r & 15, cc = c & 31, ob = rr * 64 + cc * 2; return st * 1024 + (ob ^ (((ob >> 9) & 1) << 5)); }
__host__ __device__ __forceinline__ void stage_rc(int b, int& R, int& C) { const int st = b / 1024, sb = b % 1024, swz = sb ^ (((sb >> 9) & 1) << 5); R = (st >> 1) * 16 + swz / 64; C = (st & 1) * 32 + (swz % 64) / 2; }
__host__ __device__ __forceinline__ int perm32(int rho) { const int n = rho >> 4, i = rho & 15; return 8 * (i >> 2) + 4 * n + (i & 3); }

struct Unit { int pm, pn; };
struct Gemm { const bf16_t* A; const bf16_t* Bt; int lda; int K; };

struct Order {
    int nM, nN, nwg, G, c, nextra, extra_pm0, extra_pn;
    __device__ void init(int nM_, int nN_, int G_, int c_, int nextra_ = 0, int epm0 = 0, int epn = 0) { nM = nM_; nN = nN_; nwg = nM * nN; G = G_; c = c_; nextra = nextra_; extra_pm0 = epm0; extra_pn = epn; }
    __device__ bool next(int i, Unit& u) const {
        const long L = (long)i * G + c; if (L >= nwg + nextra) return false;
        if (L >= nwg) { u.pm = extra_pm0 + (int)(L - nwg); u.pn = extra_pn; return true; }
        int wgid = (int)L; { const int q = nwg / NXCD, r = nwg % NXCD, xcd = wgid % NXCD, off = wgid / NXCD; wgid = (xcd < r ? xcd * (q + 1) : r * (q + 1) + (xcd - r) * q) + off; }
        const int nig = WGM * nN, gid = wgid / nig, fm = gid * WGM, gsz = (nM - fm) < WGM ? (nM - fm) : WGM;
        u.pm = fm + ((wgid % nig) % gsz); u.pn = (wgid % nig) / gsz; return true;
    }
};

template <class Epi, class Sched, bool ALIGN_EPI>
__device__ __forceinline__ void gemm_phase(LAS unsigned char* lds, const Gemm g, const Sched& S, const Epi& E) {
    int tid = threadIdx.x; asm volatile("" : "+v"(tid));
    const int wid = __builtin_amdgcn_readfirstlane(tid >> 6), lane = tid & 63, wr = wid >> 2, wc = wid & 3, fr = lane & 15, fq = lane >> 4;
    const int K = g.K, nt = K / BK, lda = g.lda;
    unsigned voffA[2], voffB[2];
#pragma unroll
    for (int i = 0; i < 2; ++i) { int R, C; stage_rc(tid * 16 + i * 8192, R, C); const int Rb = Epi::PERM ? ((R & ~31) + perm32(R & 31)) : R;
        voffA[i] = (unsigned)(R * lda + C) * 2u; voffB[i] = (unsigned)(Rb * K + C) * 2u; }
    const size_t kstep = (size_t)(BK * 2);
    const size_t hstepA = (size_t)HALF * lda * 2, tstepA = 2 * hstepA;
    const size_t hstepB = (size_t)HALF * K * 2, tstepB = 2 * hstepB;
    const unsigned ldsw = (unsigned)wid * 1024u;
    const int aoff = lds_byte(wr * 64 + fr, fq * 8), boff = lds_byte(wc * 32 + fr, fq * 8);
#define PG8_SA(b, h) (((b) * 2 + (h)) * HTB)
#define PG8_SB(b, h) ((4 + (b) * 2 + (h)) * HTB)
#define PG8_STAGE(bufoff, gbase, voff) do { _Pragma("unroll") for (int _i = 0; _i < 2; ++_i) \
        __builtin_amdgcn_global_load_lds((const unsigned*)((const char*)(gbase) + (voff)[_i]), (LAS unsigned*)(lds + (bufoff) + ldsw + _i * 8192), 16, 0, 0); } while (0)
#define PG8_LDA(dst, b, h) do { _Pragma("unroll") for (int m = 0; m < 4; ++m) _Pragma("unroll") for (int k = 0; k < 2; ++k) dst[m][k] = *(const LAS bf16x8*)(lds + PG8_SA(b, h) + aoff + m * 2048 + k * 1024); } while (0)
#define PG8_LDB(dst, b, h) do { _Pragma("unroll") for (int n = 0; n < 2; ++n) _Pragma("unroll") for (int k = 0; k < 2; ++k) dst[n][k] = *(const LAS bf16x8*)(lds + PG8_SB(b, h) + boff + n * 2048 + k * 1024); } while (0)
#define PG8_MMA(ai, bj, At, Bt) do { __builtin_amdgcn_s_setprio(1); _Pragma("unroll") for (int m = 0; m < 4; ++m) _Pragma("unroll") for (int n = 0; n < 2; ++n) _Pragma("unroll") for (int k = 0; k < 2; ++k) \
        acc[ai][bj][m][n] = __builtin_amdgcn_mfma_f32_16x16x32_bf16(Bt[n][k], At[m][k], acc[ai][bj][m][n], 0, 0, 0); __builtin_amdgcn_s_setprio(0); } while (0)
#define PG8_WAIT_V(n) asm volatile("s_waitcnt vmcnt(" #n ")" ::: "memory")
#define PG8_WAIT_L(n) asm volatile("s_waitcnt lgkmcnt(" #n ")" ::: "memory")
#define PG8_BAR __builtin_amdgcn_s_barrier()
#define PG8_SCHED __builtin_amdgcn_sched_barrier(0)
    Unit cur, nxt; int ui = 0;
    if (!S.next(0, cur)) return;
    f32x4 acc[2][2][4][2];
#pragma unroll
    for (int a = 0; a < 2; ++a)
#pragma unroll
        for (int b = 0; b < 2; ++b)
#pragma unroll
            for (int m = 0; m < 4; ++m)
#pragma unroll
                for (int n = 0; n < 2; ++n) acc[a][b][m][n] = (f32x4){0.f, 0.f, 0.f, 0.f};
    bf16x8 At[4][2], B0[2][2], B1[2][2];
    const char* cA = (const char*)g.A + (size_t)cur.pm * tstepA; const char* cB = (const char*)g.Bt + (size_t)cur.pn * tstepB;
    PG8_STAGE(PG8_SB(0, 0), cB, voffB); PG8_STAGE(PG8_SB(0, 1), cB + hstepB, voffB); PG8_STAGE(PG8_SA(0, 0), cA, voffA); PG8_STAGE(PG8_SA(0, 1), cA + hstepA, voffA);
    if (wr == 1) PG8_BAR;
    PG8_WAIT_V(2); PG8_BAR;
    PG8_STAGE(PG8_SB(1, 0), cB + kstep, voffB); PG8_STAGE(PG8_SA(1, 0), cA + kstep, voffA); PG8_STAGE(PG8_SB(1, 1), cB + hstepB + kstep, voffB);
    PG8_WAIT_V(6); PG8_BAR;
    for (;;) {
        const bool has_next = S.next(ui + 1, nxt);
        const char* nA = has_next ? (const char*)g.A + (size_t)nxt.pm * tstepA : cA; const char* nB = has_next ? (const char*)g.Bt + (size_t)nxt.pn * tstepB : cB;
        for (int t = 0; t < nt; t += 2) {
            if constexpr (Epi::HOOK) { if (t == (nt >> 1)) E.mid(acc, cur, wr, wc, fr, fq); }
            const bool last = (t == nt - 2);
            const char* a1 = cA + (size_t)(t + 1) * kstep;
            const char* a2 = last ? nA : cA + (size_t)(t + 2) * kstep; const char* b2 = last ? nB : cB + (size_t)(t + 2) * kstep;
            const char* a3 = a2 + kstep; const char* b3 = b2 + kstep;
            PG8_LDB(B0, 0, 0); PG8_LDB(B1, 0, 1); PG8_SCHED; PG8_LDA(At, 0, 0); PG8_STAGE(PG8_SA(1, 1), a1 + hstepA, voffA);
            PG8_WAIT_V(8); PG8_WAIT_L(0); PG8_BAR; PG8_MMA(0, 0, At, B0); PG8_MMA(0, 1, At, B1); PG8_BAR; PG8_SCHED;
            PG8_LDA(At, 0, 1); PG8_STAGE(PG8_SB(0, 0), b2, voffB); PG8_STAGE(PG8_SB(0, 1), b2 + hstepB, voffB); PG8_STAGE(PG8_SA(0, 0), a2, voffA);
            PG8_WAIT_V(8); PG8_WAIT_L(0); PG8_BAR; PG8_MMA(1, 0, At, B0); PG8_MMA(1, 1, At, B1); PG8_BAR; PG8_SCHED;
            PG8_LDB(B0, 1, 0); PG8_LDB(B1, 1, 1); PG8_SCHED; PG8_LDA(At, 1, 0); PG8_STAGE(PG8_SA(0, 1), a2 + hstepA, voffA);
            PG8_WAIT_V(8); PG8_WAIT_L(0); PG8_BAR; PG8_MMA(0, 0, At, B0); PG8_MMA(0, 1, At, B1); PG8_BAR; PG8_SCHED;
            PG8_LDA(At, 1, 1); PG8_STAGE(PG8_SB(1, 0), b3, voffB); PG8_STAGE(PG8_SB(1, 1), b3 + hstepB, voffB); PG8_STAGE(PG8_SA(1, 0), a3, voffA);
            PG8_WAIT_V(8); PG8_WAIT_L(0); PG8_BAR; PG8_MMA(1, 0, At, B0); PG8_MMA(1, 1, At, B1); PG8_BAR; PG8_SCHED;
        }
        if constexpr (ALIGN_EPI) { if (wr == 0) PG8_BAR; }
        E(acc, cur, wr, wc, fr, fq);
        if (!has_next) break;
#pragma unroll
        for (int a = 0; a < 2; ++a)
#pragma unroll
            for (int b = 0; b < 2; ++b)
#pragma unroll
                for (int m = 0; m < 4; ++m)
#pragma unroll
                    for (int n = 0; n < 2; ++n) acc[a][b][m][n] = (f32x4){0.f, 0.f, 0.f, 0.f};
        cur = nxt; cA = nA; cB = nB; ++ui;
        if constexpr (ALIGN_EPI) { if (wr == 1) PG8_BAR; }
    }
    PG8_WAIT_V(0);
    if constexpr (!ALIGN_EPI) { if (wr == 0) PG8_BAR; }
    PG8_BAR;
#undef PG8_SA
#undef PG8_SB
#undef PG8_STAGE
#undef PG8_LDA
#undef PG8_LDB
#undef PG8_MMA
#undef PG8_WAIT_V
#undef PG8_WAIT_L
#undef PG8_BAR
#undef PG8_SCHED
}
}

struct EpiG1 {
    static constexpr bool PERM = false, HOOK = false;
    bf16_t* P; const float* ssp; const float* sb; const float* ropec; const float* ropes; int skip;
    __device__ __forceinline__ void mid(f32x4 (&)[2][2][4][2], const pg8::Unit&, int, int, int, int) const {}
    __device__ __forceinline__ void operator()(const f32x4 (&acc)[2][2][4][2], const pg8::Unit& u, int wr, int wc, int fr, int fq) const {
        if (skip) { if (skip == 2) { if (acc[0][0][0][0][0] == 12345.678f) P[0] = 1; } return; }
        const bool latent = u.pm < 128;
        const int bidx = latent ? (u.pm >> 3) : 16;
        const int col0 = u.pn * 256 + wc * 32 + 4 * fq;
        const float* sbr = sb + bidx * NCOL + col0;
        f32x4 bv[2][2];
#pragma unroll
        for (int bj = 0; bj < 2; ++bj)
#pragma unroll
            for (int n = 0; n < 2; ++n) bv[bj][n] = *(const f32x4*)(sbr + bj * 128 + n * 16);
        const bool isq = (u.pn == 8 || u.pn == 9), isk = (u.pn == 10);
        const bool anyrope = latent && (isq || isk);
        const float sc = isq ? QSCALE : 1.0f;
        float rinv[8];
        {
            const int ln = fq * 16 + fr;
            f32x4 pv[8];
#pragma unroll
            for (int i = 0; i < 8; ++i) pv[i] = *(const f32x4*)(ssp + (size_t)(u.pm * 256 + (i >> 2) * 128 + wr * 64 + (i & 3) * 16 + (ln >> 2)) * 16 + (ln & 3) * 4);
#pragma unroll
            for (int i = 0; i < 8; ++i) { float q = (pv[i][0] + pv[i][1]) + (pv[i][2] + pv[i][3]); q += __shfl_xor(q, 1); q += __shfl_xor(q, 2);
                const float r = 1.0f / sqrtf(q * (1.0f / 1024.0f) + RMS_EPS); rinv[i] = __shfl(r, 4 * fr); }
        }
#pragma unroll
        for (int ai = 0; ai < 2; ++ai)
#pragma unroll
            for (int m = 0; m < 4; ++m) {
                const int row = u.pm * 256 + ai * 128 + wr * 64 + m * 16 + fr;
                const float ri = rinv[ai * 4 + m];
                f32x4 cs = (f32x4){1.f, 1.f, 1.f, 1.f}, sn = (f32x4){0.f, 0.f, 0.f, 0.f};
                if (anyrope) { const int t = row & 2047; const int pos = (wc & 1) ? (t & 63) : (t >> 6);
                    cs = *(const f32x4*)(ropec + pos * 16 + 4 * fq); sn = *(const f32x4*)(ropes + pos * 16 + 4 * fq); }
                bf16_t* rowp = P + (size_t)row * NCOL + col0;
#pragma unroll
                for (int bj = 0; bj < 2; ++bj) {
                    f32x4 v0 = acc[ai][bj][m][0] * ri + bv[bj][0], v1 = acc[ai][bj][m][1] * ri + bv[bj][1];
                    const bool rp = anyrope && (isq || bj == 0);
                    if (rp) { const f32x4 a = v0 * cs - v1 * sn, b = v1 * cs + v0 * sn; v0 = a; v1 = b; }
                    v0 = v0 * sc; v1 = v1 * sc;
                    u32x2 w0, w1; w0.x = cvt_pk_bf16(v0[0], v0[1]); w0.y = cvt_pk_bf16(v0[2], v0[3]); w1.x = cvt_pk_bf16(v1[0], v1[1]); w1.y = cvt_pk_bf16(v1[2], v1[3]);
                    *(u32x2*)(rowp + bj * 128) = w0; *(u32x2*)(rowp + bj * 128 + 16) = w1;
                }
            }
    }
};

struct EpiG2 {
    static constexpr bool PERM = true, HOOK = true;
    const bf16_t* P; bf16_t* Mout; int ldm, mcol;
    __device__ __forceinline__ void mid(f32x4 (&acc)[2][2][4][2], const pg8::Unit& u, int wr, int wc, int fr, int fq) const {
        int col8 = u.pn * 256 + wc * 32 + 8 * fq, rbase = u.pm * 256 + wr * 64 + fr;
        asm volatile("" : "+v"(col8), "+v"(rbase));
#pragma unroll
        for (int ai = 0; ai < 2; ++ai) {
            u32x4 ga[4][2], gb[4][2];
#pragma unroll
            for (int m = 0; m < 4; ++m) { const bf16_t* rowp = P + (size_t)(rbase + ai * 128 + m * 16) * NCOL + col8;
#pragma unroll
                for (int bj = 0; bj < 2; ++bj) { ga[m][bj] = *(const u32x4*)(rowp + C_GA + bj * 128); gb[m][bj] = *(const u32x4*)(rowp + C_GB + bj * 128); } }
#pragma unroll
            for (int m = 0; m < 4; ++m)
#pragma unroll
                for (int bj = 0; bj < 2; ++bj)
#pragma unroll
                    for (int w = 0; w < 4; ++w) {
                        const float a0 = bf_lo(ga[m][bj][w]), a1 = bf_hi(ga[m][bj][w]), b0 = bf_lo(gb[m][bj][w]), b1 = bf_hi(gb[m][bj][w]);
                        const float r0 = (1.0f + fast_exp(-b0)) * __builtin_amdgcn_rcpf(1.0f + fast_exp(-a0));
                        const float r1 = (1.0f + fast_exp(-b1)) * __builtin_amdgcn_rcpf(1.0f + fast_exp(-a1));
                        acc[ai][bj][m][w >> 1][(w & 1) * 2] *= r0; acc[ai][bj][m][w >> 1][(w & 1) * 2 + 1] *= r1;
                    }
            asm volatile("" ::: "memory");
        }
    }
    __device__ __forceinline__ void operator()(const f32x4 (&acc)[2][2][4][2], const pg8::Unit& u, int wr, int wc, int fr, int fq) const {
        const int col8 = u.pn * 256 + wc * 32 + 8 * fq, rbase = u.pm * 256 + wr * 64 + fr;
        u32x4 gb[2][4][2];
#pragma unroll
        for (int ai = 0; ai < 2; ++ai)
#pragma unroll
            for (int m = 0; m < 4; ++m) { const bf16_t* rowp = P + (size_t)(rbase + ai * 128 + m * 16) * NCOL + col8;
#pragma unroll
                for (int bj = 0; bj < 2; ++bj) gb[ai][m][bj] = *(const u32x4*)(rowp + C_GB + bj * 128); }
#pragma unroll
        for (int ai = 0; ai < 2; ++ai)
#pragma unroll
            for (int m = 0; m < 4; ++m) {
                bf16_t* mrow = Mout + (size_t)(rbase + ai * 128 + m * 16) * ldm + mcol + col8;
#pragma unroll
                for (int bj = 0; bj < 2; ++bj) {
                    u32x4 o;
#pragma unroll
                    for (int w = 0; w < 4; ++w) {
                        const float s0 = sigmoidf_(bf_lo(gb[ai][m][bj][w])), s1 = sigmoidf_(bf_hi(gb[ai][m][bj][w]));
                        o[w] = cvt_pk_bf16(acc[ai][bj][m][w >> 1][(w & 1) * 2] * s0, acc[ai][bj][m][w >> 1][(w & 1) * 2 + 1] * s1);
                    }
                    *(u32x4*)(mrow + bj * 128) = o;
                }
            }
    }
};

struct EpiG3 {
    static constexpr bool PERM = false, HOOK = false;
    const float* xin_lat; const float* xin_ctx; float* xout_lat; float* xout_ctx; const float* gate; const float* nw; bf16_t* xs; float* ssp;
    __device__ __forceinline__ void mid(f32x4 (&)[2][2][4][2], const pg8::Unit&, int, int, int, int) const {}
    __device__ __forceinline__ void operator()(const f32x4 (&acc)[2][2][4][2], const pg8::Unit& u, int wr, int wc, int fr, int fq) const {
        const bool latent = u.pm < 128;
        const int bidx = latent ? (u.pm >> 3) : 16;
        const int col0 = u.pn * 256 + wc * 32 + 4 * fq;
        f32x4 gv[2][2], nv[2][2];
#pragma unroll
        for (int bj = 0; bj < 2; ++bj)
#pragma unroll
            for (int n = 0; n < 2; ++n) { gv[bj][n] = gate ? *(const f32x4*)(gate + bidx * 3072 + col0 + bj * 128 + n * 16) : (f32x4){0.f, 0.f, 0.f, 0.f};
                nv[bj][n] = nw ? *(const f32x4*)(nw + bidx * 1024 + col0 + bj * 128 + n * 16) : (f32x4){0.f, 0.f, 0.f, 0.f}; }
#pragma unroll
        for (int ai = 0; ai < 2; ++ai)
#pragma unroll
        for (int mh = 0; mh < 2; ++mh) {
            f32x4 xv[2][2][2];
#pragma unroll
            for (int m2 = 0; m2 < 2; ++m2) { const int row = u.pm * 256 + ai * 128 + wr * 64 + (mh * 2 + m2) * 16 + fr;
                const float* xi = latent ? xin_lat + (size_t)row * DM : xin_ctx + (size_t)(row - TL) * DM;
#pragma unroll
                for (int bj = 0; bj < 2; ++bj)
#pragma unroll
                    for (int n = 0; n < 2; ++n) xv[m2][bj][n] = *(const f32x4*)(xi + col0 + bj * 128 + n * 16); }
#pragma unroll
            for (int m2 = 0; m2 < 2; ++m2) {
                const int m = mh * 2 + m2;
                const int row = u.pm * 256 + ai * 128 + wr * 64 + m * 16 + fr;
                float* xo = latent ? xout_lat + (size_t)row * DM : xout_ctx + (size_t)(row - TL) * DM;
                float q = 0.f;
#pragma unroll
                for (int bj = 0; bj < 2; ++bj)
#pragma unroll
                    for (int n = 0; n < 2; ++n) {
                        const int off = col0 + bj * 128 + n * 16;
                        const f32x4 xn = xv[m2][bj][n] + gv[bj][n] * acc[ai][bj][m][n];
                        *(f32x4*)(xo + off) = xn;
                        q += (xn[0] * xn[0] + xn[1] * xn[1]) + (xn[2] * xn[2] + xn[3] * xn[3]);
                        if (nw) { const f32x4 h = xn * nv[bj][n]; u32x2 w; w.x = cvt_pk_bf16(h[0], h[1]); w.y = cvt_pk_bf16(h[2], h[3]); *(u32x2*)(xs + (size_t)row * DM + off) = w; }
                    }
                q += __shfl_xor(q, 16); q += __shfl_xor(q, 32);
                if (fq == 0) ssp[(size_t)row * 16 + u.pn * 4 + wc] = q;
            }
            asm volatile("" ::: "memory");
        }
    }
};

__device__ __forceinline__ s16x4 vtr(const LAS unsigned char* p) { return __builtin_bit_cast(s16x4, __builtin_amdgcn_ds_read_tr16_b64_v4i16((LAS v4i16_t*)p)); }

__device__ __forceinline__ void attn_unit(LAS unsigned char* lds, bf16_t* P, bf16_t* Oout, int opitch, int ocol, int rowQ0, int h, int kh, int qq0, int nloc, int jlo, int keyrow_loc0, int keyrow_ctx0, float sink_l2) {
    int tid = threadIdx.x; asm volatile("" : "+v"(tid));
    const int lane = tid & 63, r32 = lane & 31, hi = lane >> 5;
    const int wid = __builtin_amdgcn_readfirstlane(tid >> 6);
    const int NT = nloc + 4;
    const size_t koff = (size_t)lane * NCOL + C_K + kh * 64 + wid * 8;
    const size_t voff = (size_t)(16 * (wid & 3) + (lane >> 2)) * NCOL + C_V + kh * 64 + (wid >> 2) * 32 + (lane & 3) * 8;
#define AT_STAGE(tt, buf) do { const int kr0_ = ((tt) < nloc) ? keyrow_loc0 + 64 * (jlo + (tt)) : keyrow_ctx0 + 64 * ((tt) - nloc); const bf16_t* tb_ = P + (size_t)kr0_ * NCOL; \
        __builtin_amdgcn_global_load_lds((const unsigned*)(tb_ + koff), (LAS unsigned*)(lds + (buf) * 16384 + wid * 1024), 16, 0, 0); \
        __builtin_amdgcn_global_load_lds((const unsigned*)(tb_ + voff), (LAS unsigned*)(lds + (buf) * 16384 + 8192 + wid * 1024), 16, 0, 0); } while (0)
    AT_STAGE(0, 0);
    bf16x8 qr[4];
    const size_t rowoff = (size_t)(rowQ0 + r32) * NCOL;
    {
        const bf16_t* qp = P + rowoff + C_Q + h * 64 + hi * 8;
#pragma unroll
        for (int d0 = 0; d0 < 4; ++d0) qr[d0] = *(const bf16x8*)(qp + d0 * 16);
    }
    f32x16 o0, o1;
#pragma unroll
    for (int i = 0; i < 16; ++i) { o0[i] = 0.f; o1[i] = 0.f; }
    float mrun = sink_l2, lrun = hi ? 0.f : 1.f;
    const int qq = qq0 + r32;
    VM_WAIT(); __syncthreads();
    for (int tt = 0; tt < NT; ++tt) {
        const int buf = tt & 1;
        if (tt + 1 < NT) AT_STAGE(tt + 1, buf ^ 1);
        const LAS unsigned char* kb = lds + buf * 16384 + hi * 1024 + r32 * 16;
        f32x16 p0, p1;
#pragma unroll
        for (int i = 0; i < 16; ++i) { p0[i] = 0.f; p1[i] = 0.f; }
#pragma unroll
        for (int d0 = 0; d0 < 4; ++d0) {
            const bf16x8 b0 = *(const LAS bf16x8*)(kb + d0 * 2048);
            const bf16x8 b1 = *(const LAS bf16x8*)(kb + d0 * 2048 + 512);
            p0 = __builtin_amdgcn_mfma_f32_32x32x16_bf16(b0, qr[d0], p0, 0, 0, 0);
            p1 = __builtin_amdgcn_mfma_f32_32x32x16_bf16(b1, qr[d0], p1, 0, 0, 0);
        }
        if (tt < nloc) {
            const int j = jlo + tt;
            if (j < 2) {
                const int lim = qq - 64 * j;
#pragma unroll
                for (int i = 0; i < 16; ++i) { const int kk = (i & 3) + 8 * (i >> 2) + 4 * hi; if (kk < lim) p0[i] = -1e30f; if (kk + 32 < lim) p1[i] = -1e30f; }
            } else if (j >= 4) {
                const int lim = qq - 64 * (j - 4);
#pragma unroll
                for (int i = 0; i < 16; ++i) { const int kk = (i & 3) + 8 * (i >> 2) + 4 * hi; if (kk > lim) p0[i] = -1e30f; if (kk + 32 > lim) p1[i] = -1e30f; }
            }
        }
        float rm = fmaxf(p0[0], p1[0]);
#pragma unroll
        for (int i = 1; i < 16; ++i) rm = fmaxf(rm, fmaxf(p0[i], p1[i]));
        rm = fmaxf(rm, __shfl_xor(rm, 32));
        const float mn = fmaxf(mrun, rm);
        const float f = __builtin_amdgcn_exp2f(mrun - mn);
        mrun = mn;
        float ps = 0.f;
#pragma unroll
        for (int i = 0; i < 16; ++i) { p0[i] = __builtin_amdgcn_exp2f(p0[i] - mn); p1[i] = __builtin_amdgcn_exp2f(p1[i] - mn); ps += p0[i] + p1[i]; }
        lrun = lrun * f + ps;
#pragma unroll
        for (int i = 0; i < 16; ++i) { o0[i] *= f; o1[i] *= f; }
        u32x4 pw[4];
#pragma unroll
        for (int w = 0; w < 4; ++w) { pw[0][w] = cvt_pk_bf16(p0[2 * w], p0[2 * w + 1]); pw[1][w] = cvt_pk_bf16(p0[8 + 2 * w], p0[8 + 2 * w + 1]);
            pw[2][w] = cvt_pk_bf16(p1[2 * w], p1[2 * w + 1]); pw[3][w] = cvt_pk_bf16(p1[8 + 2 * w], p1[8 + 2 * w + 1]); }
        const LAS unsigned char* vp = lds + buf * 16384 + 8192 + ((lane >> 4) & 1) * 32 + (lane & 3) * 8 + (4 * hi + ((lane & 15) >> 2)) * 64;
#pragma unroll
        for (int s = 0; s < 4; ++s) {
            const s16x4 l0 = vtr(vp + s * 1024), h0 = vtr(vp + s * 1024 + 512);
            const s16x4 l1 = vtr(vp + 4096 + s * 1024), h1 = vtr(vp + 4096 + s * 1024 + 512);
            const bf16x8 v0 = (bf16x8){l0[0], l0[1], l0[2], l0[3], h0[0], h0[1], h0[2], h0[3]};
            const bf16x8 v1 = (bf16x8){l1[0], l1[1], l1[2], l1[3], h1[0], h1[1], h1[2], h1[3]};
            const bf16x8 pa = __builtin_bit_cast(bf16x8, pw[s]);
            o0 = __builtin_amdgcn_mfma_f32_32x32x16_bf16(v0, pa, o0, 0, 0, 0);
            o1 = __builtin_amdgcn_mfma_f32_32x32x16_bf16(v1, pa, o1, 0, 0, 0);
        }
        VM_WAIT(); __syncthreads();
    }
#undef AT_STAGE
    lrun += __shfl_xor(lrun, 32);
    const float inv = 1.0f / lrun;
    const bf16_t* op = P + rowoff + h * 64 + 4 * hi;
    bf16_t* oo = Oout + (size_t)(rowQ0 + r32) * opitch + ocol + h * 64 + 4 * hi;
#pragma unroll
    for (int d0 = 0; d0 < 2; ++d0)
#pragma unroll
        for (int gq = 0; gq < 4; ++gq) {
            const int d = d0 * 32 + 8 * gq;
            const u32x2 z = *(const u32x2*)(op + C_ZB + d);
            const float z0 = bf_lo(z.x), z1 = bf_hi(z.x), z2 = bf_lo(z.y), z3 = bf_hi(z.y);
            const float a0 = (d0 ? o1[4 * gq + 0] : o0[4 * gq + 0]) * inv * siluf_(z0);
            const float a1 = (d0 ? o1[4 * gq + 1] : o0[4 * gq + 1]) * inv * siluf_(z1);
            const float a2 = (d0 ? o1[4 * gq + 2] : o0[4 * gq + 2]) * inv * siluf_(z2);
            const float a3 = (d0 ? o1[4 * gq + 3] : o0[4 * gq + 3]) * inv * siluf_(z3);
            u32x2 w; w.x = cvt_pk_bf16(a0, a1); w.y = cvt_pk_bf16(a2, a3);
            *(u32x2*)(oo + d) = w;
        }
}

struct V8 { f32x4 a, b; };
__device__ __forceinline__ V8 ld8(const bf16_t* p) { const u32x4 w = *(const u32x4*)p; V8 r; r.a = (f32x4){bf_lo(w.x), bf_hi(w.x), bf_lo(w.y), bf_hi(w.y)}; r.b = (f32x4){bf_lo(w.z), bf_hi(w.z), bf_lo(w.w), bf_hi(w.w)}; return r; }
__device__ __forceinline__ V8 cu_at(const bf16_t* P, int t, int c0) { const V8 c = ld8(P + (size_t)t * NCOL + C_C + c0), u = ld8(P + (size_t)t * NCOL + C_U + c0); V8 r; r.a = c.a * u.a; r.b = c.b * u.b; return r; }
__device__ __forceinline__ void conv_run(const bf16_t* P, bf16_t* Yout, int ypitch, int ycol, const float* cw, int run, int lane) {
    const int row0 = run * 16;
    int s0, s1; if (row0 < TL) { s0 = row0 & ~2047; s1 = s0 + 2048; } else { s0 = TL + ((row0 - TL) & ~255); s1 = s0 + 256; }
    const int c0 = lane * 8;
    const f32x4 w0a = *(const f32x4*)(cw + c0), w0b = *(const f32x4*)(cw + c0 + 4);
    const f32x4 w1a = *(const f32x4*)(cw + 512 + c0), w1b = *(const f32x4*)(cw + 512 + c0 + 4);
    const f32x4 w2a = *(const f32x4*)(cw + 1024 + c0), w2b = *(const f32x4*)(cw + 1024 + c0 + 4);
    const f32x4 z4 = (f32x4){0.f, 0.f, 0.f, 0.f};
    V8 prev, cur; prev.a = z4; prev.b = z4;
    if (row0 - 1 >= s0) prev = cu_at(P, row0 - 1, c0);
    cur = cu_at(P, row0, c0);
    for (int i = 0; i < 16; ++i) {
        const int t = row0 + i;
        V8 nxt; nxt.a = z4; nxt.b = z4;
        if (t + 1 < s1) nxt = cu_at(P, t + 1, c0);
        const f32x4 ca = w0a * prev.a + w1a * cur.a + w2a * nxt.a, cb = w0b * prev.b + w1b * cur.b + w2b * nxt.b;
        const V8 bg = ld8(P + (size_t)t * NCOL + C_B + c0), z = ld8(P + (size_t)t * NCOL + C_ZA + c0);
        f32x4 ya, yb;
#pragma unroll
        for (int e = 0; e < 4; ++e) { ya[e] = bg.a[e] * ca[e] * siluf_(z.a[e]); yb[e] = bg.b[e] * cb[e] * siluf_(z.b[e]); }
        u32x4 w; w.x = cvt_pk_bf16(ya[0], ya[1]); w.y = cvt_pk_bf16(ya[2], ya[3]); w.z = cvt_pk_bf16(yb[0], yb[1]); w.w = cvt_pk_bf16(yb[2], yb[3]);
        *(u32x4*)(Yout + (size_t)t * ypitch + ycol + c0) = w;
        prev = cur; cur = nxt;
    }
}

__device__ __forceinline__ void transpose_item(const float* W, int ldw, bf16_t* WT, int ldo, int koff, int nblk, LAS float* scr, int item, int lane) {
    const int kb = item / nblk, nb = item % nblk, k0 = 64 * kb, n0 = 32 * nb;
#pragma unroll 8
    for (int i = 0; i < 32; ++i) { const int kk = 2 * i + (lane >> 5); scr[kk * 33 + (lane & 31)] = W[(size_t)(k0 + kk) * ldw + n0 + (lane & 31)]; }
    LDS_WAIT(); asm volatile("" ::: "memory");
    const int c = lane & 7;
#pragma unroll
    for (int j = 0; j < 4; ++j) { const int n = (lane >> 3) + 8 * j; const LAS float* s = scr + (8 * c) * 33 + n;
        u32x4 o; o.x = cvt_pk_bf16(s[0 * 33], s[1 * 33]); o.y = cvt_pk_bf16(s[2 * 33], s[3 * 33]); o.z = cvt_pk_bf16(s[4 * 33], s[5 * 33]); o.w = cvt_pk_bf16(s[6 * 33], s[7 * 33]);
        *(u32x4*)(WT + (size_t)(n0 + n) * ldo + koff + k0 + 8 * c) = o; }
    LDS_WAIT(); asm volatile("" ::: "memory");
}

__device__ __forceinline__ void rowmat17_item(int tid, LAS unsigned char* lds, const float* W, int ldw, int col0, const float* bias, float* out, int ldo) {
    const int lane = tid & 63, wid = tid >> 6;
    const LAS float* tab = (const LAS float*)lds;
    LAS float* part = (LAS float*)(lds + 17 * 1024 * 4);
    float acc[17];
#pragma unroll
    for (int r = 0; r < 17; ++r) acc[r] = 0.f;
    const float* wp = W + (size_t)(wid * 128) * ldw + col0 + lane;
#pragma unroll 2
    for (int k = 0; k < 128; k += 4) {
        const float w0 = wp[(size_t)(k + 0) * ldw], w1 = wp[(size_t)(k + 1) * ldw], w2 = wp[(size_t)(k + 2) * ldw], w3 = wp[(size_t)(k + 3) * ldw];
#pragma unroll
        for (int r = 0; r < 17; ++r) { const f32x4 t = *(const LAS f32x4*)(tab + r * 1024 + wid * 128 + k); acc[r] += (t[0] * w0 + t[1] * w1) + (t[2] * w2 + t[3] * w3); }
    }
#pragma unroll
    for (int r = 0; r < 17; ++r) part[(wid * 17 + r) * 64 + lane] = acc[r];
    __syncthreads();
    for (int idx = tid; idx < 17 * 64; idx += 512) { const int r = idx >> 6, e = idx & 63; float s = 0.f;
#pragma unroll
        for (int w = 0; w < 8; ++w) s += part[(w * 17 + r) * 64 + e];
        if (bias) s += bias[col0 + e];
        out[(size_t)r * ldo + col0 + e] = s; }
    __syncthreads();
}


#define XB_TMO      128
#define XB_XCNT(j)  (256  + 64 * (j))
#define XB_XSUB(j)  (1280 + 64 * (j))
#define XB_XGEN(j)  (2304 + 64 * (j))
#define XB_TOP      3328
#define XB_TOPGEN   3392
#define XCD_BAR_WORDS 3456
#define XB_SPIN_CAP (1u << 18)
__device__ __forceinline__ unsigned xb_ld(unsigned* p)              { return __hip_atomic_load(p, __ATOMIC_RELAXED, __HIP_MEMORY_SCOPE_AGENT); }
__device__ __forceinline__ unsigned xb_add(unsigned* p, unsigned v) { return __hip_atomic_fetch_add(p, v, __ATOMIC_RELAXED, __HIP_MEMORY_SCOPE_AGENT); }
__device__ __forceinline__ unsigned xb_xcc_id() { return (unsigned)__builtin_amdgcn_s_getreg((3 << 11) | 20) & 0xFu; }
#define XB_SPIN(cond, bar) do { unsigned _sp = 0; while (cond) { __builtin_amdgcn_s_sleep(1); \
    if ((++_sp & 255u) == 0u) { if (xb_ld(&(bar)[XB_TMO])) break; if (_sp > XB_SPIN_CAP) { atomicAdd(&(bar)[XB_TMO], 1u); break; } } } } while (0)
struct XcdBarrier { unsigned* bar; unsigned x; volatile LAS unsigned* st; };
__device__ __forceinline__ XcdBarrier xcd_barrier_post(unsigned* bar, volatile LAS unsigned* st) {
    XcdBarrier b; b.bar = bar; b.x = xb_xcc_id(); b.st = st;
    if (threadIdx.x == 0) (void)xb_add(&bar[XB_XCNT(b.x)], 1u);
    return b;
}
__device__ __forceinline__ void xcd_barrier_complete(unsigned* bar, unsigned x, unsigned& nloc, unsigned& nx) {
    const unsigned G = gridDim.x * gridDim.y * gridDim.z;
    unsigned sum, cnt, mine, sp = 0u;
    for (;;) {
        sum = 0u; cnt = 0u; mine = 0u;
#pragma unroll
        for (unsigned j = 0; j < 16; ++j) { const unsigned c = xb_ld(&bar[XB_XCNT(j)]); sum += c; cnt += (c > 0u) ? 1u : 0u; mine = (j == x) ? c : mine; }
        if (sum == G) break;
        __builtin_amdgcn_s_sleep(1);
        if ((++sp & 255u) == 0u) { if (xb_ld(&bar[XB_TMO])) break; if (sp > XB_SPIN_CAP) { atomicAdd(&bar[XB_TMO], 1u); break; } }
    }
    nloc = mine > 0u ? mine : 1u; nx = cnt > 0u ? cnt : 1u;
}
__device__ __forceinline__ void xcd_barrier(const XcdBarrier& b) {
    asm volatile("s_waitcnt vmcnt(0)" ::: "memory");
    __syncthreads();
    if (threadIdx.x == 0) {
        unsigned* bar = b.bar;
        __builtin_amdgcn_s_waitcnt(0);
        unsigned nloc = b.st[0], nx = b.st[1];
        if (nloc == 0u) { xcd_barrier_complete(bar, b.x, nloc, nx); b.st[0] = nloc; b.st[1] = nx; }
        const unsigned old = xb_add(&bar[XB_XSUB(b.x)], 1u);
        const unsigned gen = old / nloc;
        if (old + 1u == (gen + 1u) * nloc) {
            __builtin_amdgcn_fence(__ATOMIC_RELEASE, "agent");
            asm volatile("s_waitcnt vmcnt(0)" ::: "memory");
            const unsigned og = xb_add(&bar[XB_TOP], 1u);
            const unsigned tg = og / nx;
            if (og + 1u == (tg + 1u) * nx) xb_add(&bar[XB_TOPGEN], 1u);
            else XB_SPIN(xb_ld(&bar[XB_TOPGEN]) == tg, bar);
            __builtin_amdgcn_fence(__ATOMIC_ACQUIRE, "agent");
            xb_add(&bar[XB_XGEN(b.x)], 1u);
            asm volatile("s_waitcnt vmcnt(0)" ::: "memory");
        } else {
            XB_SPIN(xb_ld(&bar[XB_XGEN(b.x)]) == gen, bar);
            __builtin_amdgcn_fence(__ATOMIC_ACQUIRE, "agent");
            asm volatile("s_waitcnt vmcnt(0)" ::: "memory");
        }
    }
    __syncthreads();
}

__global__ void __launch_bounds__(512, 2) fwd_kernel(Args a) {
    extern __shared__ __attribute__((aligned(16))) unsigned char lds_raw[];
    LAS unsigned char* lds = (LAS unsigned char*)lds_raw;
    const float* x_in = a.in[0]; const float* c_in = a.in[1]; const float* ctx_in = a.in[2]; const float* cctx_in = a.in[3];
    const float* norm_w = a.in[4]; const float* w_mod = a.in[5]; const float* b_mod = a.in[6]; const float* w_in = a.in[7]; const float* conv_w = a.in[8];
    const float* w_a_out = a.in[9]; const float* w_b_out = a.in[10]; const float* attn_sink = a.in[11]; const float* w_o = a.in[12]; const float* fnorm_w = a.in[13];
    unsigned char* ws = a.ws;
    bf16_t* WIN_T = (bf16_t*)(ws + WS_WIN_T); bf16_t* WAB_T = (bf16_t*)(ws + WS_WAB_T); bf16_t* WO_T = (bf16_t*)(ws + WS_WO_T);
    float* MOD = (float*)(ws + WS_MOD); float* NW1 = (float*)(ws + WS_NW1); float* SB = (float*)(ws + WS_SB);
    float* ROPEC = (float*)(ws + WS_ROPE); float* ROPES = ROPEC + 64 * 16;
    float* SSP = (float*)(ws + WS_SSP); float* XCTX = (float*)(ws + WS_XCTX);
    bf16_t* XS = (bf16_t*)(ws + WS_XS); bf16_t* P = (bf16_t*)(ws + WS_P);
    float* OUT = a.out;
    volatile LAS unsigned* MISC = (volatile LAS unsigned*)(lds + 131072);
    if (threadIdx.x < 64) MISC[threadIdx.x] = 0u;
    __syncthreads();
    XcdBarrier xbar; xbar.bar = (unsigned*)(ws + WS_CTL); xbar.x = 0; xbar.st = nullptr;
    if (a.coop) xbar = xcd_barrier_post((unsigned*)(ws + WS_CTL), MISC + 8);

    for (int ph = a.ph_lo; ph < a.ph_hi; ++ph) {
#define PH_PROLOG int tid = threadIdx.x, bx = blockIdx.x; asm volatile("" : "+v"(tid), "+s"(bx)); const int lane = tid & 63, wave = __builtin_amdgcn_readfirstlane(tid >> 6); const int G = gridDim.x; const int gw = bx * 8 + wave, NGW = G * 8; (void)lane; (void)gw; (void)NGW;
#define DUP_ON(k) ((DUP_MASK >> (k)) & 1)
#if MK_COOP
#define SEAM_SYNC() do { if (a.coop) xcd_barrier(xbar); __syncthreads(); } while (0)
#else
#define SEAM_SYNC() do { } while (0)
#endif
        if (ph == 0 && (PHMASK & 1)) { PH_PROLOG
          for (int rep = DUP_ON(0) ? 0 : 1; rep < 2; ++rep) {
            constexpr int NMOD = DEPTH * 48;
            if (bx < NMOD) {
                LAS float* tab = (LAS float*)lds;
                for (int idx = tid; idx < 17 * 1024; idx += 512) { const int r = idx >> 10, k = idx & 1023; const float v = (r < 16) ? c_in[r * 1024 + k] : cctx_in[k]; tab[idx] = siluf_(v); }
                __syncthreads();
                for (int it = bx; it < NMOD; it += G) { const int l = it / 48, ec = it % 48;
                    rowmat17_item(tid, lds, w_mod + (size_t)l * 1024 * 3072, 3072, ec * 64, b_mod + l * 3072, MOD + (size_t)l * 17 * 3072, 3072); }
            }
            __syncthreads();
            if (bx == G - 1) { for (int idx = tid; idx < 64 * 16; idx += 512) { const int pos = idx >> 4, f = idx & 15; const float invf = powf(10000.0f, -(float)f / 16.0f); const float ang = (float)pos * invf;
                    ROPEC[idx] = cosf(ang); ROPES[idx] = sinf(ang); } }
            LAS float* scr = (LAS float*)(lds + wave * 16384);
            constexpr int I_IN = 16 * 168, I_A = 8 * 32, I_O = 16 * 32;
            constexpr int NITEMS = I_IN + DEPTH * (2 * I_A + I_O);
            for (int it = gw; it < NITEMS; it += NGW) {
                int r = it;
                if (r < I_IN) { transpose_item(w_in, NCOL, WIN_T, 1024, 0, 168, scr, r, lane); continue; } r -= I_IN;
                const int l = r / (2 * I_A + I_O); r -= l * (2 * I_A + I_O);
                if (r < I_A) { transpose_item(w_a_out + (size_t)l * 512 * 1024, 1024, WAB_T + (size_t)l * 1024 * 1024, 1024, 0, 32, scr, r, lane); continue; } r -= I_A;
                if (r < I_A) { transpose_item(w_b_out + (size_t)l * 512 * 1024, 1024, WAB_T + (size_t)l * 1024 * 1024, 1024, 512, 32, scr, r, lane); continue; } r -= I_A;
                transpose_item(w_o + (size_t)l * 1024 * 1024, 1024, WO_T + (size_t)l * 1024 * 1024, 1024, 0, 32, scr, r, lane);
            }
            if (rep == 0) SEAM_SYNC();
          }
        } else if (ph == 1 && (PHMASK & 2)) { PH_PROLOG
          for (int rep = DUP_ON(1) ? 0 : 1; rep < 2; ++rep) {
            constexpr int NSB = DEPTH * 84;
            { int curl = -1;
              for (int it = bx; it < NSB; it += G) { const int l = it / 84, nc = it % 84;
                if (l != curl) { __syncthreads(); LAS float* tab = (LAS float*)lds;
                    for (int idx = tid; idx < 17 * 1024; idx += 512) { const int r = idx >> 10, k = idx & 1023; tab[idx] = MOD[((size_t)l * 17 + r) * 3072 + k]; }
                    __syncthreads(); curl = l; }
                rowmat17_item(tid, lds, w_in + (size_t)l * 1024 * NCOL, NCOL, nc * 64, nullptr, SB + (size_t)l * 17 * NCOL, NCOL); } }
            for (int idx = bx * 512 + tid; idx < DEPTH * 17 * 1024; idx += G * 512) { const int k = idx & 1023, lr = idx >> 10, l = lr / 17;
                NW1[idx] = norm_w[l * 1024 + k] * (1.0f + MOD[(size_t)lr * 3072 + 1024 + k]); }
            for (int row = gw; row < TT; row += NGW) {
                const bool lat = row < TL; const int b = lat ? (row >> 11) : 16;
                const f32x4* xr = (const f32x4*)(lat ? x_in + (size_t)row * DM : ctx_in + (size_t)(row - TL) * DM) + lane;
                const f32x4* nwp = (const f32x4*)norm_w + lane; const f32x4* scp = (const f32x4*)(MOD + (size_t)b * 3072 + 1024) + lane;
                f32x4 v[4]; float s = 0.f;
#pragma unroll
                for (int j = 0; j < 4; ++j) { v[j] = xr[64 * j]; s += (v[j][0] * v[j][0] + v[j][1] * v[j][1]) + (v[j][2] * v[j][2] + v[j][3] * v[j][3]); }
                s = wave_sum(s);
                u32x2* o8 = (u32x2*)(XS + (size_t)row * DM) + lane;
#pragma unroll
                for (int j = 0; j < 4; ++j) { const f32x4 hh = v[j] * (nwp[64 * j] * (scp[64 * j] + 1.0f)); u32x2 w; w.x = cvt_pk_bf16(hh[0], hh[1]); w.y = cvt_pk_bf16(hh[2], hh[3]); o8[64 * j] = w; }
                if (lane < 16) SSP[(size_t)row * 16 + lane] = (lane == 0) ? s : 0.f;
            }
            if (rep == 0) SEAM_SYNC();
          }
        } else if (ph == NPHASE - 1 && (PHMASK & 4)) { PH_PROLOG
            for (int row = gw; row < TL; row += NGW) {
                float s = SSP[(size_t)row * 16 + (lane & 15)];
                s += __shfl_xor(s, 1); s += __shfl_xor(s, 2); s += __shfl_xor(s, 4); s += __shfl_xor(s, 8);
                const float rinv = 1.0f / sqrtf(s * (1.0f / 1024.0f) + RMS_EPS);
                f32x4* xr = (f32x4*)(OUT + (size_t)row * DM) + lane; const f32x4* fw = (const f32x4*)fnorm_w + lane;
#pragma unroll
                for (int j = 0; j < 4; ++j) { const f32x4 v = xr[64 * j]; f32x4 o = v * rinv * fw[64 * j];
                    xr[64 * j] = o; }
            }
        } else {
            const int l = (ph - 2) >> 2, sub = (ph - 2) & 3;
            const bool lastl = (l == DEPTH - 1);
            if (sub == 0 && (PHMASK & 8)) { PH_PROLOG
                pg8::Gemm g{XS, WIN_T, DM, DM};
                pg8::Order S; if (!lastl) S.init(TT / 256, NCOL / 256, G, bx); else S.init(TL / 256, NCOL / 256, G, bx, NB, TL / 256, 10);
                for (int rep = DUP_ON(3) ? 0 : 1; rep < 2; ++rep) { EpiG1 E{P, SSP, SB + (size_t)l * 17 * NCOL, ROPEC, ROPES, rep == 0 ? PROBE_SKIP : 0};
                    pg8::gemm_phase<EpiG1, pg8::Order, true>(lds, g, S, E); if (rep == 0) SEAM_SYNC(); }
            } else if (sub == 1 && (PHMASK & 16)) { PH_PROLOG
                const float* sink = attn_sink + l * 8;
                const int nlat = 1024, nctx = lastl ? 0 : 128;
              for (int rep = DUP_ON(4) ? 0 : 1; rep < 2; ++rep) {
                bf16_t* Oo = rep ? P : XS; const int opitch = rep ? NCOL : 1024, ocol = rep ? C_Q : 512, ycol = rep ? C_ZA : 0;
                for (int ua = bx; ua < nlat + nctx; ua += G) {
                    if (ua < nlat) {
                        const int b = ua >> 6, rem = ua & 63, qblk = rem >> 2, kh = (rem >> 1) & 1, hp = rem & 1;
                        const int h = kh * 4 + hp * 2 + (wave >> 2);
                        const int jlo = (qblk == 0) ? 2 : 0, jhi = (qblk == 15) ? 4 : 6;
                        attn_unit(lds, P, Oo, opitch, ocol, b * SEQ + qblk * 128 + (wave & 3) * 32, h, kh, (wave & 3) * 32, jhi - jlo, jlo, b * SEQ + qblk * 128 - 128, TL + b * CTXL, sink[h] * LOG2E);
                    } else {
                        const int uc = ua - nlat, b = uc >> 3, h = uc & 7;
                        attn_unit(lds, P, Oo, opitch, ocol, TL + b * CTXL + wave * 32, h, h >> 2, 0, 0, 0, 0, TL + b * CTXL, sink[h] * LOG2E);
                    }
                }
                __syncthreads();
                const int nruns = (lastl ? TL : TT) / 16;
                const int ntr = lastl ? 0 : 16 * 168;
                LAS float* scr = (LAS float*)(lds + wave * 16384);
                for (int it = (NGW - 1 - gw); it < nruns + ntr; it += NGW) {
                    if (it < nruns) conv_run(P, Oo, opitch, ycol, conv_w + (size_t)l * 3 * 512, it, lane);
                    else transpose_item(w_in + (size_t)(l + 1) * 1024 * NCOL, NCOL, WIN_T, 1024, 0, 168, scr, it - nruns, lane);
                }
                if (rep == 0) SEAM_SYNC();
              }
            } else if (sub == 2 && (PHMASK & 32)) { PH_PROLOG
                pg8::Gemm g{P + C_ZA, WAB_T + (size_t)l * 1024 * 1024, NCOL, DM};
                pg8::Order S; S.init((lastl ? TL : TT) / 256, 4, G, bx);
                for (int rep = DUP_ON(5) ? 0 : 1; rep < 2; ++rep) {
                    EpiG2 E{P, rep ? P : XS, rep ? NCOL : 1024, rep ? C_GA : 0};
                    pg8::gemm_phase<EpiG2, pg8::Order, true>(lds, g, S, E); if (rep == 0) SEAM_SYNC(); }
            } else if (PHMASK & 64) { PH_PROLOG
                pg8::Gemm g{P + C_GA, WO_T + (size_t)l * 1024 * 1024, NCOL, DM};
                pg8::Order S; S.init((lastl ? TL : TT) / 256, 4, G, bx);
                for (int rep = DUP_ON(6) ? 0 : 1; rep < 2; ++rep) {
                    EpiG3 E{l == 0 ? x_in : OUT, l == 0 ? ctx_in : XCTX, OUT, XCTX, (rep == 0 && l > 0) ? nullptr : MOD + (size_t)l * 17 * 3072 + 2048, lastl ? nullptr : NW1 + (size_t)(l + 1) * 17 * 1024, XS, SSP};
                    pg8::gemm_phase<EpiG3, pg8::Order, true>(lds, g, S, E); if (rep == 0) SEAM_SYNC(); }
            }
        }
        if (ph + 1 < a.ph_hi) {
#if MK_COOP
            if (a.coop) { if (ph == 0) cg::this_grid().sync(); else xcd_barrier(xbar); }
#endif
            __syncthreads();
        }
    }
}

extern "C" void kernel_launch(void* const* d_in, const int* in_sizes, int n_in, void* d_out, int out_size, void* d_ws, size_t ws_size, hipStream_t stream) {
    static int grid = 0;
    if (grid == 0) {
        if (n_in != 14 || in_sizes[0] != TL * DM || out_size != TL * DM || ws_size < WS_END) {
            fprintf(stderr, "kernel_launch: unexpected shapes (n_in %d, in0 %d, out %d, ws %zu need %zu); nothing launched\n", n_in, n_in > 0 ? in_sizes[0] : -1, out_size, ws_size, (size_t)WS_END); grid = -1; return; }
        int dev = 0, cus = 0;
        if (hipGetDevice(&dev) != hipSuccess || hipDeviceGetAttribute(&cus, hipDeviceAttributeMultiprocessorCount, dev) != hipSuccess || cus <= 0) cus = 256;
        if (hipFuncSetAttribute((const void*)fwd_kernel, hipFuncAttributeMaxDynamicSharedMemorySize, LDS_BYTES) != hipSuccess) { fprintf(stderr, "kernel_launch: hipFuncSetAttribute failed\n"); grid = -1; return; }
        int per_cu = 0;
        if (hipOccupancyMaxActiveBlocksPerMultiprocessor(&per_cu, (const void*)fwd_kernel, 512, LDS_BYTES) != hipSuccess || per_cu < 1) { fprintf(stderr, "kernel_launch: occupancy query says %d\n", per_cu); (void)hipGetLastError(); }
        grid = cus;
    }
    if (grid < 0) return;
    Args a{};
    for (int i = 0; i < 14; ++i) a.in[i] = (const float*)d_in[i];
    a.out = (float*)d_out; a.ws = (unsigned char*)d_ws;
#if MK_COOP
    if (hipMemsetAsync((char*)d_ws + WS_CTL, 0, CTL_ZERO_BYTES, stream) != hipSuccess) { fprintf(stderr, "kernel_launch: memset failed\n"); return; }
    a.ph_lo = 0; a.ph_hi = NPHASE; a.coop = 1;
    void* args[] = {&a};
    hipError_t e = hipLaunchCooperativeKernel((const void*)fwd_kernel, dim3(grid), dim3(512), args, LDS_BYTES, stream);
    if (e != hipSuccess) fprintf(stderr, "cooperative launch failed: %s (grid %d)\n", hipGetErrorString(e), grid);
#else
    for (int ph = 0; ph < NPHASE; ++ph) {
        a.ph_lo = ph; a.ph_hi = ph + 1; a.coop = 0;
        hipLaunchKernelGGL(fwd_kernel, dim3(grid), dim3(512), LDS_BYTES, stream, a);
    }
#endif
}
```

```cpp
#include <hip/hip_runtime.h>
#include <hip/hip_cooperative_groups.h>
#include <cstdio>
#include <cstdint>
namespace cg = cooperative_groups;

#ifndef PHMASK
#define PHMASK 127
#endif
#ifndef PROBE_SKIP
#define PROBE_SKIP 0
#endif
#ifndef PROBE_STAGGER
#define PROBE_STAGGER 0
#endif
#ifndef PROBE_AT
#define PROBE_AT 0
#endif
#ifndef PROBE_ATV
#define PROBE_ATV 0
#endif
#ifndef ATTN_V3
#define ATTN_V3 1
#endif
#ifndef RESID_BF16
#define RESID_BF16 0
#endif
#ifndef DUP_MASK
#define DUP_MASK 0
#endif
#ifndef MK_COOP
#define MK_COOP 1
#endif

#define LAS __attribute__((address_space(3)))
typedef unsigned short bf16_t;
typedef short bf16x8 __attribute__((ext_vector_type(8)));
typedef short s16x4 __attribute__((ext_vector_type(4)));
typedef short v4i16_t __attribute__((ext_vector_type(4)));
typedef float f32x4 __attribute__((ext_vector_type(4)));
typedef float f32x16 __attribute__((ext_vector_type(16)));
typedef unsigned u32x4 __attribute__((ext_vector_type(4)));
typedef unsigned u32x2 __attribute__((ext_vector_type(2)));

constexpr int DM = 1024, NB = 16, SEQ = 2048, CTXL = 256, DEPTH = 4, NCOL = 5376;
constexpr int TL = NB * SEQ, TC = NB * CTXL, TT = TL + TC;
constexpr int C_B = 0, C_C = 512, C_U = 1024, C_ZA = 1536, C_Q = 2048, C_K = 2560, C_V = 2688, C_ZB = 2816, C_GA = 3328, C_GB = 4352;
constexpr float RMS_EPS = 1e-6f;
constexpr float LOG2E = 1.4426950408889634f;
constexpr float QSCALE = 0.125f * LOG2E;

constexpr size_t MiB = 1u << 20;
constexpr size_t WS_CTL = 0, CTL_ZERO_BYTES = 65536;
constexpr size_t WS_WIN_T = 1 * MiB;
constexpr size_t WS_WAB_T = 12 * MiB;
constexpr size_t WS_WO_T = 20 * MiB;
constexpr size_t WS_MOD = 28 * MiB;
constexpr size_t WS_NW1 = 29 * MiB;
constexpr size_t WS_SB = 30 * MiB;
constexpr size_t WS_ROPE = 32 * MiB;
constexpr size_t WS_SSP = 33 * MiB;
constexpr size_t WS_XCTX = 36 * MiB;
constexpr size_t WS_XS = 52 * MiB;
constexpr size_t WS_P = 124 * MiB;
constexpr size_t WS_END = WS_P + (size_t)TT * NCOL * 2;
static_assert(WS_END <= 502 * MiB, "ws map");

constexpr int LDS_EPI_OFF = 131072 + 1024;
constexpr int LDS_ROPE_OFF = 131072 + 1024 + 2048;
constexpr int LDS_BYTES = 131072 + 1024 + 2048 + 8192;
constexpr int NPHASE = 2 + 4 * DEPTH + 1;

struct Args { const float* in[14]; float* out; unsigned char* ws; int ph_lo, ph_hi, coop, pad; };

__device__ __forceinline__ unsigned cvt_pk_bf16(float lo, float hi) { unsigned r; asm volatile("v_cvt_pk_bf16_f32 %0, %1, %2" : "=v"(r) : "v"(lo), "v"(hi)); return r; }
__device__ __forceinline__ float bf_lo(unsigned w) { return __uint_as_float(w << 16); }
__device__ __forceinline__ float bf_hi(unsigned w) { return __uint_as_float(w & 0xffff0000u); }
__device__ __forceinline__ float fast_exp(float x) { return __builtin_amdgcn_exp2f(x * LOG2E); }
__device__ __forceinline__ float sigmoidf_(float x) { return __builtin_amdgcn_rcpf(1.0f + fast_exp(-x)); }
__device__ __forceinline__ float siluf_(float x) { return x * sigmoidf_(x); }
__device__ __forceinline__ float shx(float v, int lane, int m) { return __int_as_float(__builtin_amdgcn_ds_bpermute((lane ^ m) << 2, __float_as_int(v))); }
__device__ __forceinline__ float shl_(float v, int src) { return __int_as_float(__builtin_amdgcn_ds_bpermute(src << 2, __float_as_int(v))); }
__device__ __forceinline__ float wave_sum(float v, int lane) {
#pragma unroll
    for (int o = 1; o < 64; o <<= 1) v += shx(v, lane, o);
    return v;
}
__device__ __forceinline__ int lane_id_() { int r; asm volatile("v_mbcnt_lo_u32_b32 %0, -1, 0\n\tv_mbcnt_hi_u32_b32 %0, -1, %0" : "=v"(r)); return r; }
#define LDS_WAIT() asm volatile("s_waitcnt lgkmcnt(0)" ::: "memory")
#define VM_WAIT() asm volatile("s_waitcnt vmcnt(0)" ::: "memory")

namespace pg8 {
constexpr int BM = 256, BK = 64, HALF = 128, HTB = HALF * BK * 2, STAGE_BYTES = 8 * HTB, NXCD = 8, WGM = 8;
__host__ __device__ __forceinline__ int lds_byte(int r, int c) { const int st = (r >> 4) * 2 + (c >> 5), rr = r & 15, cc = c & 31, ob = rr * 64 + cc * 2; return st * 1024 + (ob ^ (((ob >> 9) & 1) << 5)); }
__host__ __device__ __forceinline__ void stage_rc(int b, int& R, int& C) { const int st = b / 1024, sb = b % 1024, swz = sb ^ (((sb >> 9) & 1) << 5); R = (st >> 1) * 16 + swz / 64; C = (st & 1) * 32 + (swz % 64) / 2; }
__host__ __device__ __forceinline__ int perm32(int rho) { const int n = rho >> 4, i = rho & 15; return 8 * (i >> 2) + 4 * n + (i & 3); }

struct Unit { int pm, pn; };
struct Gemm { const bf16_t* A; const bf16_t* Bt; int lda; int K; };

struct Order {
    int nM, nN, nwg, G, c, nextra, extra_pm0, extra_pn;
    __device__ void init(int nM_, int nN_, int G_, int c_, int nextra_ = 0, int epm0 = 0, int epn = 0) { nM = nM_; nN = nN_; nwg = nM * nN; G = G_; c = c_; nextra = nextra_; extra_pm0 = epm0; extra_pn = epn; }
    __device__ bool next(int i, Unit& u) const {
        const long L = (long)i * G + c; if (L >= nwg + nextra) return false;
        if (L >= nwg) { u.pm = extra_pm0 + (int)(L - nwg); u.pn = extra_pn; return true; }
        int wgid = (int)L; { const int q = nwg / NXCD, r = nwg % NXCD, xcd = wgid % NXCD, off = wgid / NXCD; wgid = (xcd < r ? xcd * (q + 1) : r * (q + 1) + (xcd - r) * q) + off; }
        const int nig = WGM * nN, gid = wgid / nig, fm = gid * WGM, gsz = (nM - fm) < WGM ? (nM - fm) : WGM;
        u.pm = fm + ((wgid % nig) % gsz); u.pn = (wgid % nig) / gsz; return true;
    }
};

template <class Epi, class Sched, bool ALIGN_EPI>
__device__ __forceinline__ void gemm_phase(int tid_in, LAS unsigned char* lds, const Gemm g, const Sched& S, const Epi& E, unsigned stagger_ticks = 0) {
    if (stagger_ticks) { const unsigned long long t0_ = __builtin_amdgcn_s_memrealtime(); while (__builtin_amdgcn_s_memrealtime() - t0_ < stagger_ticks) __builtin_amdgcn_s_sleep(8); }
    int tid = tid_in; asm volatile("" : "+v"(tid));
    const int wid = __builtin_amdgcn_readfirstlane(tid >> 6), lane = tid & 63, wr = wid >> 2, wc = wid & 3, fr = lane & 15, fq = lane >> 4;
    const int K = g.K, nt = K / BK, lda = g.lda;
    unsigned voffA[2], voffB[2];
#pragma unroll
    for (int i = 0; i < 2; ++i) { int R, C; stage_rc(tid * 16 + i * 8192, R, C); const int Rb = Epi::PERM ? ((R & ~31) + perm32(R & 31)) : R;
        voffA[i] = (unsigned)(R * lda + C) * 2u; voffB[i] = (unsigned)(Rb * K + C) * 2u; }
    const size_t kstep = (size_t)(BK * 2);
    const size_t hstepA = (size_t)HALF * lda * 2, tstepA = 2 * hstepA;
    const size_t hstepB = (size_t)HALF * K * 2, tstepB = 2 * hstepB;
    const unsigned ldsw = (unsigned)wid * 1024u;
    const int aoff = lds_byte(wr * 64 + fr, fq * 8), boff = lds_byte(wc * 32 + fr, fq * 8);
#define PG8_SA(b, h) (((b) * 2 + (h)) * HTB)
#define PG8_SB(b, h) ((4 + (b) * 2 + (h)) * HTB)
#define PG8_STAGE(bufoff, gbase, voff) do { _Pragma("unroll") for (int _i = 0; _i < 2; ++_i) \
        __builtin_amdgcn_global_load_lds((const unsigned*)((const char*)(gbase) + (voff)[_i]), (LAS unsigned*)(lds + (bufoff) + ldsw + _i * 8192), 16, 0, 0); } while (0)
#define PG8_LDA(dst, b, h) do { _Pragma("unroll") for (int m = 0; m < 4; ++m) _Pragma("unroll") for (int k = 0; k < 2; ++k) dst[m][k] = *(const LAS bf16x8*)(lds + PG8_SA(b, h) + aoff + m * 2048 + k * 1024); } while (0)
#define PG8_LDB(dst, b, h) do { _Pragma("unroll") for (int n = 0; n < 2; ++n) _Pragma("unroll") for (int k = 0; k < 2; ++k) dst[n][k] = *(const LAS bf16x8*)(lds + PG8_SB(b, h) + boff + n * 2048 + k * 1024); } while (0)
#define PG8_MMA(ai, bj, At, Bt) do { __builtin_amdgcn_s_setprio(1); _Pragma("unroll") for (int m = 0; m < 4; ++m) _Pragma("unroll") for (int n = 0; n < 2; ++n) _Pragma("unroll") for (int k = 0; k < 2; ++k) \
        acc[ai][bj][m][n] = __builtin_amdgcn_mfma_f32_16x16x32_bf16(Bt[n][k], At[m][k], acc[ai][bj][m][n], 0, 0, 0); __builtin_amdgcn_s_setprio(0); } while (0)
#define PG8_WAIT_V(n) asm volatile("s_waitcnt vmcnt(" #n ")" ::: "memory")
#define PG8_WAIT_L(n) asm volatile("s_waitcnt lgkmcnt(" #n ")" ::: "memory")
#define PG8_BAR __builtin_amdgcn_s_barrier()
#define PG8_SCHED __builtin_amdgcn_sched_barrier(0)
    Unit cur, nxt; int ui = 0;
    if (!S.next(0, cur)) return;
    f32x4 acc[2][2][4][2];
#pragma unroll
    for (int a = 0; a < 2; ++a)
#pragma unroll
        for (int b = 0; b < 2; ++b)
#pragma unroll
            for (int m = 0; m < 4; ++m)
#pragma unroll
                for (int n = 0; n < 2; ++n) acc[a][b][m][n] = (f32x4){0.f, 0.f, 0.f, 0.f};
    bf16x8 At[4][2], B0[2][2], B1[2][2];
    const char* cA = (const char*)g.A + (size_t)cur.pm * tstepA; const char* cB = (const char*)g.Bt + (size_t)cur.pn * tstepB;
    PG8_STAGE(PG8_SB(0, 0), cB, voffB); PG8_STAGE(PG8_SB(0, 1), cB + hstepB, voffB); PG8_STAGE(PG8_SA(0, 0), cA, voffA); PG8_STAGE(PG8_SA(0, 1), cA + hstepA, voffA);
    if (wr == 1) PG8_BAR;
    PG8_WAIT_V(2); PG8_BAR;
    PG8_STAGE(PG8_SB(1, 0), cB + kstep, voffB); PG8_STAGE(PG8_SA(1, 0), cA + kstep, voffA); PG8_STAGE(PG8_SB(1, 1), cB + hstepB + kstep, voffB);
    PG8_WAIT_V(6); PG8_BAR;
    for (;;) {
        const bool has_next = S.next(ui + 1, nxt);
        const char* nA = has_next ? (const char*)g.A + (size_t)nxt.pm * tstepA : cA; const char* nB = has_next ? (const char*)g.Bt + (size_t)nxt.pn * tstepB : cB;
        for (int t = 0; t < nt; t += 2) {
            if constexpr (Epi::HOOK) { if (t == (nt >> 1)) E.mid(acc, cur, wr, wc, fr, fq); }
            const bool last = (t == nt - 2);
            const char* a1 = cA + (size_t)(t + 1) * kstep;
            const char* a2 = last ? nA : cA + (size_t)(t + 2) * kstep; const char* b2 = last ? nB : cB + (size_t)(t + 2) * kstep;
            const char* a3 = a2 + kstep; const char* b3 = b2 + kstep;
            PG8_LDB(B0, 0, 0); PG8_LDB(B1, 0, 1); PG8_SCHED; PG8_LDA(At, 0, 0); PG8_STAGE(PG8_SA(1, 1), a1 + hstepA, voffA);
            PG8_WAIT_V(8); PG8_WAIT_L(0); PG8_BAR; PG8_MMA(0, 0, At, B0); PG8_MMA(0, 1, At, B1); PG8_BAR; PG8_SCHED;
            PG8_LDA(At, 0, 1); PG8_STAGE(PG8_SB(0, 0), b2, voffB); PG8_STAGE(PG8_SB(0, 1), b2 + hstepB, voffB); PG8_STAGE(PG8_SA(0, 0), a2, voffA);
            PG8_WAIT_V(8); PG8_WAIT_L(0); PG8_BAR; PG8_MMA(1, 0, At, B0); PG8_MMA(1, 1, At, B1); PG8_BAR; PG8_SCHED;
            PG8_LDB(B0, 1, 0); PG8_LDB(B1, 1, 1); PG8_SCHED; PG8_LDA(At, 1, 0); PG8_STAGE(PG8_SA(0, 1), a2 + hstepA, voffA);
            PG8_WAIT_V(8); PG8_WAIT_L(0); PG8_BAR; PG8_MMA(0, 0, At, B0); PG8_MMA(0, 1, At, B1); PG8_BAR; PG8_SCHED;
            PG8_LDA(At, 1, 1); PG8_STAGE(PG8_SB(1, 0), b3, voffB); PG8_STAGE(PG8_SB(1, 1), b3 + hstepB, voffB); PG8_STAGE(PG8_SA(1, 0), a3, voffA);
            PG8_WAIT_V(8); PG8_WAIT_L(0); PG8_BAR; PG8_MMA(1, 0, At, B0); PG8_MMA(1, 1, At, B1); PG8_BAR; PG8_SCHED;
        }
        if constexpr (ALIGN_EPI) { if (wr == 0) PG8_BAR; }
        E(acc, cur, wr, wc, fr, fq);
        if (!has_next) break;
#pragma unroll
        for (int a = 0; a < 2; ++a)
#pragma unroll
            for (int b = 0; b < 2; ++b)
#pragma unroll
                for (int m = 0; m < 4; ++m)
#pragma unroll
                    for (int n = 0; n < 2; ++n) acc[a][b][m][n] = (f32x4){0.f, 0.f, 0.f, 0.f};
        cur = nxt; cA = nA; cB = nB; ++ui;
        if constexpr (ALIGN_EPI) { if (wr == 1) PG8_BAR; }
    }
    PG8_WAIT_V(0);
    if constexpr (!ALIGN_EPI) { if (wr == 0) PG8_BAR; }
    PG8_BAR;
#undef PG8_SA
#undef PG8_SB
#undef PG8_STAGE
#undef PG8_LDA
#undef PG8_LDB
#undef PG8_MMA
#undef PG8_WAIT_V
#undef PG8_WAIT_L
#undef PG8_BAR
#undef PG8_SCHED
}
}

struct EpiG1 {
    static constexpr bool PERM = true, HOOK = false;
    bf16_t* P; const float* ssp; const float* sb; LAS unsigned char* ldsc; int skip;
    __device__ __forceinline__ void mid(f32x4 (&)[2][2][4][2], const pg8::Unit&, int, int, int, int) const {}
    __device__ __forceinline__ void operator()(const f32x4 (&acc)[2][2][4][2], const pg8::Unit& u, int wr, int wc, int fr, int fq) const {
        if (skip == 2) { if (acc[0][0][0][0][0] == 12345.678f) P[0] = 1; return; }
        asm volatile("" : "+v"(fr), "+v"(fq));
        const bool latent = u.pm < 128;
        const int bidx = latent ? (u.pm >> 3) : 16;
        const int col8 = u.pn * 256 + wc * 32 + 8 * fq;
        const float* sbr = sb + bidx * NCOL + col8;
        f32x4 bv[2][2];
#pragma unroll
        for (int bj = 0; bj < 2; ++bj)
#pragma unroll
            for (int n = 0; n < 2; ++n) bv[bj][n] = *(const f32x4*)(sbr + bj * 128 + n * 4);
        const bool isq = (u.pn == 8 || u.pn == 9), isk = (u.pn == 10);
        const bool anyrope = latent && (isq || isk);
        const float sc = isq ? QSCALE : 1.0f;
        float rinv[8];
        {
            const int ln = fq * 16 + fr;
            f32x4 pv[8];
#pragma unroll
            for (int i = 0; i < 8; ++i) pv[i] = *(const f32x4*)(ssp + (size_t)(u.pm * 256 + (i >> 2) * 128 + wr * 64 + (i & 3) * 16 + (ln >> 2)) * 16 + (ln & 3) * 4);
#pragma unroll
            for (int i = 0; i < 8; ++i) { float q = (pv[i][0] + pv[i][1]) + (pv[i][2] + pv[i][3]); q += shx(q, ln, 1); q += shx(q, ln, 2);
                const float r = 1.0f / sqrtf(q * (1.0f / 1024.0f) + RMS_EPS); rinv[i] = shl_(r, 4 * fr); }
        }
        const unsigned lo = (unsigned)((wr * 64 + fr) * NCOL + col8);
        bf16_t* pb = P + (size_t)u.pm * 256 * NCOL;
        if (!anyrope) {
#pragma unroll
            for (int ai = 0; ai < 2; ++ai)
#pragma unroll
                for (int m = 0; m < 4; ++m) {
                    const float ri = rinv[ai * 4 + m];
                    bf16_t* rowp = pb + (size_t)(ai * 128 + m * 16) * NCOL;
#pragma unroll
                    for (int bj = 0; bj < 2; ++bj) {
                        const f32x4 v0 = (acc[ai][bj][m][0] * ri + bv[bj][0]) * sc, v1 = (acc[ai][bj][m][1] * ri + bv[bj][1]) * sc;
                        u32x4 w; w.x = cvt_pk_bf16(v0[0], v0[1]); w.y = cvt_pk_bf16(v0[2], v0[3]); w.z = cvt_pk_bf16(v1[0], v1[1]); w.w = cvt_pk_bf16(v1[2], v1[3]);
                        *(u32x4*)(rowp + (lo + (unsigned)(bj * 128))) = w;
                    }
                }
        } else {
            const LAS f32x4* tc4 = (const LAS f32x4*)(ldsc + LDS_ROPE_OFF);
            const LAS f32x4* ts4 = tc4 + 256;
            const float sgn = (fq < 2) ? -1.0f : 1.0f;
            const bool oddw = (wc & 1) != 0;
#pragma unroll
            for (int ai = 0; ai < 2; ++ai)
#pragma unroll
                for (int m = 0; m < 4; ++m) {
                    const int t = (u.pm * 256 + ai * 128 + wr * 64 + m * 16 + fr) & 2047;
                    const int pos = oddw ? (t & 63) : (t >> 6);
                    const int ti = pos * 4 + (fq & 1) * 2;
                    const f32x4 c0 = tc4[ti], c1 = tc4[ti + 1], s0 = ts4[ti], s1 = ts4[ti + 1];
                    const float ri = rinv[ai * 4 + m];
                    bf16_t* rowp = pb + (size_t)(ai * 128 + m * 16) * NCOL;
#pragma unroll
                    for (int bj = 0; bj < 2; ++bj) {
                        f32x4 v0 = acc[ai][bj][m][0] * ri + bv[bj][0], v1 = acc[ai][bj][m][1] * ri + bv[bj][1];
                        if (isq || bj == 0) {
                            f32x4 p0, p1;
#pragma unroll
                            for (int e = 0; e < 4; ++e) { p0[e] = shx(v0[e], fq * 16 + fr, 32); p1[e] = shx(v1[e], fq * 16 + fr, 32); }
                            v0 = v0 * c0 + (p0 * s0) * sgn; v1 = v1 * c1 + (p1 * s1) * sgn;
                        }
                        v0 = v0 * sc; v1 = v1 * sc;
                        u32x4 w; w.x = cvt_pk_bf16(v0[0], v0[1]); w.y = cvt_pk_bf16(v0[2], v0[3]); w.z = cvt_pk_bf16(v1[0], v1[1]); w.w = cvt_pk_bf16(v1[2], v1[3]);
                        *(u32x4*)(rowp + (lo + (unsigned)(bj * 128))) = w;
                    }
                }
        }
    }
};

struct EpiG2 {
    static constexpr bool PERM = true, HOOK = true;
    const bf16_t* P; bf16_t* Mout; int ldm, mcol;
    __device__ __forceinline__ void mid(f32x4 (&acc)[2][2][4][2], const pg8::Unit& u, int wr, int wc, int fr, int fq) const {
        int col8 = u.pn * 256 + wc * 32 + 8 * fq, rbase = u.pm * 256 + wr * 64 + fr;
        asm volatile("" : "+v"(col8), "+v"(rbase));
#pragma unroll
        for (int ai = 0; ai < 2; ++ai) {
            u32x4 ga[4][2], gb[4][2];
#pragma unroll
            for (int m = 0; m < 4; ++m) { const bf16_t* rowp = P + (size_t)(rbase + ai * 128 + m * 16) * NCOL + col8;
#pragma unroll
                for (int bj = 0; bj < 2; ++bj) { ga[m][bj] = *(const u32x4*)(rowp + C_GA + bj * 128); gb[m][bj] = *(const u32x4*)(rowp + C_GB + bj * 128); } }
#pragma unroll
            for (int m = 0; m < 4; ++m)
#pragma unroll
                for (int bj = 0; bj < 2; ++bj)
#pragma unroll
                    for (int w = 0; w < 4; ++w) {
                        const float a0 = bf_lo(ga[m][bj][w]), a1 = bf_hi(ga[m][bj][w]), b0 = bf_lo(gb[m][bj][w]), b1 = bf_hi(gb[m][bj][w]);
                        const float r0 = (1.0f + fast_exp(-b0)) * __builtin_amdgcn_rcpf(1.0f + fast_exp(-a0));
                        const float r1 = (1.0f + fast_exp(-b1)) * __builtin_amdgcn_rcpf(1.0f + fast_exp(-a1));
                        acc[ai][bj][m][w >> 1][(w & 1) * 2] *= r0; acc[ai][bj][m][w >> 1][(w & 1) * 2 + 1] *= r1;
                    }
            asm volatile("" ::: "memory");
        }
    }
    __device__ __forceinline__ void operator()(const f32x4 (&acc)[2][2][4][2], const pg8::Unit& u, int wr, int wc, int fr, int fq) const {
        asm volatile("" : "+v"(fr), "+v"(fq));
        const int col8 = u.pn * 256 + wc * 32 + 8 * fq, rbase = u.pm * 256 + wr * 64 + fr;
        u32x4 gb[2][4][2];
#pragma unroll
        for (int ai = 0; ai < 2; ++ai)
#pragma unroll
            for (int m = 0; m < 4; ++m) { const bf16_t* rowp = P + (size_t)(rbase + ai * 128 + m * 16) * NCOL + col8;
#pragma unroll
                for (int bj = 0; bj < 2; ++bj) gb[ai][m][bj] = *(const u32x4*)(rowp + C_GB + bj * 128); }
#pragma unroll
        for (int ai = 0; ai < 2; ++ai)
#pragma unroll
            for (int m = 0; m < 4; ++m) {
                bf16_t* mrow = Mout + (size_t)(rbase + ai * 128 + m * 16) * ldm + mcol + col8;
#pragma unroll
                for (int bj = 0; bj < 2; ++bj) {
                    u32x4 o;
#pragma unroll
                    for (int w = 0; w < 4; ++w) {
                        const float s0 = sigmoidf_(bf_lo(gb[ai][m][bj][w])), s1 = sigmoidf_(bf_hi(gb[ai][m][bj][w]));
                        o[w] = cvt_pk_bf16(acc[ai][bj][m][w >> 1][(w & 1) * 2] * s0, acc[ai][bj][m][w >> 1][(w & 1) * 2 + 1] * s1);
                    }
                    *(u32x4*)(mrow + bj * 128) = o;
                }
            }
    }
};

#if RESID_BF16
typedef bf16_t resid_t;
#else
typedef float resid_t;
#endif
struct EpiG3 {
    static constexpr bool PERM = true, HOOK = false;
    const resid_t* xin_lat; const resid_t* xin_ctx; resid_t* xout_lat; resid_t* xout_ctx; const float* gate; const float* nw; bf16_t* xs; float* ssp; LAS unsigned char* ldsc;
    __device__ __forceinline__ void mid(f32x4 (&)[2][2][4][2], const pg8::Unit&, int, int, int, int) const {}
    __device__ __forceinline__ void operator()(f32x4 (&acc)[2][2][4][2], const pg8::Unit& u, int wr, int wc, int fr, int fq) const {
        asm volatile("" : "+v"(fr), "+v"(fq));
        const bool latent = u.pm < 128;
        const int bidx = latent ? (u.pm >> 3) : 16;
        const int col8 = u.pn * 256 + wc * 32 + 8 * fq;
        {
            f32x4 gv[2][2];
#pragma unroll
            for (int bj = 0; bj < 2; ++bj)
#pragma unroll
                for (int n = 0; n < 2; ++n) gv[bj][n] = gate ? *(const f32x4*)(gate + bidx * 3072 + col8 + bj * 128 + n * 4) : (f32x4){0.f, 0.f, 0.f, 0.f};
#pragma unroll
            for (int ai = 0; ai < 2; ++ai)
#pragma unroll
                for (int bj = 0; bj < 2; ++bj)
#pragma unroll
                    for (int m = 0; m < 4; ++m)
#pragma unroll
                        for (int n = 0; n < 2; ++n) acc[ai][bj][m][n] = acc[ai][bj][m][n] * gv[bj][n];
        }
        LAS f32x4* nvl = (LAS f32x4*)(ldsc + LDS_EPI_OFF + (wr * 4 + wc) * 256);
        if (nw) { const int ln = fq * 16 + fr; if (ln < 16) nvl[ln] = *(const f32x4*)(nw + bidx * 1024 + u.pn * 256 + wc * 32 + (ln >> 3) * 128 + ((ln >> 1) & 3) * 8 + (ln & 1) * 4); }
        unsigned lo = (unsigned)((wr * 64 + fr) * DM + col8); asm volatile("" : "+v"(lo));
        const resid_t* xib = latent ? xin_lat + (size_t)u.pm * 256 * DM : xin_ctx + (size_t)(u.pm * 256 - TL) * DM;
        resid_t* xob = latent ? xout_lat + (size_t)u.pm * 256 * DM : xout_ctx + (size_t)(u.pm * 256 - TL) * DM;
        bf16_t* xsb = xs + (size_t)u.pm * 256 * DM;
        float* sspb = ssp + (size_t)u.pm * 256 * 16 + u.pn * 4 + wc;
#if RESID_BF16
#pragma unroll
        for (int ai = 0; ai < 2; ++ai) {
            u32x4 xv[4][2];
#pragma unroll
            for (int m = 0; m < 4; ++m)
#pragma unroll
                for (int bj = 0; bj < 2; ++bj) xv[m][bj] = *(const u32x4*)(xib + (size_t)(ai * 128 + m * 16) * DM + (lo + (unsigned)(bj * 128)));
#pragma unroll
            for (int m = 0; m < 4; ++m) {
#else
#pragma unroll
        for (int ai = 0; ai < 2; ++ai)
#pragma unroll
        for (int mh = 0; mh < 2; ++mh) {
            f32x4 xv[2][2][2];
#pragma unroll
            for (int m2 = 0; m2 < 2; ++m2)
#pragma unroll
                for (int bj = 0; bj < 2; ++bj)
#pragma unroll
                    for (int n = 0; n < 2; ++n) xv[m2][bj][n] = *(const f32x4*)(xib + (size_t)(ai * 128 + (mh * 2 + m2) * 16) * DM + (lo + (unsigned)(bj * 128 + n * 4)));
#pragma unroll
            for (int m2 = 0; m2 < 2; ++m2) { const int m = mh * 2 + m2;
#endif
                resid_t* xo = xob + (size_t)(ai * 128 + m * 16) * DM; bf16_t* xsr = xsb + (size_t)(ai * 128 + m * 16) * DM;
                float q = 0.f;
#pragma unroll
                for (int bj = 0; bj < 2; ++bj) {
                    const unsigned off = lo + (unsigned)(bj * 128);
#if RESID_BF16
                    const u32x4 xr = xv[m][bj];
                    const f32x4 x0 = (f32x4){bf_lo(xr[0]), bf_hi(xr[0]), bf_lo(xr[1]), bf_hi(xr[1])} + acc[ai][bj][m][0];
                    const f32x4 x1 = (f32x4){bf_lo(xr[2]), bf_hi(xr[2]), bf_lo(xr[3]), bf_hi(xr[3])} + acc[ai][bj][m][1];
                    u32x4 w; w.x = cvt_pk_bf16(x0[0], x0[1]); w.y = cvt_pk_bf16(x0[2], x0[3]); w.z = cvt_pk_bf16(x1[0], x1[1]); w.w = cvt_pk_bf16(x1[2], x1[3]);
                    *(u32x4*)(xo + off) = w;
#else
                    const f32x4 x0 = xv[m2][bj][0] + acc[ai][bj][m][0], x1 = xv[m2][bj][1] + acc[ai][bj][m][1];
                    *(f32x4*)(xo + off) = x0; *(f32x4*)(xo + off + 4) = x1;
#endif
                    q += ((x0[0] * x0[0] + x0[1] * x0[1]) + (x0[2] * x0[2] + x0[3] * x0[3])) + ((x1[0] * x1[0] + x1[1] * x1[1]) + (x1[2] * x1[2] + x1[3] * x1[3]));
                    if (nw) { const f32x4 h0 = x0 * nvl[bj * 8 + fq * 2], h1 = x1 * nvl[bj * 8 + fq * 2 + 1];
                        u32x4 ws_; ws_.x = cvt_pk_bf16(h0[0], h0[1]); ws_.y = cvt_pk_bf16(h0[2], h0[3]); ws_.z = cvt_pk_bf16(h1[0], h1[1]); ws_.w = cvt_pk_bf16(h1[2], h1[3]);
                        *(u32x4*)(xsr + off) = ws_; }
                }
                q += shx(q, fq * 16 + fr, 16); q += shx(q, fq * 16 + fr, 32);
                if (fq == 0) sspb[(unsigned)((ai * 128 + wr * 64 + m * 16 + fr) * 16)] = q;
            }
            asm volatile("" ::: "memory");
        }
    }
};

__device__ __forceinline__ s16x4 vtr(const LAS unsigned char* p) { return __builtin_bit_cast(s16x4, __builtin_amdgcn_ds_read_tr16_b64_v4i16((LAS v4i16_t*)p)); }

struct AUnit { int rowQ0, h, kh, qq0, nloc, jlo, kr_loc0, kr_ctx0; };
__device__ __forceinline__ AUnit aunit(int ua, int wave, int nlat) {
    AUnit D;
    if (ua < nlat) { const int b = ua >> 6, rem = ua & 63, qblk = rem >> 2, kh = (rem >> 1) & 1, hp = rem & 1;
        D.h = kh * 4 + hp * 2 + (wave >> 2); D.kh = kh; D.qq0 = (wave & 3) * 32; D.rowQ0 = b * SEQ + qblk * 128 + D.qq0;
        D.jlo = (qblk == 0) ? 2 : 0; D.nloc = ((qblk == 15) ? 4 : 6) - D.jlo; D.kr_loc0 = b * SEQ + qblk * 128 - 128; D.kr_ctx0 = TL + b * CTXL;
    } else { const int uc = ua - nlat, b = uc >> 3, h = uc & 7;
        D.h = h; D.kh = h >> 2; D.qq0 = 0; D.rowQ0 = TL + b * CTXL + wave * 32; D.jlo = 0; D.nloc = 0; D.kr_loc0 = 0; D.kr_ctx0 = TL + b * CTXL; }
    return D;
}
__device__ __forceinline__ void wait_vm_n(int n) {
    switch (n) {
        case 2: asm volatile("s_waitcnt vmcnt(2)" ::: "memory"); break;
        case 8: asm volatile("s_waitcnt vmcnt(8)" ::: "memory"); break;
        case 10: asm volatile("s_waitcnt vmcnt(10)" ::: "memory"); break;
        case 12: asm volatile("s_waitcnt vmcnt(12)" ::: "memory"); break;
        case 14: asm volatile("s_waitcnt vmcnt(14)" ::: "memory"); break;
        case 16: asm volatile("s_waitcnt vmcnt(16)" ::: "memory"); break;
        case 18: asm volatile("s_waitcnt vmcnt(18)" ::: "memory"); break;
        case 20: asm volatile("s_waitcnt vmcnt(20)" ::: "memory"); break;
        case 22: asm volatile("s_waitcnt vmcnt(22)" ::: "memory"); break;
        default: asm volatile("s_waitcnt vmcnt(0)" ::: "memory"); break;
    }
}
__device__ __forceinline__ void attn_phase2(LAS unsigned char* lds, int tid, const bf16_t* P, bf16_t* Oout, int opitch, int ocol, const float* sink, int bx, int G, int nlat, int ntot, int variant = 0) {
    const int lane = tid & 63, r32 = lane & 31, hi = lane >> 5;
    const int wid = __builtin_amdgcn_readfirstlane(tid >> 6);
    if (bx >= ntot) return;
    const size_t kofl = (size_t)lane * NCOL + C_K + wid * 8;
    const size_t vofl = (size_t)(16 * (wid & 3) + (lane >> 2)) * NCOL + C_V + (wid >> 2) * 32 + (lane & 3) * 8;
    int ua_c = bx, ua_s = bx;
    AUnit Dc = aunit(ua_c, wid, nlat), Ds = Dc, Dn = Dc;
    int ts = 0, NTs = Ds.nloc + 4, tc = 0, NTc = NTs, sslot = 0, cslot = 0;
    bf16x8 qr[4], qn[4]; u32x2 zb[8];
#pragma unroll
    for (int i = 0; i < 4; ++i) qn[i] = (bf16x8){0, 0, 0, 0, 0, 0, 0, 0};
#pragma unroll
    for (int i = 0; i < 8; ++i) zb[i] = (u32x2){0u, 0u};
    {   const bf16_t* qp = P + (size_t)(Dc.rowQ0 + r32) * NCOL + C_Q + Dc.h * 64 + hi * 8;
#pragma unroll
        for (int d0 = 0; d0 < 4; ++d0) qr[d0] = *(const bf16x8*)(qp + d0 * 16); }
    int nx = 0;
#define AT2_STAGE_NEXT() do { nx = 0; if (ua_s < ntot) { \
        if (ts == NTs - 1) {     \
            const bf16_t* zp_ = P + (size_t)(Ds.rowQ0 + r32) * NCOL + C_ZB + Ds.h * 64 + 4 * hi; \
            _Pragma("unroll") for (int i_ = 0; i_ < 8; ++i_) zb[i_] = *(const u32x2*)(zp_ + (i_ >> 2) * 32 + (i_ & 3) * 8); \
            nx += 8; \
            if (ua_s + G < ntot) { Dn = aunit(ua_s + G, wid, nlat); const bf16_t* qp_ = P + (size_t)(Dn.rowQ0 + r32) * NCOL + C_Q + Dn.h * 64 + hi * 8; \
                _Pragma("unroll") for (int d0_ = 0; d0_ < 4; ++d0_) qn[d0_] = *(const bf16x8*)(qp_ + d0_ * 16); nx += 4; } } \
        const int kr0_ = (ts < Ds.nloc) ? Ds.kr_loc0 + 64 * (Ds.jlo + ts) : Ds.kr_ctx0 + 64 * (ts - Ds.nloc); const bf16_t* tb_ = P + (size_t)kr0_ * NCOL + Ds.kh * 64; \
        if (variant != 2) { __builtin_amdgcn_global_load_lds((const unsigned*)(tb_ + kofl), (LAS unsigned*)(lds + sslot * 16384 + wid * 1024), 16, 0, 0); \
        __builtin_amdgcn_global_load_lds((const unsigned*)(tb_ + vofl), (LAS unsigned*)(lds + sslot * 16384 + 8192 + wid * 1024), 16, 0, 0); \
        nx += 2; } sslot = (sslot == 2) ? 0 : sslot + 1; ++ts; \
        if (ts == NTs) { ua_s += G; if (ua_s < ntot) { Ds = Dn; ts = 0; NTs = Ds.nloc + 4; } } } } while (0)
    AT2_STAGE_NEXT(); AT2_STAGE_NEXT();
    asm volatile("s_waitcnt vmcnt(2)" ::: "memory"); __builtin_amdgcn_s_barrier(); asm volatile("" ::: "memory");
    f32x16 o0, o1;
#pragma unroll
    for (int i = 0; i < 16; ++i) { o0[i] = 0.f; o1[i] = 0.f; }
    float mrun = sink[Dc.h] * LOG2E, lrun = hi ? 0.f : 1.f;
    int nst = 0;
    for (;;) {
        AT2_STAGE_NEXT();
        const bool local = tc < Dc.nloc; const int j = Dc.jlo + tc;
        const bool need = (variant != 1) && (!local || !((j == 0 && Dc.qq0 >= 64) || (j == 5 && Dc.qq0 < 64)));
        if (need) {
            const int qq = Dc.qq0 + r32;
            const LAS unsigned char* kb = lds + cslot * 16384 + hi * 1024 + r32 * 16;
            f32x16 p0, p1;
#pragma unroll
            for (int i = 0; i < 16; ++i) { p0[i] = 0.f; p1[i] = 0.f; }
#pragma unroll
            for (int d0 = 0; d0 < 4; ++d0) {
                const bf16x8 b0 = *(const LAS bf16x8*)(kb + d0 * 2048);
                const bf16x8 b1 = *(const LAS bf16x8*)(kb + d0 * 2048 + 512);
                p0 = __builtin_amdgcn_mfma_f32_32x32x16_bf16(b0, qr[d0], p0, 0, 0, 0);
                p1 = __builtin_amdgcn_mfma_f32_32x32x16_bf16(b1, qr[d0], p1, 0, 0, 0);
            }
            if (local) {
                if (j < 2) { const int lim = qq - 64 * j;
#pragma unroll
                    for (int i = 0; i < 16; ++i) { const int kk = (i & 3) + 8 * (i >> 2) + 4 * hi; if (kk < lim) p0[i] = -1e30f; if (kk + 32 < lim) p1[i] = -1e30f; }
                } else if (j >= 4) { const int lim = qq - 64 * (j - 4);
#pragma unroll
                    for (int i = 0; i < 16; ++i) { const int kk = (i & 3) + 8 * (i >> 2) + 4 * hi; if (kk > lim) p0[i] = -1e30f; if (kk + 32 > lim) p1[i] = -1e30f; }
                }
            }
            float rm = fmaxf(p0[0], p1[0]);
#pragma unroll
            for (int i = 1; i < 16; ++i) rm = fmaxf(rm, fmaxf(p0[i], p1[i]));
            rm = fmaxf(rm, shx(rm, lane, 32));
            const float mn = fmaxf(mrun, rm);
            if (__any(mn > mrun)) {
                const float f = __builtin_amdgcn_exp2f(mrun - mn);
                lrun *= f;
#pragma unroll
                for (int i = 0; i < 16; ++i) { o0[i] *= f; o1[i] *= f; }
                mrun = mn;
            }
            float ps = 0.f;
#pragma unroll
            for (int i = 0; i < 16; ++i) { p0[i] = __builtin_amdgcn_exp2f(p0[i] - mrun); p1[i] = __builtin_amdgcn_exp2f(p1[i] - mrun); ps += p0[i] + p1[i]; }
            lrun += ps;
            u32x4 pw[4];
#pragma unroll
            for (int w = 0; w < 4; ++w) { pw[0][w] = cvt_pk_bf16(p0[2 * w], p0[2 * w + 1]); pw[1][w] = cvt_pk_bf16(p0[8 + 2 * w], p0[8 + 2 * w + 1]);
                pw[2][w] = cvt_pk_bf16(p1[2 * w], p1[2 * w + 1]); pw[3][w] = cvt_pk_bf16(p1[8 + 2 * w], p1[8 + 2 * w + 1]); }
            const LAS unsigned char* vp = lds + cslot * 16384 + 8192 + ((lane >> 4) & 1) * 32 + (lane & 3) * 8 + (4 * hi + ((lane & 15) >> 2)) * 64;
#pragma unroll
            for (int s = 0; s < 4; ++s) {
                const s16x4 l0 = vtr(vp + s * 1024), h0 = vtr(vp + s * 1024 + 512);
                const s16x4 l1 = vtr(vp + 4096 + s * 1024), h1 = vtr(vp + 4096 + s * 1024 + 512);
                const bf16x8 v0 = (bf16x8){l0[0], l0[1], l0[2], l0[3], h0[0], h0[1], h0[2], h0[3]};
                const bf16x8 v1 = (bf16x8){l1[0], l1[1], l1[2], l1[3], h1[0], h1[1], h1[2], h1[3]};
                const bf16x8 pa = __builtin_bit_cast(bf16x8, pw[s]);
                o0 = __builtin_amdgcn_mfma_f32_32x32x16_bf16(v0, pa, o0, 0, 0, 0);
                o1 = __builtin_amdgcn_mfma_f32_32x32x16_bf16(v1, pa, o1, 0, 0, 0);
            }
        }
        wait_vm_n(nx + nst); nst = 0;
        asm volatile("s_waitcnt lgkmcnt(0)" ::: "memory"); __builtin_amdgcn_s_barrier(); asm volatile("" ::: "memory");
        cslot = (cslot == 2) ? 0 : cslot + 1; ++tc;
        if (tc == NTc) {
            lrun += shx(lrun, lane, 32);
            const float inv = 1.0f / lrun;
            bf16_t* oo = Oout + (size_t)(Dc.rowQ0 + r32) * opitch + ocol + Dc.h * 64 + 4 * hi;
#pragma unroll
            for (int d0 = 0; d0 < 2; ++d0)
#pragma unroll
                for (int gq = 0; gq < 4; ++gq) {
                    const u32x2 z = zb[d0 * 4 + gq];
                    const float a0 = (d0 ? o1[4 * gq + 0] : o0[4 * gq + 0]) * inv * siluf_(bf_lo(z.x));
                    const float a1 = (d0 ? o1[4 * gq + 1] : o0[4 * gq + 1]) * inv * siluf_(bf_hi(z.x));
                    const float a2 = (d0 ? o1[4 * gq + 2] : o0[4 * gq + 2]) * inv * siluf_(bf_lo(z.y));
                    const float a3 = (d0 ? o1[4 * gq + 3] : o0[4 * gq + 3]) * inv * siluf_(bf_hi(z.y));
                    u32x2 w; w.x = cvt_pk_bf16(a0, a1); w.y = cvt_pk_bf16(a2, a3);
                    *(u32x2*)(oo + d0 * 32 + gq * 8) = w;
                }
            nst = 8;
            ua_c += G; if (ua_c >= ntot) break;
            Dc = aunit(ua_c, wid, nlat); tc = 0; NTc = Dc.nloc + 4;
#pragma unroll
            for (int d0 = 0; d0 < 4; ++d0) qr[d0] = qn[d0];
#pragma unroll
            for (int i = 0; i < 16; ++i) { o0[i] = 0.f; o1[i] = 0.f; }
            mrun = sink[Dc.h] * LOG2E; lrun = hi ? 0.f : 1.f;
        }
    }
#undef AT2_STAGE_NEXT
    asm volatile("s_waitcnt vmcnt(0) lgkmcnt(0)" ::: "memory"); __builtin_amdgcn_s_barrier(); asm volatile("" ::: "memory");
}

namespace at3 {
constexpr int NSLOT = 3, SLOTB = 8192;
constexpr int LDS_K = 0, LDS_V = NSLOT * SLOTB, LDS_WS = 2 * NSLOT * SLOTB, LDS_OST = LDS_WS + 8 * 64 * 4, LDS_TOTAL = LDS_OST + 8 * 4096;
__device__ __forceinline__ int crow(int r, int hi) { return (r & 3) + 8 * (r >> 2) + 4 * hi; }
#define SBAR() __builtin_amdgcn_sched_barrier(0)
__device__ __forceinline__ void glds16(const void* sbase, unsigned voff, unsigned lds_dst) { unsigned keep;
    asm volatile("s_mov_b32 %0, m0\n\ts_mov_b32 m0, %3\n\ts_nop 4\n\tglobal_load_lds_dwordx4 %1, %2\n\ts_mov_b32 m0, %0" : "=&s"(keep) : "v"(voff), "s"(sbase), "s"(lds_dst) : "memory"); }
__device__ __forceinline__ float max3f(float a, float b, float c) { float r; asm("v_max3_f32 %0, %1, %2, %3" : "=v"(r) : "v"(a), "v"(b), "v"(c)); return r; }
__device__ __forceinline__ float max2f(float a, float b) { float r; asm("v_max_f32_e32 %0, %1, %2" : "=v"(r) : "v"(a), "v"(b)); return r; }
__device__ __forceinline__ float fadd_s(float a, float b) { float r; asm("v_add_f32_e32 %0, %1, %2" : "=v"(r) : "v"(a), "v"(b)); return r; }
__device__ __forceinline__ float fsub_s(float a, float b) { float r; asm("v_sub_f32_e32 %0, %1, %2" : "=v"(r) : "v"(a), "v"(b)); return r; }
typedef float f32x2_t __attribute__((ext_vector_type(2))); typedef __bf16 bf16x2_t __attribute__((ext_vector_type(2)));
__device__ __forceinline__ unsigned cvtpk_s(float lo, float hi) { f32x2_t v = {lo, hi}; bf16x2_t b = __builtin_convertvector(v, bf16x2_t); return __builtin_bit_cast(unsigned, b); }
#define WAIT_BAR(N) asm volatile("s_waitcnt vmcnt(" #N ") lgkmcnt(0)\n\ts_barrier" ::: "memory")
typedef const LAS char* lds_cptr;
__device__ __forceinline__ void qkt(f32x16& p0, f32x16& p1, lds_cptr Kslot, const bf16x8* qr, int r32, int hi) {
    const f32x16 negm = f32x16{};
    lds_cptr kb = Kslot + hi * 1024 + r32 * 16;
#pragma unroll
    for (int d0 = 0; d0 < 4; ++d0) {
        const bf16x8 b0 = *(const LAS bf16x8*)(kb + d0 * 2048);
        const bf16x8 b1 = *(const LAS bf16x8*)(kb + d0 * 2048 + 512);
        if (d0 == 0) { p0 = __builtin_amdgcn_mfma_f32_32x32x16_bf16(b0, qr[0], negm, 0, 0, 0); p1 = __builtin_amdgcn_mfma_f32_32x32x16_bf16(b1, qr[0], negm, 0, 0, 0); }
        else { p0 = __builtin_amdgcn_mfma_f32_32x32x16_bf16(b0, qr[d0], p0, 0, 0, 0); p1 = __builtin_amdgcn_mfma_f32_32x32x16_bf16(b1, qr[d0], p1, 0, 0, 0); } }
}
__device__ __forceinline__ void kload8(bf16x8* kf, lds_cptr kp) {
    kf[0] = *(const LAS bf16x8*)(kp);        kf[1] = *(const LAS bf16x8*)(kp + 512);
    kf[2] = *(const LAS bf16x8*)(kp + 2048); kf[3] = *(const LAS bf16x8*)(kp + 2560);
    kf[4] = *(const LAS bf16x8*)(kp + 4096); kf[5] = *(const LAS bf16x8*)(kp + 4608);
    kf[6] = *(const LAS bf16x8*)(kp + 6144); kf[7] = *(const LAS bf16x8*)(kp + 6656);
}
__device__ __forceinline__ void kload2(bf16x8* kf, lds_cptr kp, int j) { kf[2 * j] = *(const LAS bf16x8*)(kp + j * 2048); kf[2 * j + 1] = *(const LAS bf16x8*)(kp + j * 2048 + 512); }
__device__ __forceinline__ s16x4 vtr3(lds_cptr p) { return __builtin_bit_cast(s16x4, __builtin_amdgcn_ds_read_tr16_b64_v4i16((LAS v4i16_t*)p)); }
__device__ __forceinline__ float rowmax(const f32x16& p0, const f32x16& p1) {
    float a = max3f(p0[0], p0[1], p1[0]), b = max3f(p0[2], p0[3], p1[1]); a = max3f(a, p1[2], p1[3]);
#pragma unroll
    for (int r = 4; r < 16; r += 4) { a = max3f(a, p0[r], p0[r + 1]); b = max3f(b, p0[r + 2], p0[r + 3]); a = max3f(a, p1[r], p1[r + 1]); b = max3f(b, p1[r + 2], p1[r + 3]); }
    const float m = max2f(a, b);
    auto rr = __builtin_amdgcn_permlane32_swap(__float_as_uint(m), __float_as_uint(m), false, false);
    return max2f(__uint_as_float(rr[0]), __uint_as_float(rr[1]));
}
__device__ __forceinline__ void pv(f32x16* o, int vb, bf16x8 pa0, bf16x8 pa1, bf16x8 pa2, bf16x8 pa3) {
#pragma unroll
    for (int d0 = 0; d0 < 2; ++d0) { s16x4 lo[4], hi[4];
#pragma unroll
        for (int ks = 0; ks < 4; ++ks) {
            asm volatile("ds_read_b64_tr_b16 %0,%1 offset:%c2" : "=&v"(lo[ks]) : "v"(vb), "i"(d0 * 4096 + ks * 1024) : "memory");
            asm volatile("ds_read_b64_tr_b16 %0,%1 offset:%c2" : "=&v"(hi[ks]) : "v"(vb), "i"(d0 * 4096 + ks * 1024 + 512) : "memory"); }
        asm volatile("s_waitcnt lgkmcnt(0)" ::: "memory"); SBAR();
#define PK(k) (bf16x8){lo[k][0], lo[k][1], lo[k][2], lo[k][3], hi[k][0], hi[k][1], hi[k][2], hi[k][3]}
        o[d0] = __builtin_amdgcn_mfma_f32_32x32x16_bf16(pa0, PK(0), o[d0], 0, 0, 0);
        o[d0] = __builtin_amdgcn_mfma_f32_32x32x16_bf16(pa1, PK(1), o[d0], 0, 0, 0);
        o[d0] = __builtin_amdgcn_mfma_f32_32x32x16_bf16(pa2, PK(2), o[d0], 0, 0, 0);
        o[d0] = __builtin_amdgcn_mfma_f32_32x32x16_bf16(pa3, PK(3), o[d0], 0, 0, 0);
#undef PK
    }
}
__device__ __forceinline__ void wmask(f32x16& p0, f32x16& p1, int j, int qq, int hi) {
    const float NEG = -INFINITY;
    if (j < 2) { const int lim = qq - 64 * j;
#pragma unroll
        for (int r = 0; r < 16; ++r) { const int kk = (r & 3) + 8 * (r >> 2) + 4 * hi; if (kk < lim) p0[r] = NEG; if (kk + 32 < lim) p1[r] = NEG; }
    } else if (j >= 4) { const int lim = qq - 64 * (j - 4);
#pragma unroll
        for (int r = 0; r < 16; ++r) { const int kk = (r & 3) + 8 * (r >> 2) + 4 * hi; if (kk > lim) p0[r] = NEG; if (kk + 32 > lim) p1[r] = NEG; }
    }
}
template <int THRL> __device__ __forceinline__ void attn_unit(int tid_in, LAS unsigned char* shm3u, const bf16_t* P, bf16_t* Oout, int opitch, int ocol, int rowQ0, int h, int kh, int qq0, int nloc, int jlo, int kr_loc0, int kr_ctx0, float sink_l2) {
    int tid = tid_in; asm volatile("" : "+v"(tid));
    const int lane = tid & 63, r32 = lane & 31, hi = lane >> 5; const int wid = __builtin_amdgcn_readfirstlane(tid >> 6);
    const lds_cptr shm3 = (lds_cptr)shm3u;
    const unsigned lds0 = (unsigned)(uintptr_t)shm3u;
    LAS float* wsf = (LAS float*)(shm3u + LDS_WS) + wid * 64;
    const bf16_t* Qw = P + (size_t)rowQ0 * NCOL + C_Q + h * 64;
    const unsigned koffb = (unsigned)(lane * NCOL + C_K + kh * 64 + wid * 8) * 2u;
    const unsigned voffb = (unsigned)((16 * (wid & 3) + (lane >> 2)) * NCOL + C_V + kh * 64 + (wid >> 2) * 32 + (lane & 3) * 8) * 2u;
    const unsigned kdst = lds0 + LDS_K + wid * 1024, vdst = lds0 + LDS_V + wid * 1024;
#define KROW(t) (((t) < nloc) ? kr_loc0 + 64 * (jlo + (t)) : kr_ctx0 + 64 * ((t) - nloc))
#define DMA_K(t, slot) glds16(P + (size_t)KROW(t) * NCOL, koffb, (unsigned)__builtin_amdgcn_readfirstlane(kdst + (slot)))
#define DMA_V(t, slot) glds16(P + (size_t)KROW(t) * NCOL, voffb, (unsigned)__builtin_amdgcn_readfirstlane(vdst + (slot)))
    bf16x8 kf[8];
    const lds_cptr kp0 = shm3 + LDS_K + hi * 1024 + r32 * 16; const lds_cptr vp0 = shm3 + LDS_V + ((lane >> 4) & 1) * 32 + (lane & 3) * 8 + (4 * hi + ((lane & 15) >> 2)) * 64;
    const int NT = nloc + 4;
    DMA_K(0, 0); DMA_V(0, 0); DMA_K(1, SLOTB);
    bf16x8 qr[4];
#pragma unroll
    for (int d0 = 0; d0 < 4; ++d0) qr[d0] = *reinterpret_cast<const bf16x8*>(&Qw[(size_t)r32 * NCOL + d0 * 16 + hi * 8]);
    const lds_cptr qls = shm3 + LDS_OST + wid * 4096 + lane * 16;
#pragma unroll
    for (int d0 = 0; d0 < 4; ++d0) *(LAS bf16x8*)(shm3u + LDS_OST + wid * 4096 + lane * 16 + d0 * 1024) = qr[d0];
#define QLD(d) (*(const LAS bf16x8*)(qls + (d) * 1024))
    float mhat = 0.f, l_reg = 0.f; f32x16 o[2]; o[0] = f32x16{}; o[1] = f32x16{};
    const int qrel = qq0 + r32;
#define CMASK(P0, P1, t) do { if ((t) < nloc) wmask(P0, P1, jlo + (t), qrel, hi); } while (0)
    bool resc = false;
#define START(P0, P1) do { const float rm = max2f(rowmax(P0, P1), sink_l2); resc = false; \
    { const float dl = rm; mhat = fadd_s(mhat, dl); \
      _Pragma("unroll") for (int r = 0; r < 16; ++r) { P0[r] = fsub_s(P0[r], dl); P1[r] = fsub_s(P1[r], dl); } } \
    l_reg = hi ? 0.f : __builtin_amdgcn_exp2f(sink_l2 - mhat); \
    _Pragma("unroll") for (int r = 0; r < 16; ++r) P0[r] = __builtin_amdgcn_exp2f(P0[r]); } while (0)
#define RESC() do { if (resc) { asm volatile("s_waitcnt lgkmcnt(0)" ::: "memory"); \
      _Pragma("unroll") for (int r = 0; r < 16; ++r) { const float f_ = wsf[crow(r, hi)]; o[0][r] *= f_; o[1][r] *= f_; if ((r & 3) == 3) asm volatile("" ::: "memory"); } } } while (0)
    f32x16 pA0, pA1, pB0, pB1;
    int sl_prev = 0, sl_cur = 0, sl_next = SLOTB;
#define ROT() do { sl_prev = sl_cur; sl_cur = sl_next; sl_next = (sl_next == (NSLOT - 1) * SLOTB) ? 0 : sl_next + SLOTB; } while (0)
    DMA_K(2, 2 * SLOTB);
    WAIT_BAR(3);
    qkt(pA0, pA1, shm3 + LDS_K, qr, r32, hi); asm volatile("s_nop 15\n\ts_nop 7" : "+v"(pA0), "+v"(pA1)); CMASK(pA0, pA1, 0);
    START(pA0, pA1);
    _Pragma("unroll") for (int r = 0; r < 16; ++r) pA1[r] = __builtin_amdgcn_exp2f(pA1[r]);
    WAIT_BAR(0);
    DMA_K(3, 0); DMA_V(1, SLOTB);
    ROT();
    kload8(kf, kp0 + sl_cur);
    WAIT_BAR(2);
    s16x4 vlo[8], vhi[8]; u32x4 pw0, pw1, pw2, pw3;
#define PKW(P, B) cvtpk_s(P[B], P[B + 1])
#define PAF(k) __builtin_bit_cast(bf16x8, pw##k)
#define VFR(i) (bf16x8){vlo[i][0], vlo[i][1], vlo[i][2], vlo[i][3], vhi[i][0], vhi[i][1], vhi[i][2], vhi[i][3]}
#define PIN(x) asm volatile("" : "+v"(x))
#define MX3(a, b, c) __builtin_fmaxf(__builtin_fmaxf((a), (b)), (c))
#define GAPA(MF, A0, A1, A2, A3, W0, W1, PW) do { MF; sacc += A0; sacc += A1; sacc += A2; sacc += A3; PIN(sacc); W0; W1; PIN(PW); SBAR(); } while (0)
#define EX(v) __builtin_amdgcn_exp2f(v)
#define GAPB(MF, X, B) do { MF; X[B] = EX(X[B] - mhat); X[B + 1] = EX(X[B + 1] - mhat); X[B + 2] = EX(X[B + 2] - mhat); X[B + 3] = EX(X[B + 3] - mhat); PIN(X); SBAR(); } while (0)
#define VRD(i) do { vlo[i] = vtr3(vp_ + (((i) >> 2) * 4096 + ((i) & 3) * 1024)); vhi[i] = vtr3(vp_ + (((i) >> 2) * 4096 + ((i) & 3) * 1024 + 512)); } while (0)
#define KRD(G, j) do { if (G) { kload2(kf, kp0 + sl_next, j); SBAR(); } } while (0)
#define STEP(C0, C1, P0, P1, t, GK, GV, GL) do { SBAR(); \
    const lds_cptr vp_ = vp0 + sl_prev; const f32x16 zero16 = f32x16{}; \
    const bf16x8 qd0 = QLD(0), qd1 = QLD(1); VRD(0); SBAR(); float sacc = (P0[0] + P0[1]); \
    GAPA(C0 = __builtin_amdgcn_mfma_f32_32x32x16_bf16(kf[0], qd0, zero16, 0, 0, 0), P0[2], P0[3], P0[4], P0[5],     pw0[0] = PKW(P0, 0), pw0[1] = PKW(P0, 2), pw0); \
    VRD(4); SBAR(); GAPA(C1 = __builtin_amdgcn_mfma_f32_32x32x16_bf16(kf[1], qd0, zero16, 0, 0, 0), P0[6], P0[7], P0[8], P0[9],     pw0[2] = PKW(P0, 4), pw0[3] = PKW(P0, 6), pw0); \
    const bf16x8 qd2 = QLD(2), qd3 = QLD(3); VRD(1); SBAR(); GAPA(C0 = __builtin_amdgcn_mfma_f32_32x32x16_bf16(kf[2], qd1, C0, 0, 0, 0),   P0[10], P0[11], P0[12], P0[13], pw1[0] = PKW(P0, 8), pw1[1] = PKW(P0, 10), pw1); \
    VRD(5); SBAR(); GAPA(C1 = __builtin_amdgcn_mfma_f32_32x32x16_bf16(kf[3], qd1, C1, 0, 0, 0),   P0[14], P0[15], P1[0], P1[1],   pw1[2] = PKW(P0, 12), pw1[3] = PKW(P0, 14), pw1); \
    VRD(2); SBAR(); GAPA(C0 = __builtin_amdgcn_mfma_f32_32x32x16_bf16(kf[4], qd2, C0, 0, 0, 0),   P1[2], P1[3], P1[4], P1[5],     pw2[0] = PKW(P1, 0), pw2[1] = PKW(P1, 2), pw2); \
    VRD(6); SBAR(); GAPA(C1 = __builtin_amdgcn_mfma_f32_32x32x16_bf16(kf[5], qd2, C1, 0, 0, 0),   P1[6], P1[7], P1[8], P1[9],     pw2[2] = PKW(P1, 4), pw2[3] = PKW(P1, 6), pw2); \
    VRD(3); SBAR(); GAPA(C0 = __builtin_amdgcn_mfma_f32_32x32x16_bf16(kf[6], qd3, C0, 0, 0, 0),   P1[10], P1[11], P1[12], P1[13], pw3[0] = PKW(P1, 8), pw3[1] = PKW(P1, 10), pw3); \
    VRD(7); SBAR(); GAPA(C1 = __builtin_amdgcn_mfma_f32_32x32x16_bf16(kf[7], qd3, C1, 0, 0, 0),   P1[14], P1[15], 0.f, 0.f,       pw3[2] = PKW(P1, 12), pw3[3] = PKW(P1, 14), pw3); \
    l_reg += sacc; \
    if (GK) { DMA_K((t) + 3, sl_cur); } if (GV) { DMA_V((t) + 1, sl_next); } \
    CMASK(C0, C1, t); \
    { float a = MX3(C0[0], C0[1], C1[0]), b = MX3(C0[2], C0[3], C1[1]); a = MX3(a, C1[2], C1[3]); \
      _Pragma("unroll") for (int r = 4; r < 16; r += 4) { a = MX3(a, C0[r], C0[r + 1]); b = MX3(b, C0[r + 2], C0[r + 3]); a = MX3(a, C1[r], C1[r + 1]); b = MX3(b, C1[r + 2], C1[r + 3]); } \
      float rm = __builtin_fmaxf(a, b); { auto rr = __builtin_amdgcn_permlane32_swap(__float_as_uint(rm), __float_as_uint(rm), false, false); rm = __builtin_fmaxf(__uint_as_float(rr[0]), __uint_as_float(rr[1])); } \
      resc = false; rm -= mhat; \
      if (__builtin_expect(__any(rm > (float)THRL), 0)) { const float dl = __builtin_fmaxf(rm, 0.f); mhat += dl; \
        const float f = __builtin_amdgcn_exp2f(-dl); l_reg *= f; if (hi == 0) wsf[r32] = f; resc = true; } } \
    SBAR(); \
    GAPB(o[0] = __builtin_amdgcn_mfma_f32_32x32x16_bf16(PAF(0), VFR(0), o[0], 0, 0, 0), C0, 0); \
    GAPB(o[1] = __builtin_amdgcn_mfma_f32_32x32x16_bf16(PAF(0), VFR(4), o[1], 0, 0, 0), C0, 4); \
    KRD(GL, 0); GAPB(o[0] = __builtin_amdgcn_mfma_f32_32x32x16_bf16(PAF(1), VFR(1), o[0], 0, 0, 0), C0, 8); \
    KRD(GL, 1); GAPB(o[1] = __builtin_amdgcn_mfma_f32_32x32x16_bf16(PAF(1), VFR(5), o[1], 0, 0, 0), C0, 12); \
    KRD(GL, 2); GAPB(o[0] = __builtin_amdgcn_mfma_f32_32x32x16_bf16(PAF(2), VFR(2), o[0], 0, 0, 0), C1, 0); \
    KRD(GL, 3); GAPB(o[1] = __builtin_amdgcn_mfma_f32_32x32x16_bf16(PAF(2), VFR(6), o[1], 0, 0, 0), C1, 4); \
    GAPB(o[0] = __builtin_amdgcn_mfma_f32_32x32x16_bf16(PAF(3), VFR(3), o[0], 0, 0, 0), C1, 8); \
    GAPB(o[1] = __builtin_amdgcn_mfma_f32_32x32x16_bf16(PAF(3), VFR(7), o[1], 0, 0, 0), C1, 12); \
    } while (0)
    int t = 1;
#define ENDW(tt) do { if ((tt) + 3 < NT) { WAIT_BAR(2); } else if ((tt) + 2 < NT) { WAIT_BAR(1); } else { WAIT_BAR(0); } } while (0)
    for (; t + 1 < NT; t += 2) {
        STEP(pB0, pB1, pA0, pA1, t, (t + 3 < NT), (t + 1 < NT), (t + 1 < NT));       ENDW(t);     RESC(); ROT();
        STEP(pA0, pA1, pB0, pB1, t + 1, (t + 4 < NT), (t + 2 < NT), (t + 2 < NT));   ENDW(t + 1); RESC(); ROT();
    }
    STEP(pB0, pB1, pA0, pA1, NT - 1, false, false, false); RESC();
    { float sacc = pB0[0] + pB0[1]; _Pragma("unroll") for (int r = 2; r < 16; ++r) sacc += pB0[r]; _Pragma("unroll") for (int r = 0; r < 16; ++r) sacc += pB1[r]; l_reg += sacc;
      pw0 = (u32x4){PKW(pB0, 0), PKW(pB0, 2), PKW(pB0, 4), PKW(pB0, 6)}; pw1 = (u32x4){PKW(pB0, 8), PKW(pB0, 10), PKW(pB0, 12), PKW(pB0, 14)}; pw2 = (u32x4){PKW(pB1, 0), PKW(pB1, 2), PKW(pB1, 4), PKW(pB1, 6)}; pw3 = (u32x4){PKW(pB1, 8), PKW(pB1, 10), PKW(pB1, 12), PKW(pB1, 14)};
      SBAR(); int ln2 = lane_id_(); asm volatile("" : "+v"(ln2)); const int hi2 = ln2 >> 5;
      const int vb0 = (int)(lds0 + LDS_V) + ((ln2 >> 4) & 1) * 32 + (ln2 & 3) * 8 + (4 * hi2 + ((ln2 & 15) >> 2)) * 64;
      pv(o, vb0 + sl_cur, PAF(0), PAF(1), PAF(2), PAF(3)); }
#undef PKW
#undef PAF
#undef VFR
#undef PIN
#undef MX3
#undef GAPA
#undef GAPB
#undef EX
#undef VRD
#undef KRD
#undef STEP
#undef ENDW
    { auto rr = __builtin_amdgcn_permlane32_swap(__float_as_uint(l_reg), __float_as_uint(l_reg), false, false); l_reg = __uint_as_float(rr[0]) + __uint_as_float(rr[1]); }
    int lane_e = lane_id_(); asm volatile("" : "+v"(lane_e));
    const int r32_e = lane_e & 31, hi_e = lane_e >> 5;
    if (hi_e == 0) wsf[32 + r32_e] = l_reg; asm volatile("s_waitcnt lgkmcnt(0)" ::: "memory");
    float rli[16];
#pragma unroll
    for (int r = 0; r < 16; ++r) rli[r] = __builtin_amdgcn_rcpf(wsf[32 + crow(r, hi_e)]);
    {   LAS bf16_t* stg = (LAS bf16_t*)(shm3u + LDS_OST) + wid * 2048;
        u32x4 zv[4];
        const bf16_t* zrow = P + (size_t)rowQ0 * NCOL + C_ZB + h * 64;
#pragma unroll
        for (int i = 0; i < 4; ++i) { const int row = i * 8 + (lane_e >> 3), ch = lane_e & 7; zv[i] = *(const u32x4*)(zrow + (size_t)row * NCOL + ch * 8); }
#pragma unroll
        for (int r = 0; r < 16; ++r) { const int orow = crow(r, hi_e);
#pragma unroll
            for (int d0 = 0; d0 < 2; ++d0) { const unsigned short b = (unsigned short)(cvtpk_s(o[d0][r] * rli[r], 0.f) & 0xffffu); stg[orow * 64 + d0 * 32 + r32_e] = b; } }
        asm volatile("s_waitcnt lgkmcnt(0)" ::: "memory");
        bf16_t* orow_p = Oout + (size_t)rowQ0 * opitch + ocol + h * 64;
#pragma unroll
        for (int i = 0; i < 4; ++i) { const int row = i * 8 + (lane_e >> 3), ch = lane_e & 7; const u32x4 v = *(const LAS u32x4*)(stg + row * 64 + ch * 8);
            u32x4 w;
#pragma unroll
            for (int e = 0; e < 4; ++e) { w[e] = cvt_pk_bf16(bf_lo(v[e]) * siluf_(bf_lo(zv[i][e])), bf_hi(v[e]) * siluf_(bf_hi(zv[i][e]))); }
            *(u32x4*)(orow_p + (size_t)row * opitch + ch * 8) = w; } }
    asm volatile("s_waitcnt lgkmcnt(0)\n\ts_barrier" ::: "memory");
#undef DMA_K
#undef DMA_V
#undef KROW
#undef CMASK
#undef START
#undef RESC
#undef ROT
#undef QLD
}
#undef SBAR
#undef WAIT_BAR
}

struct V8 { f32x4 a, b; };
__device__ __forceinline__ V8 ld8(const bf16_t* p) { const u32x4 w = *(const u32x4*)p; V8 r; r.a = (f32x4){bf_lo(w.x), bf_hi(w.x), bf_lo(w.y), bf_hi(w.y)}; r.b = (f32x4){bf_lo(w.z), bf_hi(w.z), bf_lo(w.w), bf_hi(w.w)}; return r; }
__device__ __forceinline__ V8 cu_at(const bf16_t* P, int t, int c0) { const V8 c = ld8(P + (size_t)t * NCOL + C_C + c0), u = ld8(P + (size_t)t * NCOL + C_U + c0); V8 r; r.a = c.a * u.a; r.b = c.b * u.b; return r; }
__device__ __forceinline__ void conv_run(const bf16_t* P, bf16_t* Yout, int ypitch, int ycol, const float* cw, int run, int lane) {
    const int row0 = run * 16;
    int s0, s1; if (row0 < TL) { s0 = row0 & ~2047; s1 = s0 + 2048; } else { s0 = TL + ((row0 - TL) & ~255); s1 = s0 + 256; }
    const int c0 = lane * 8;
    const f32x4 w0a = *(const f32x4*)(cw + c0), w0b = *(const f32x4*)(cw + c0 + 4);
    const f32x4 w1a = *(const f32x4*)(cw + 512 + c0), w1b = *(const f32x4*)(cw + 512 + c0 + 4);
    const f32x4 w2a = *(const f32x4*)(cw + 1024 + c0), w2b = *(const f32x4*)(cw + 1024 + c0 + 4);
    const f32x4 z4 = (f32x4){0.f, 0.f, 0.f, 0.f};
    V8 prev, cur; prev.a = z4; prev.b = z4;
    if (row0 - 1 >= s0) prev = cu_at(P, row0 - 1, c0);
    cur = cu_at(P, row0, c0);
    for (int i = 0; i < 16; ++i) {
        const int t = row0 + i;
        V8 nxt; nxt.a = z4; nxt.b = z4;
        if (t + 1 < s1) nxt = cu_at(P, t + 1, c0);
        const f32x4 ca = w0a * prev.a + w1a * cur.a + w2a * nxt.a, cb = w0b * prev.b + w1b * cur.b + w2b * nxt.b;
        const V8 bg = ld8(P + (size_t)t * NCOL + C_B + c0), z = ld8(P + (size_t)t * NCOL + C_ZA + c0);
        f32x4 ya, yb;
#pragma unroll
        for (int e = 0; e < 4; ++e) { ya[e] = bg.a[e] * ca[e] * siluf_(z.a[e]); yb[e] = bg.b[e] * cb[e] * siluf_(z.b[e]); }
        u32x4 w; w.x = cvt_pk_bf16(ya[0], ya[1]); w.y = cvt_pk_bf16(ya[2], ya[3]); w.z = cvt_pk_bf16(yb[0], yb[1]); w.w = cvt_pk_bf16(yb[2], yb[3]);
        *(u32x4*)(Yout + (size_t)t * ypitch + ycol + c0) = w;
        prev = cur; cur = nxt;
    }
}

__device__ __forceinline__ void conv_run8(const bf16_t* P, bf16_t* Yout, int ypitch, int ycol, const float* cw, int run, int lane) {
    const int row0 = run * 8;
    int s0, s1; if (row0 < TL) { s0 = row0 & ~2047; s1 = s0 + 2048; } else { s0 = TL + ((row0 - TL) & ~255); s1 = s0 + 256; }
    const int c0 = lane * 8;
    const bf16_t* base = P + (size_t)row0 * NCOL + c0;
    u32x4 rc[10], ru[10], rb[8], rz[8];
    const u32x4 z4u = (u32x4){0u, 0u, 0u, 0u};
    rc[0] = z4u; ru[0] = z4u; rc[9] = z4u; ru[9] = z4u;
    if (row0 - 1 >= s0) { rc[0] = *(const u32x4*)(base - NCOL + C_C); ru[0] = *(const u32x4*)(base - NCOL + C_U); }
#pragma unroll
    for (int i = 0; i < 8; ++i) { rc[i + 1] = *(const u32x4*)(base + (size_t)i * NCOL + C_C); ru[i + 1] = *(const u32x4*)(base + (size_t)i * NCOL + C_U);
        rb[i] = *(const u32x4*)(base + (size_t)i * NCOL + C_B); rz[i] = *(const u32x4*)(base + (size_t)i * NCOL + C_ZA); }
    if (row0 + 8 < s1) { rc[9] = *(const u32x4*)(base + (size_t)8 * NCOL + C_C); ru[9] = *(const u32x4*)(base + (size_t)8 * NCOL + C_U); }
    const f32x4 w0a = *(const f32x4*)(cw + c0), w0b = *(const f32x4*)(cw + c0 + 4);
    const f32x4 w1a = *(const f32x4*)(cw + 512 + c0), w1b = *(const f32x4*)(cw + 512 + c0 + 4);
    const f32x4 w2a = *(const f32x4*)(cw + 1024 + c0), w2b = *(const f32x4*)(cw + 1024 + c0 + 4);
#define CV_A(q_) ((f32x4){bf_lo((q_)[0]), bf_hi((q_)[0]), bf_lo((q_)[1]), bf_hi((q_)[1])})
#define CV_B(q_) ((f32x4){bf_lo((q_)[2]), bf_hi((q_)[2]), bf_lo((q_)[3]), bf_hi((q_)[3])})
    f32x4 pa = CV_A(rc[0]) * CV_A(ru[0]), pb = CV_B(rc[0]) * CV_B(ru[0]);
    f32x4 ca = CV_A(rc[1]) * CV_A(ru[1]), cb = CV_B(rc[1]) * CV_B(ru[1]);
#pragma unroll
    for (int i = 0; i < 8; ++i) {
        const f32x4 na = CV_A(rc[i + 2]) * CV_A(ru[i + 2]), nb = CV_B(rc[i + 2]) * CV_B(ru[i + 2]);
        const f32x4 va = w0a * pa + w1a * ca + w2a * na, vb = w0b * pb + w1b * cb + w2b * nb;
        const f32x4 ba = CV_A(rb[i]), bb = CV_B(rb[i]), za = CV_A(rz[i]), zb = CV_B(rz[i]);
        f32x4 ya, yb;
#pragma unroll
        for (int e = 0; e < 4; ++e) { ya[e] = ba[e] * va[e] * siluf_(za[e]); yb[e] = bb[e] * vb[e] * siluf_(zb[e]); }
        u32x4 w; w.x = cvt_pk_bf16(ya[0], ya[1]); w.y = cvt_pk_bf16(ya[2], ya[3]); w.z = cvt_pk_bf16(yb[0], yb[1]); w.w = cvt_pk_bf16(yb[2], yb[3]);
        *(u32x4*)(Yout + (size_t)(row0 + i) * ypitch + ycol + c0) = w;
        pa = ca; pb = cb; ca = na; cb = nb;
    }
#undef CV_A
#undef CV_B
}

__device__ __forceinline__ void transpose_item(const float* W, int ldw, bf16_t* WT, int ldo, int koff, int nblk, LAS float* scr, int item, int lane) {
    const int kb = item / nblk, nb = item % nblk, k0 = 64 * kb, n0 = 32 * nb;
#pragma unroll 8
    for (int i = 0; i < 32; ++i) { const int kk = 2 * i + (lane >> 5); scr[kk * 33 + (lane & 31)] = W[(size_t)(k0 + kk) * ldw + n0 + (lane & 31)]; }
    LDS_WAIT(); asm volatile("" ::: "memory");
    const int c = lane & 7;
#pragma unroll
    for (int j = 0; j < 4; ++j) { const int n = (lane >> 3) + 8 * j; const LAS float* s = scr + (8 * c) * 33 + n;
        u32x4 o; o.x = cvt_pk_bf16(s[0 * 33], s[1 * 33]); o.y = cvt_pk_bf16(s[2 * 33], s[3 * 33]); o.z = cvt_pk_bf16(s[4 * 33], s[5 * 33]); o.w = cvt_pk_bf16(s[6 * 33], s[7 * 33]);
        *(u32x4*)(WT + (size_t)(n0 + n) * ldo + koff + k0 + 8 * c) = o; }
    LDS_WAIT(); asm volatile("" ::: "memory");
}

__device__ __forceinline__ void rowmat17_item(int tid, LAS unsigned char* lds, const float* W, int ldw, int col0, const float* bias, float* out, int ldo) {
    const int lane = tid & 63, wid = tid >> 6;
    const LAS float* tab = (const LAS float*)lds;
    LAS float* part = (LAS float*)(lds + 17 * 1024 * 4);
    float acc[17];
#pragma unroll
    for (int r = 0; r < 17; ++r) acc[r] = 0.f;
    const float* wp = W + (size_t)(wid * 128) * ldw + col0 + lane;
    for (int k = 0; k < 128; k += 16) {
        float wv[16];
#pragma unroll
        for (int i = 0; i < 16; ++i) wv[i] = wp[(size_t)(k + i) * ldw];
#pragma unroll
        for (int q = 0; q < 4; ++q)
#pragma unroll
            for (int r = 0; r < 17; ++r) { const f32x4 t = *(const LAS f32x4*)(tab + r * 1024 + wid * 128 + k + 4 * q); acc[r] += (t[0] * wv[4 * q] + t[1] * wv[4 * q + 1]) + (t[2] * wv[4 * q + 2] + t[3] * wv[4 * q + 3]); }
    }
#pragma unroll
    for (int r = 0; r < 17; ++r) part[(wid * 17 + r) * 64 + lane] = acc[r];
    __syncthreads();
    for (int idx = tid; idx < 17 * 64; idx += 512) { const int r = idx >> 6, e = idx & 63; float s = 0.f;
#pragma unroll
        for (int w = 0; w < 8; ++w) s += part[(w * 17 + r) * 64 + e];
        if (bias) s += bias[col0 + e];
        out[(size_t)r * ldo + col0 + e] = s; }
    __syncthreads();
}


#define XB_TMO      128
#define XB_XCNT(j)  (256  + 64 * (j))
#define XB_XSUB(j)  (1280 + 64 * (j))
#define XB_XGEN(j)  (2304 + 64 * (j))
#define XB_TOP      3328
#define XB_TOPGEN   3392
#define XCD_BAR_WORDS 3456
#define XB_SPIN_CAP (1u << 18)
__device__ __forceinline__ unsigned xb_ld(unsigned* p)              { return __hip_atomic_load(p, __ATOMIC_RELAXED, __HIP_MEMORY_SCOPE_AGENT); }
__device__ __forceinline__ unsigned xb_add(unsigned* p, unsigned v) { return __hip_atomic_fetch_add(p, v, __ATOMIC_RELAXED, __HIP_MEMORY_SCOPE_AGENT); }
__device__ __forceinline__ unsigned xb_xcc_id() { return (unsigned)__builtin_amdgcn_s_getreg((3 << 11) | 20) & 0xFu; }
#define XB_SPIN(cond, bar) do { unsigned _sp = 0; while (cond) { __builtin_amdgcn_s_sleep(1); \
    if ((++_sp & 255u) == 0u) { if (xb_ld(&(bar)[XB_TMO])) break; if (_sp > XB_SPIN_CAP) { atomicAdd(&(bar)[XB_TMO], 1u); break; } } } } while (0)
struct XcdBarrier { unsigned* bar; unsigned x; volatile LAS unsigned* st; };
__device__ __forceinline__ XcdBarrier xcd_barrier_post(unsigned* bar, volatile LAS unsigned* st, int tid) {
    XcdBarrier b; b.bar = bar; b.x = xb_xcc_id(); b.st = st;
    if (tid == 0) (void)xb_add(&bar[XB_XCNT(b.x)], 1u);
    return b;
}
__device__ __forceinline__ void xcd_barrier_complete(unsigned* bar, unsigned x, unsigned& nloc, unsigned& nx) {
    const unsigned G = gridDim.x * gridDim.y * gridDim.z;
    unsigned sum, cnt, mine, sp = 0u;
    for (;;) {
        sum = 0u; cnt = 0u; mine = 0u;
#pragma unroll
        for (unsigned j = 0; j < 16; ++j) { const unsigned c = xb_ld(&bar[XB_XCNT(j)]); sum += c; cnt += (c > 0u) ? 1u : 0u; mine = (j == x) ? c : mine; }
        if (sum == G) break;
        __builtin_amdgcn_s_sleep(1);
        if ((++sp & 255u) == 0u) { if (xb_ld(&bar[XB_TMO])) break; if (sp > XB_SPIN_CAP) { atomicAdd(&bar[XB_TMO], 1u); break; } }
    }
    nloc = mine > 0u ? mine : 1u; nx = cnt > 0u ? cnt : 1u;
}
__device__ __forceinline__ void xcd_barrier(const XcdBarrier& b, int tid) {
    asm volatile("s_waitcnt vmcnt(0)" ::: "memory");
    __syncthreads();
    if (tid == 0) {
        unsigned* bar = b.bar;
        __builtin_amdgcn_s_waitcnt(0);
        unsigned nloc = b.st[0], nx = b.st[1];
        if (nloc == 0u) { xcd_barrier_complete(bar, b.x, nloc, nx); b.st[0] = nloc; b.st[1] = nx; }
        const unsigned old = xb_add(&bar[XB_XSUB(b.x)], 1u);
        const unsigned gen = old / nloc;
        if (old + 1u == (gen + 1u) * nloc) {
            __builtin_amdgcn_fence(__ATOMIC_RELEASE, "agent");
            asm volatile("s_waitcnt vmcnt(0)" ::: "memory");
            const unsigned og = xb_add(&bar[XB_TOP], 1u);
            const unsigned tg = og / nx;
            if (og + 1u == (tg + 1u) * nx) xb_add(&bar[XB_TOPGEN], 1u);
            else XB_SPIN(xb_ld(&bar[XB_TOPGEN]) == tg, bar);
            __builtin_amdgcn_fence(__ATOMIC_ACQUIRE, "agent");
            xb_add(&bar[XB_XGEN(b.x)], 1u);
            asm volatile("s_waitcnt vmcnt(0)" ::: "memory");
        } else {
            XB_SPIN(xb_ld(&bar[XB_XGEN(b.x)]) == gen, bar);
            __builtin_amdgcn_fence(__ATOMIC_ACQUIRE, "agent");
            asm volatile("s_waitcnt vmcnt(0)" ::: "memory");
        }
    }
    __syncthreads();
}

__global__ void __launch_bounds__(512, 2) fwd_kernel(Args a) {
    extern __shared__ __attribute__((aligned(16))) unsigned char lds_raw[];
    LAS unsigned char* lds = (LAS unsigned char*)lds_raw;
    unsigned char* ws0 = a.ws;
    volatile LAS unsigned* MISC = (volatile LAS unsigned*)(lds + 131072);
    const int wave0 = __builtin_amdgcn_readfirstlane((int)threadIdx.x >> 6);
#define MYTID() (wave0 * 64 + lane_id_())
    if (MYTID() < 64) MISC[MYTID()] = 0u;
    __syncthreads();
    XcdBarrier xbar; xbar.bar = (unsigned*)(ws0 + WS_CTL); xbar.x = 0; xbar.st = nullptr;
    if (a.coop) xbar = xcd_barrier_post((unsigned*)(ws0 + WS_CTL), MISC + 8, MYTID());

#define PH_PROLOG const __attribute__((address_space(4))) Args* ap = (const __attribute__((address_space(4))) Args*)__builtin_amdgcn_kernarg_segment_ptr(); asm volatile("" : "+s"(ap)); const float* x_in = ap->in[0]; const float* c_in = ap->in[1]; const float* ctx_in = ap->in[2]; const float* cctx_in = ap->in[3]; const float* norm_w = ap->in[4]; const float* w_mod = ap->in[5]; const float* b_mod = ap->in[6]; const float* w_in = ap->in[7]; const float* conv_w = ap->in[8]; const float* w_a_out = ap->in[9]; const float* w_b_out = ap->in[10]; const float* attn_sink = ap->in[11]; const float* w_o = ap->in[12]; const float* fnorm_w = ap->in[13]; unsigned char* ws = ap->ws; bf16_t* WIN_T = (bf16_t*)(ws + WS_WIN_T); bf16_t* WAB_T = (bf16_t*)(ws + WS_WAB_T); bf16_t* WO_T = (bf16_t*)(ws + WS_WO_T); float* MOD = (float*)(ws + WS_MOD); float* NW1 = (float*)(ws + WS_NW1); float* SB = (float*)(ws + WS_SB); float* ROPEC = (float*)(ws + WS_ROPE); float* ROPES = ROPEC + 64 * 16; float* SSP = (float*)(ws + WS_SSP); resid_t* XCTX = (resid_t*)(ws + WS_XCTX); bf16_t* XS = (bf16_t*)(ws + WS_XS); bf16_t* P = (bf16_t*)(ws + WS_P); float* OUT = ap->out; (void)x_in; (void)c_in; (void)ctx_in; (void)cctx_in; (void)norm_w; (void)w_mod; (void)b_mod; (void)w_in; (void)conv_w; (void)w_a_out; (void)w_b_out; (void)attn_sink; (void)w_o; (void)fnorm_w; (void)WIN_T; (void)WAB_T; (void)WO_T; (void)MOD; (void)NW1; (void)SB; (void)ROPEC; (void)ROPES; (void)SSP; (void)XCTX; (void)XS; (void)P; (void)OUT; int tid = MYTID(), bx = blockIdx.x; asm volatile("" : "+v"(tid), "+s"(bx)); const int lane = tid & 63, wave = __builtin_amdgcn_readfirstlane(tid >> 6); const int G = gridDim.x; const int gw = bx * 8 + wave, NGW = G * 8; (void)lane; (void)gw; (void)NGW;
#define DUP_ON(k) ((DUP_MASK >> (k)) & 1)
#if MK_COOP
#define SEAM_SYNC() do { if (a.coop) xcd_barrier(xbar, MYTID()); __syncthreads(); } while (0)
#else
#define SEAM_SYNC() do { } while (0)
#endif
    if (a.ph_lo == 0 && (PHMASK & 1)) { PH_PROLOG
          for (int rep = DUP_ON(0) ? 0 : 1; rep < 2; ++rep) {
            constexpr int NMOD = DEPTH * 48;
            if (bx < NMOD) {
                LAS float* tab = (LAS float*)lds;
#pragma clang loop vectorize(disable) interleave(disable) unroll(disable)
                for (int idx = tid; idx < 17 * 1024; idx += 512) { const int r = idx >> 10, k = idx & 1023; const float v = (r < 16) ? c_in[r * 1024 + k] : cctx_in[k]; tab[idx] = siluf_(v); }
                __syncthreads();
                for (int it = bx; it < NMOD; it += G) { const int l = it / 48, ec = it % 48;
                    rowmat17_item(tid, lds, w_mod + (size_t)l * 1024 * 3072, 3072, ec * 64, b_mod + l * 3072, MOD + (size_t)l * 17 * 3072, 3072); }
            }
            __syncthreads();
            if (bx == G - 1) { for (int idx = tid; idx < 64 * 16; idx += 512) { const int pos = idx >> 4, f = idx & 15; const float invf = powf(10000.0f, -(float)f / 16.0f); const float ang = (float)pos * invf;
                    ROPEC[idx] = cosf(ang); ROPES[idx] = sinf(ang); } }
            LAS float* scr = (LAS float*)(lds + wave * 16384);
            constexpr int I_IN = 16 * 168, I_A = 8 * 32, I_O = 16 * 32;
            constexpr int NITEMS = I_IN + DEPTH * (2 * I_A + I_O);
            for (int it = gw; it < NITEMS; it += NGW) {
                int r = it;
                if (r < I_IN) { transpose_item(w_in, NCOL, WIN_T, 1024, 0, 168, scr, r, lane); continue; } r -= I_IN;
                const int l = r / (2 * I_A + I_O); r -= l * (2 * I_A + I_O);
                if (r < I_A) { transpose_item(w_a_out + (size_t)l * 512 * 1024, 1024, WAB_T + (size_t)l * 1024 * 1024, 1024, 0, 32, scr, r, lane); continue; } r -= I_A;
                if (r < I_A) { transpose_item(w_b_out + (size_t)l * 512 * 1024, 1024, WAB_T + (size_t)l * 1024 * 1024, 1024, 512, 32, scr, r, lane); continue; } r -= I_A;
                transpose_item(w_o + (size_t)l * 1024 * 1024, 1024, WO_T + (size_t)l * 1024 * 1024, 1024, 0, 32, scr, r, lane);
            }
            if (rep == 0) SEAM_SYNC();
          }
    }
    if (a.ph_lo == 0 && a.ph_hi > 1) {
#if MK_COOP
        if (a.coop) cg::this_grid().sync();
#endif
        __syncthreads();
    }
    for (int ph = (a.ph_lo == 0 ? 1 : a.ph_lo); ph < a.ph_hi; ++ph) {
        if (ph == 1 && (PHMASK & 2)) { PH_PROLOG
          for (int rep = DUP_ON(1) ? 0 : 1; rep < 2; ++rep) {
            constexpr int NSB = DEPTH * 84;
            { int curl = -1;
              for (int it = bx; it < NSB; it += G) { const int l = it / 84, nc = it % 84;
                if (l != curl) { __syncthreads(); LAS float* tab = (LAS float*)lds;
#pragma clang loop vectorize(disable) interleave(disable) unroll(disable)
                    for (int idx = tid; idx < 17 * 1024; idx += 512) { const int r = idx >> 10, k = idx & 1023; tab[idx] = MOD[((size_t)l * 17 + r) * 3072 + k]; }
                    __syncthreads(); curl = l; }
                rowmat17_item(tid, lds, w_in + (size_t)l * 1024 * NCOL, NCOL, nc * 64, nullptr, SB + (size_t)l * 17 * NCOL, NCOL); } }
            for (int idx = bx * 512 + tid; idx < DEPTH * 17 * 1024; idx += G * 512) { const int k = idx & 1023, lr = idx >> 10, l = lr / 17;
                NW1[idx] = norm_w[l * 1024 + k] * (1.0f + MOD[(size_t)lr * 3072 + 1024 + k]); }
            for (int row0 = gw * 3; row0 < TT; row0 += NGW * 3) {
                f32x4 v[3][4]; float ss[3];
#pragma unroll
                for (int q = 0; q < 3; ++q) { const int row = row0 + q; const bool lat = row < TL;
                    const f32x4* xr = (const f32x4*)(lat ? x_in + (size_t)row * DM : ctx_in + (size_t)(row - TL) * DM) + lane;
#pragma unroll
                    for (int j = 0; j < 4; ++j) v[q][j] = xr[64 * j]; }
#pragma unroll
                for (int q = 0; q < 3; ++q) { float s_ = 0.f;
#pragma unroll
                    for (int j = 0; j < 4; ++j) s_ += (v[q][j][0] * v[q][j][0] + v[q][j][1] * v[q][j][1]) + (v[q][j][2] * v[q][j][2] + v[q][j][3] * v[q][j][3]);
                    ss[q] = wave_sum(s_, lane); }
#pragma unroll
                for (int q = 0; q < 3; ++q) { const int row = row0 + q; const bool lat = row < TL; const int b = lat ? (row >> 11) : 16;
                    const f32x4* nwp = (const f32x4*)norm_w + lane; const f32x4* scp = (const f32x4*)(MOD + (size_t)b * 3072 + 1024) + lane;
                    u32x2* o8 = (u32x2*)(XS + (size_t)row * DM) + lane;
#if RESID_BF16
                    u32x2* x8 = (u32x2*)(lat ? (bf16_t*)OUT + (size_t)row * DM : XCTX + (size_t)(row - TL) * DM) + lane;
#endif
#pragma unroll
                    for (int j = 0; j < 4; ++j) { const f32x4 hh = v[q][j] * (nwp[64 * j] * (scp[64 * j] + 1.0f)); u32x2 w; w.x = cvt_pk_bf16(hh[0], hh[1]); w.y = cvt_pk_bf16(hh[2], hh[3]); o8[64 * j] = w;
#if RESID_BF16
                        u32x2 wx; wx.x = cvt_pk_bf16(v[q][j][0], v[q][j][1]); wx.y = cvt_pk_bf16(v[q][j][2], v[q][j][3]); x8[64 * j] = wx;
#endif
                    }
                    if (lane < 16) SSP[(size_t)row * 16 + lane] = (lane == 0) ? ss[q] : 0.f; }
            }
            if (rep == 0) SEAM_SYNC();
          }
        } else if (ph == NPHASE - 1 && (PHMASK & 4)) { PH_PROLOG
            for (int row = gw; row < TL; row += NGW) {
                float s = SSP[(size_t)row * 16 + (lane & 15)];
                s += shx(s, lane, 1); s += shx(s, lane, 2); s += shx(s, lane, 4); s += shx(s, lane, 8);
                const float rinv = 1.0f / sqrtf(s * (1.0f / 1024.0f) + RMS_EPS);
                f32x4* xr = (f32x4*)(OUT + (size_t)row * DM) + lane; const f32x4* fw = (const f32x4*)fnorm_w + lane;
#if RESID_BF16
                const u32x2* xb = (const u32x2*)(XS + (size_t)row * DM) + lane;
#pragma unroll
                for (int j = 0; j < 4; ++j) { const u32x2 w = xb[64 * j]; const f32x4 v = (f32x4){bf_lo(w.x), bf_hi(w.x), bf_lo(w.y), bf_hi(w.y)}; xr[64 * j] = v * rinv * fw[64 * j]; }
#else
#pragma unroll
                for (int j = 0; j < 4; ++j) { const f32x4 v = xr[64 * j]; xr[64 * j] = v * rinv * fw[64 * j]; }
#endif
            }
        } else {
            const int l = (ph - 2) >> 2, sub = (ph - 2) & 3;
            const bool lastl = (l == DEPTH - 1);
            if (sub == 0 && (PHMASK & 8)) { PH_PROLOG
                pg8::Gemm g{XS, WIN_T, DM, DM};
                pg8::Order S; if (!lastl) S.init(TT / 256, NCOL / 256, G, bx); else S.init(TL / 256, NCOL / 256, G, bx, NB, TL / 256, 10);
                { LAS float* rt = (LAS float*)(lds + LDS_ROPE_OFF); for (int idx = tid; idx < 2048; idx += 512) rt[idx] = ROPEC[idx]; __syncthreads(); }
                for (int rep = DUP_ON(3) ? 0 : 1; rep < 2; ++rep) { EpiG1 E{P, SSP, SB + (size_t)l * 17 * NCOL, lds, rep == 0 ? PROBE_SKIP : 0};
                    pg8::gemm_phase<EpiG1, pg8::Order, true>(tid, lds, g, S, E, rep == 0 ? (unsigned)(((bx >> 3) & 31) * PROBE_STAGGER) : 0u); if (rep == 0) SEAM_SYNC(); }
            } else if (sub == 1 && (PHMASK & 16)) { PH_PROLOG
                const float* sink = attn_sink + l * 8;
                const int nlat = 1024, nctx = lastl ? 0 : 128;
              for (int rep = DUP_ON(4) ? 0 : 1; rep < 2; ++rep) {
                bf16_t* Oo = rep ? P : XS; const int opitch = rep ? NCOL : 1024, ocol = rep ? C_Q : 512, ycol = rep ? C_ZA : 0;
                if (!(rep == 0 && PROBE_AT == 2)) {
#if ATTN_V3
                    for (int ua = bx; ua < nlat + nctx; ua += G) { const AUnit D = aunit(ua, wave, nlat);
                        at3::attn_unit<8>(tid, lds, P, Oo, opitch, ocol, D.rowQ0, D.h, D.kh, D.qq0, D.nloc, D.jlo, D.kr_loc0, D.kr_ctx0, sink[D.h] * LOG2E); }
#else
                    attn_phase2(lds, tid, P, Oo, opitch, ocol, sink, bx, G, nlat, nlat + nctx, rep == 0 ? PROBE_ATV : 0);
#endif
                }
                __syncthreads();
                const int nruns = (lastl ? TL : TT) / 8;
                for (int it = (NGW - 1 - gw); it < nruns && !(rep == 0 && PROBE_AT == 1); it += NGW) conv_run8(P, Oo, opitch, ycol, conv_w + (size_t)l * 3 * 512, it, lane);
                if (rep == 0) SEAM_SYNC();
              }
            } else if (sub == 2 && (PHMASK & 32)) { PH_PROLOG
                pg8::Gemm g{P + C_ZA, WAB_T + (size_t)l * 1024 * 1024, NCOL, DM};
                pg8::Order S; S.init((lastl ? TL : TT) / 256, 4, G, bx);
                for (int rep = DUP_ON(5) ? 0 : 1; rep < 2; ++rep) {
                    EpiG2 E{P, rep ? P : XS, rep ? NCOL : 1024, rep ? C_GA : 0};
                    pg8::gemm_phase<EpiG2, pg8::Order, true>(tid, lds, g, S, E); if (rep == 0) SEAM_SYNC(); }
                if (!lastl) {
                    const int tid_t = MYTID(); int bx_t = blockIdx.x; asm volatile("" : "+s"(bx_t));
                    const int lane_t = tid_t & 63, wave_t = __builtin_amdgcn_readfirstlane(tid_t >> 6);
                    const int nunits = (TT / 256) * 4, nfull = nunits % G;
                    const int b0 = (nfull == 0) ? 0 : nfull, nb = G - b0;
                    if (bx_t >= b0) { LAS float* scr = (LAS float*)(lds + wave_t * 16384);
                        for (int it = (bx_t - b0) * 8 + wave_t; it < 16 * 168; it += nb * 8) transpose_item(w_in + (size_t)(l + 1) * 1024 * NCOL, NCOL, WIN_T, 1024, 0, 168, scr, it, lane_t);
                    }
                }
            } else if (PHMASK & 64) { PH_PROLOG
                pg8::Gemm g{P + C_GA, WO_T + (size_t)l * 1024 * 1024, NCOL, DM};
                pg8::Order S; S.init((lastl ? TL : TT) / 256, 4, G, bx);
                for (int rep = DUP_ON(6) ? 0 : 1; rep < 2; ++rep) {
                    #if RESID_BF16
                    EpiG3 E{(const bf16_t*)OUT, XCTX, lastl ? XS : (bf16_t*)OUT, XCTX, MOD + (size_t)l * 17 * 3072 + 2048, lastl ? nullptr : NW1 + (size_t)(l + 1) * 17 * 1024, XS, SSP, lds};
#else
                    EpiG3 E{l == 0 ? x_in : OUT, l == 0 ? ctx_in : XCTX, OUT, XCTX, MOD + (size_t)l * 17 * 3072 + 2048, lastl ? nullptr : NW1 + (size_t)(l + 1) * 17 * 1024, XS, SSP, lds};
#endif
                    pg8::gemm_phase<EpiG3, pg8::Order, true>(tid, lds, g, S, E); if (rep == 0) SEAM_SYNC(); }
            }
        }
        if (ph + 1 < a.ph_hi) {
#if MK_COOP
            if (a.coop) xcd_barrier(xbar, MYTID());
#endif
            __syncthreads();
        }
    }
}

extern "C" void kernel_launch(void* const* d_in, const int* in_sizes, int n_in, void* d_out, int out_size, void* d_ws, size_t ws_size, hipStream_t stream) {
    static int grid = 0;
    if (grid == 0) {
        if (n_in != 14 || in_sizes[0] != TL * DM || out_size != TL * DM || ws_size < WS_END) {
            fprintf(stderr, "kernel_launch: unexpected shapes (n_in %d, in0 %d, out %d, ws %zu need %zu); nothing launched\n", n_in, n_in > 0 ? in_sizes[0] : -1, out_size, ws_size, (size_t)WS_END); grid = -1; return; }
        int dev = 0, cus = 0;
        if (hipGetDevice(&dev) != hipSuccess || hipDeviceGetAttribute(&cus, hipDeviceAttributeMultiprocessorCount, dev) != hipSuccess || cus <= 0) cus = 256;
        if (hipFuncSetAttribute((const void*)fwd_kernel, hipFuncAttributeMaxDynamicSharedMemorySize, LDS_BYTES) != hipSuccess) { fprintf(stderr, "kernel_launch: hipFuncSetAttribute failed\n"); grid = -1; return; }
        int per_cu = 0;
        if (hipOccupancyMaxActiveBlocksPerMultiprocessor(&per_cu, (const void*)fwd_kernel, 512, LDS_BYTES) != hipSuccess || per_cu < 1) { fprintf(stderr, "kernel_launch: occupancy query says %d\n", per_cu); (void)hipGetLastError(); }
        grid = cus;
    }
    if (grid < 0) return;
    Args a{};
    for (int i = 0; i < 14; ++i) a.in[i] = (const float*)d_in[i];
    a.out = (float*)d_out; a.ws = (unsigned char*)d_ws;
#if MK_COOP
    if (hipMemsetAsync((char*)d_ws + WS_CTL, 0, CTL_ZERO_BYTES, stream) != hipSuccess) { fprintf(stderr, "kernel_launch: memset failed\n"); return; }
    a.ph_lo = 0; a.ph_hi = NPHASE; a.coop = 1;
    void* args[] = {&a};
    hipError_t e = hipLaunchCooperativeKernel((const void*)fwd_kernel, dim3(grid), dim3(512), args, LDS_BYTES, stream);
    if (e != hipSuccess) fprintf(stderr, "cooperative launch failed: %s (grid %d)\n", hipGetErrorString(e), grid);
#else
    for (int ph = 0; ph < NPHASE; ++ph) {
        a.ph_lo = ph; a.ph_hi = ph + 1; a.coop = 0;
        hipLaunchKernelGGL(fwd_kernel, dim3(grid), dim3(512), LDS_BYTES, stream, a);
    }
#endif
}
```

```cpp
#include <hip/hip_runtime.h>
#include <hip/hip_cooperative_groups.h>
#include <cstdio>
#include <cstdint>
namespace cg = cooperative_groups;

#ifndef PHMASK
#define PHMASK 127
#endif
#ifndef PROBE_SKIP
#define PROBE_SKIP 0
#endif
#ifndef PROBE_STAGGER
#define PROBE_STAGGER 0
#endif
#ifndef PROBE_AT
#define PROBE_AT 0
#endif
#ifndef PROBE_ATV
#define PROBE_ATV 0
#endif
#ifndef ATTN_V3
#define ATTN_V3 1
#endif
#ifndef RESID_BF16
#define RESID_BF16 0
#endif
#ifndef DUP_MASK
#define DUP_MASK 0
#endif
#ifndef MK_COOP
#define MK_COOP 1
#endif

#define LAS __attribute__((address_space(3)))
typedef unsigned short bf16_t;
typedef short bf16x8 __attribute__((ext_vector_type(8)));
typedef short s16x4 __attribute__((ext_vector_type(4)));
typedef short v4i16_t __attribute__((ext_vector_type(4)));
typedef float f32x4 __attribute__((ext_vector_type(4)));
typedef float f32x16 __attribute__((ext_vector_type(16)));
typedef unsigned u32x4 __attribute__((ext_vector_type(4)));
typedef unsigned u32x2 __attribute__((ext_vector_type(2)));

constexpr int DM = 1024, NB = 16, SEQ = 2048, CTXL = 256, DEPTH = 4, NIN = 5376, NCOL = 4352;
constexpr int TL = NB * SEQ, TC = NB * CTXL, TT = TL + TC;
constexpr int C_CU = 0, C_BZ = 512, C_Q = 1024, C_K = 1536, C_V = 1664, C_ZB = 1792, C_GA = 2304, C_GB = 3328;
__host__ __device__ __forceinline__ int orig_col(int c) { const int t = c >> 8, h = (c >> 7) & 1, o = c & 127; return (t < 4) ? (h ? 1024 : 512) + t * 128 + o : (t < 8) ? (h ? 1536 : 0) + (t - 4) * 128 + o : c; }
constexpr float RMS_EPS = 1e-6f;
constexpr float LOG2E = 1.4426950408889634f;
constexpr float QSCALE = 0.125f * LOG2E;

constexpr size_t MiB = 1u << 20;
constexpr size_t WS_CTL = 0, CTL_ZERO_BYTES = 65536;
constexpr size_t WS_WIN_T = 1 * MiB;
constexpr size_t WS_WAB_T = 12 * MiB;
constexpr size_t WS_WO_T = 20 * MiB;
constexpr size_t WS_MOD = 28 * MiB;
constexpr size_t WS_NW1 = 29 * MiB;
constexpr size_t WS_SB = 30 * MiB;
constexpr size_t WS_ROPE = 32 * MiB;
constexpr size_t WS_SSP = 33 * MiB;
constexpr size_t WS_XCTX = 36 * MiB;
constexpr size_t WS_XS = 52 * MiB;
constexpr size_t WS_P = 124 * MiB;
constexpr size_t WS_END = WS_P + (size_t)TT * NCOL * 2;
static_assert(WS_END <= 502 * MiB && C_BZ + 512 == C_Q && C_GB + 1024 == NCOL, "ws map / P columns");

constexpr int LDS_EPI_OFF = 131072 + 1024;
constexpr int LDS_ROPE_OFF = 131072 + 1024 + 2048;
constexpr int LDS_BYTES = 131072 + 1024 + 2048 + 8192;
constexpr int NPHASE = 2 + 4 * DEPTH + 1;

struct Args { const float* in[14]; float* out; unsigned char* ws; int ph_lo, ph_hi, coop, pad; };

__device__ __forceinline__ unsigned cvt_pk_bf16(float lo, float hi) { unsigned r; asm volatile("v_cvt_pk_bf16_f32 %0, %1, %2" : "=v"(r) : "v"(lo), "v"(hi)); return r; }
__device__ __forceinline__ float bf_lo(unsigned w) { return __uint_as_float(w << 16); }
__device__ __forceinline__ float bf_hi(unsigned w) { return __uint_as_float(w & 0xffff0000u); }
__device__ __forceinline__ float fast_exp(float x) { return __builtin_amdgcn_exp2f(x * LOG2E); }
__device__ __forceinline__ float sigmoidf_(float x) { return __builtin_amdgcn_rcpf(1.0f + fast_exp(-x)); }
__device__ __forceinline__ float siluf_(float x) { return x * sigmoidf_(x); }
__device__ __forceinline__ float shx(float v, int lane, int m) { return __int_as_float(__builtin_amdgcn_ds_bpermute((lane ^ m) << 2, __float_as_int(v))); }
__device__ __forceinline__ float shl_(float v, int src) { return __int_as_float(__builtin_amdgcn_ds_bpermute(src << 2, __float_as_int(v))); }
__device__ __forceinline__ float wave_sum(float v, int lane) {
#pragma unroll
    for (int o = 1; o < 64; o <<= 1) v += shx(v, lane, o);
    return v;
}
__device__ __forceinline__ int lane_id_() { int r; asm volatile("v_mbcnt_lo_u32_b32 %0, -1, 0\n\tv_mbcnt_hi_u32_b32 %0, -1, %0" : "=v"(r)); return r; }
#define LDS_WAIT() asm volatile("s_waitcnt lgkmcnt(0)" ::: "memory")
#define VM_WAIT() asm volatile("s_waitcnt vmcnt(0)" ::: "memory")

namespace pg8 {
constexpr int BM = 256, BK = 64, HALF = 128, HTB = HALF * BK * 2, STAGE_BYTES = 8 * HTB, NXCD = 8, WGM = 8;
__host__ __device__ __forceinline__ int lds_byte(int r, int c) { const int st = (r >> 4) * 2 + (c >> 5), rr = r & 15, cc = c & 31, ob = rr * 64 + cc * 2; return st * 1024 + (ob ^ (((ob >> 9) & 1) << 5)); }
__host__ __device__ __forceinline__ void stage_rc(int b, int& R, int& C) { const int st = b / 1024, sb = b % 1024, swz = sb ^ (((sb >> 9) & 1) << 5); R = (st >> 1) * 16 + swz / 64; C = (st & 1) * 32 + (swz % 64) / 2; }
__host__ __device__ __forceinline__ int perm32(int rho) { const int n = rho >> 4, i = rho & 15; return 8 * (i >> 2) + 4 * n + (i & 3); }

struct Unit { int pm, pn; };
struct Gemm { const bf16_t* A; const bf16_t* Bt; int lda; int K; };

struct Order {
    int nM, nN, nwg, G, c, nextra, extra_pm0, extra_pn;
    __device__ void init(int nM_, int nN_, int G_, int c_, int nextra_ = 0, int epm0 = 0, int epn = 0) { nM = nM_; nN = nN_; nwg = nM * nN; G = G_; c = c_; nextra = nextra_; extra_pm0 = epm0; extra_pn = epn; }
    __device__ bool next(int i, Unit& u) const {
        const long L = (long)i * G + c; if (L >= nwg + nextra) return false;
        if (L >= nwg) { u.pm = extra_pm0 + (int)(L - nwg); u.pn = extra_pn; return true; }
        int wgid = (int)L; { const int q = nwg / NXCD, r = nwg % NXCD, xcd = wgid % NXCD, off = wgid / NXCD; wgid = (xcd < r ? xcd * (q + 1) : r * (q + 1) + (xcd - r) * q) + off; }
        const int nig = WGM * nN, gid = wgid / nig, fm = gid * WGM, gsz = (nM - fm) < WGM ? (nM - fm) : WGM;
        u.pm = fm + ((wgid % nig) % gsz); u.pn = (wgid % nig) / gsz; return true;
    }
};

template <class Epi, class Sched, bool ALIGN_EPI>
__device__ __forceinline__ void gemm_phase(int tid_in, LAS unsigned char* lds, const Gemm g, const Sched& S, const Epi& E, unsigned stagger_ticks = 0) {
    if (stagger_ticks) { const unsigned long long t0_ = __builtin_amdgcn_s_memrealtime(); while (__builtin_amdgcn_s_memrealtime() - t0_ < stagger_ticks) __builtin_amdgcn_s_sleep(8); }
    int tid = tid_in; asm volatile("" : "+v"(tid));
    const int wid = __builtin_amdgcn_readfirstlane(tid >> 6), lane = tid & 63, wr = wid >> 2, wc = wid & 3, fr = lane & 15, fq = lane >> 4;
    const int K = g.K, nt = K / BK, lda = g.lda;
    unsigned voffA[2], voffB[2];
#pragma unroll
    for (int i = 0; i < 2; ++i) { int R, C; stage_rc(tid * 16 + i * 8192, R, C); const int Rb = Epi::PERM ? ((R & ~31) + perm32(R & 31)) : R;
        voffA[i] = (unsigned)(R * lda + C) * 2u; voffB[i] = (unsigned)(Rb * K + C) * 2u; }
    const size_t kstep = (size_t)(BK * 2);
    const size_t hstepA = (size_t)HALF * lda * 2, tstepA = 2 * hstepA;
    const size_t hstepB = (size_t)HALF * K * 2, tstepB = 2 * hstepB;
    const unsigned ldsw = (unsigned)wid * 1024u;
    const int aoff = lds_byte(wr * 64 + fr, fq * 8), boff = lds_byte(wc * 32 + fr, fq * 8);
#define PG8_SA(b, h) (((b) * 2 + (h)) * HTB)
#define PG8_SB(b, h) ((4 + (b) * 2 + (h)) * HTB)
#define PG8_STAGE(bufoff, gbase, voff) do { _Pragma("unroll") for (int _i = 0; _i < 2; ++_i) \
        __builtin_amdgcn_global_load_lds((const unsigned*)((const char*)(gbase) + (voff)[_i]), (LAS unsigned*)(lds + (bufoff) + ldsw + _i * 8192), 16, 0, 0); } while (0)
#define PG8_LDA(dst, b, h) do { _Pragma("unroll") for (int m = 0; m < 4; ++m) _Pragma("unroll") for (int k = 0; k < 2; ++k) dst[m][k] = *(const LAS bf16x8*)(lds + PG8_SA(b, h) + aoff + m * 2048 + k * 1024); } while (0)
#define PG8_LDB(dst, b, h) do { _Pragma("unroll") for (int n = 0; n < 2; ++n) _Pragma("unroll") for (int k = 0; k < 2; ++k) dst[n][k] = *(const LAS bf16x8*)(lds + PG8_SB(b, h) + boff + n * 2048 + k * 1024); } while (0)
#define PG8_MMA(ai, bj, At, Bt) do { __builtin_amdgcn_s_setprio(1); _Pragma("unroll") for (int m = 0; m < 4; ++m) _Pragma("unroll") for (int n = 0; n < 2; ++n) _Pragma("unroll") for (int k = 0; k < 2; ++k) \
        acc[ai][bj][m][n] = __builtin_amdgcn_mfma_f32_16x16x32_bf16(Bt[n][k], At[m][k], acc[ai][bj][m][n], 0, 0, 0); __builtin_amdgcn_s_setprio(0); } while (0)
#define PG8_WAIT_V(n) asm volatile("s_waitcnt vmcnt(" #n ")" ::: "memory")
#define PG8_WAIT_L(n) asm volatile("s_waitcnt lgkmcnt(" #n ")" ::: "memory")
#define PG8_BAR __builtin_amdgcn_s_barrier()
#define PG8_SCHED __builtin_amdgcn_sched_barrier(0)
    Unit cur, nxt; int ui = 0;
    if (!S.next(0, cur)) return;
    f32x4 acc[2][2][4][2];
#pragma unroll
    for (int a = 0; a < 2; ++a)
#pragma unroll
        for (int b = 0; b < 2; ++b)
#pragma unroll
            for (int m = 0; m < 4; ++m)
#pragma unroll
                for (int n = 0; n < 2; ++n) acc[a][b][m][n] = (f32x4){0.f, 0.f, 0.f, 0.f};
    bf16x8 At[4][2], B0[2][2], B1[2][2];
    const char* cA = (const char*)g.A + (size_t)cur.pm * tstepA; const char* cB = (const char*)g.Bt + (size_t)cur.pn * tstepB;
    PG8_STAGE(PG8_SB(0, 0), cB, voffB); PG8_STAGE(PG8_SB(0, 1), cB + hstepB, voffB); PG8_STAGE(PG8_SA(0, 0), cA, voffA); PG8_STAGE(PG8_SA(0, 1), cA + hstepA, voffA);
    if (wr == 1) PG8_BAR;
    PG8_WAIT_V(2); PG8_BAR;
    PG8_STAGE(PG8_SB(1, 0), cB + kstep, voffB); PG8_STAGE(PG8_SA(1, 0), cA + kstep, voffA); PG8_STAGE(PG8_SB(1, 1), cB + hstepB + kstep, voffB);
    PG8_WAIT_V(6); PG8_BAR;
    for (;;) {
        const bool has_next = S.next(ui + 1, nxt);
        const char* nA = has_next ? (const char*)g.A + (size_t)nxt.pm * tstepA : cA; const char* nB = has_next ? (const char*)g.Bt + (size_t)nxt.pn * tstepB : cB;
        for (int t = 0; t < nt; t += 2) {
            if constexpr (Epi::HOOK) { if (t == (nt >> 1)) E.mid(acc, cur, wr, wc, fr, fq); }
            const bool last = (t == nt - 2);
            const char* a1 = cA + (size_t)(t + 1) * kstep;
            const char* a2 = last ? nA : cA + (size_t)(t + 2) * kstep; const char* b2 = last ? nB : cB + (size_t)(t + 2) * kstep;
            const char* a3 = a2 + kstep; const char* b3 = b2 + kstep;
            PG8_LDB(B0, 0, 0); PG8_LDB(B1, 0, 1); PG8_SCHED; PG8_LDA(At, 0, 0); PG8_STAGE(PG8_SA(1, 1), a1 + hstepA, voffA);
            PG8_WAIT_V(8); PG8_WAIT_L(0); PG8_BAR; PG8_MMA(0, 0, At, B0); PG8_MMA(0, 1, At, B1); PG8_BAR; PG8_SCHED;
            PG8_LDA(At, 0, 1); PG8_STAGE(PG8_SB(0, 0), b2, voffB); PG8_STAGE(PG8_SB(0, 1), b2 + hstepB, voffB); PG8_STAGE(PG8_SA(0, 0), a2, voffA);
            PG8_WAIT_V(8); PG8_WAIT_L(0); PG8_BAR; PG8_MMA(1, 0, At, B0); PG8_MMA(1, 1, At, B1); PG8_BAR; PG8_SCHED;
            PG8_LDB(B0, 1, 0); PG8_LDB(B1, 1, 1); PG8_SCHED; PG8_LDA(At, 1, 0); PG8_STAGE(PG8_SA(0, 1), a2 + hstepA, voffA);
            PG8_WAIT_V(8); PG8_WAIT_L(0); PG8_BAR; PG8_MMA(0, 0, At, B0); PG8_MMA(0, 1, At, B1); PG8_BAR; PG8_SCHED;
            PG8_LDA(At, 1, 1); PG8_STAGE(PG8_SB(1, 0), b3, voffB); PG8_STAGE(PG8_SB(1, 1), b3 + hstepB, voffB); PG8_STAGE(PG8_SA(1, 0), a3, voffA);
            PG8_WAIT_V(8); PG8_WAIT_L(0); PG8_BAR; PG8_MMA(1, 0, At, B0); PG8_MMA(1, 1, At, B1); PG8_BAR; PG8_SCHED;
        }
        if constexpr (ALIGN_EPI) { if (wr == 0) PG8_BAR; }
        E(acc, cur, wr, wc, fr, fq);
        if (!has_next) break;
#pragma unroll
        for (int a = 0; a < 2; ++a)
#pragma unroll
            for (int b = 0; b < 2; ++b)
#pragma unroll
                for (int m = 0; m < 4; ++m)
#pragma unroll
                    for (int n = 0; n < 2; ++n) acc[a][b][m][n] = (f32x4){0.f, 0.f, 0.f, 0.f};
        cur = nxt; cA = nA; cB = nB; ++ui;
        if constexpr (ALIGN_EPI) { if (wr == 1) PG8_BAR; }
    }
    PG8_WAIT_V(0);
    if constexpr (!ALIGN_EPI) { if (wr == 0) PG8_BAR; }
    PG8_BAR;
#undef PG8_SA
#undef PG8_SB
#undef PG8_STAGE
#undef PG8_LDA
#undef PG8_LDB
#undef PG8_MMA
#undef PG8_WAIT_V
#undef PG8_WAIT_L
#undef PG8_BAR
#undef PG8_SCHED
}
}

struct EpiG1 {
    static constexpr bool PERM = true, HOOK = false;
    bf16_t* P; const float* ssp; const float* sb; LAS unsigned char* ldsc; int skip;
    __device__ __forceinline__ void mid(f32x4 (&)[2][2][4][2], const pg8::Unit&, int, int, int, int) const {}
    __device__ __forceinline__ void operator()(const f32x4 (&acc)[2][2][4][2], const pg8::Unit& u, int wr, int wc, int fr, int fq) const {
        if (skip == 2) { if (acc[0][0][0][0][0] == 12345.678f) P[0] = 1; return; }
        asm volatile("" : "+v"(fr), "+v"(fq));
        const bool latent = u.pm < 128;
        const int bidx = latent ? (u.pm >> 3) : 16;
        const int col8 = u.pn * 256 + wc * 32 + 8 * fq;
        const float* sbr = sb + bidx * NIN + col8;
        f32x4 bv[2][2];
#pragma unroll
        for (int bj = 0; bj < 2; ++bj)
#pragma unroll
            for (int n = 0; n < 2; ++n) bv[bj][n] = *(const f32x4*)(sbr + bj * 128 + n * 4);
        const bool isq = (u.pn == 8 || u.pn == 9), isk = (u.pn == 10);
        const bool anyrope = latent && (isq || isk);
        const float sc = isq ? QSCALE : 1.0f;
        float rinv[8];
        {
            const int ln = fq * 16 + fr;
            f32x4 pv[8];
#pragma unroll
            for (int i = 0; i < 8; ++i) pv[i] = *(const f32x4*)(ssp + (size_t)(u.pm * 256 + (i >> 2) * 128 + wr * 64 + (i & 3) * 16 + (ln >> 2)) * 16 + (ln & 3) * 4);
#pragma unroll
            for (int i = 0; i < 8; ++i) { float q = (pv[i][0] + pv[i][1]) + (pv[i][2] + pv[i][3]); q += shx(q, ln, 1); q += shx(q, ln, 2);
                const float r = 1.0f / sqrtf(q * (1.0f / 1024.0f) + RMS_EPS); rinv[i] = shl_(r, 4 * fr); }
        }
        bf16_t* pb = P + (size_t)u.pm * 256 * NCOL;
        if (u.pn < 8) {
            const bool iscu = u.pn < 4;
            const unsigned lo2 = (unsigned)((wr * 64 + fr) * NCOL + (iscu ? C_CU + u.pn * 128 : C_BZ + (u.pn - 4) * 128) + wc * 32 + 8 * fq);
#pragma unroll
            for (int ai = 0; ai < 2; ++ai)
#pragma unroll
                for (int m = 0; m < 4; ++m) {
                    const float ri = rinv[ai * 4 + m];
                    bf16_t* rowp = pb + (size_t)(ai * 128 + m * 16) * NCOL;
                    const f32x4 a0 = acc[ai][0][m][0] * ri + bv[0][0], a1 = acc[ai][0][m][1] * ri + bv[0][1];
                    const f32x4 b0 = acc[ai][1][m][0] * ri + bv[1][0], b1 = acc[ai][1][m][1] * ri + bv[1][1];
                    f32x4 o0, o1;
                    if (iscu) { o0 = a0 * b0; o1 = a1 * b1; }
                    else {
#pragma unroll
                        for (int e = 0; e < 4; ++e) { o0[e] = a0[e] * siluf_(b0[e]); o1[e] = a1[e] * siluf_(b1[e]); } }
                    u32x4 w; w.x = cvt_pk_bf16(o0[0], o0[1]); w.y = cvt_pk_bf16(o0[2], o0[3]); w.z = cvt_pk_bf16(o1[0], o1[1]); w.w = cvt_pk_bf16(o1[2], o1[3]);
                    *(u32x4*)(rowp + lo2) = w;
                }
            return;
        }
        const unsigned lo = (unsigned)((wr * 64 + fr) * NCOL + C_Q + (u.pn - 8) * 256 + wc * 32 + 8 * fq);
        if (!anyrope) {
#pragma unroll
            for (int ai = 0; ai < 2; ++ai)
#pragma unroll
                for (int m = 0; m < 4; ++m) {
                    const float ri = rinv[ai * 4 + m];
                    bf16_t* rowp = pb + (size_t)(ai * 128 + m * 16) * NCOL;
#pragma unroll
                    for (int bj = 0; bj < 2; ++bj) {
                        const f32x4 v0 = (acc[ai][bj][m][0] * ri + bv[bj][0]) * sc, v1 = (acc[ai][bj][m][1] * ri + bv[bj][1]) * sc;
                        u32x4 w; w.x = cvt_pk_bf16(v0[0], v0[1]); w.y = cvt_pk_bf16(v0[2], v0[3]); w.z = cvt_pk_bf16(v1[0], v1[1]); w.w = cvt_pk_bf16(v1[2], v1[3]);
                        *(u32x4*)(rowp + (lo + (unsigned)(bj * 128))) = w;
                    }
                }
        } else {
            const LAS f32x4* tc4 = (const LAS f32x4*)(ldsc + LDS_ROPE_OFF);
            const LAS f32x4* ts4 = tc4 + 256;
            const float sgn = (fq < 2) ? -1.0f : 1.0f;
            const bool oddw = (wc & 1) != 0;
#pragma unroll
            for (int ai = 0; ai < 2; ++ai)
#pragma unroll
                for (int m = 0; m < 4; ++m) {
                    const int t = (u.pm * 256 + ai * 128 + wr * 64 + m * 16 + fr) & 2047;
                    const int pos = oddw ? (t & 63) : (t >> 6);
                    const int ti = pos * 4 + (fq & 1) * 2;
                    const f32x4 c0 = tc4[ti], c1 = tc4[ti + 1], s0 = ts4[ti], s1 = ts4[ti + 1];
                    const float ri = rinv[ai * 4 + m];
                    bf16_t* rowp = pb + (size_t)(ai * 128 + m * 16) * NCOL;
#pragma unroll
                    for (int bj = 0; bj < 2; ++bj) {
                        f32x4 v0 = acc[ai][bj][m][0] * ri + bv[bj][0], v1 = acc[ai][bj][m][1] * ri + bv[bj][1];
                        if (isq || bj == 0) {
                            f32x4 p0, p1;
#pragma unroll
                            for (int e = 0; e < 4; ++e) { p0[e] = shx(v0[e], fq * 16 + fr, 32); p1[e] = shx(v1[e], fq * 16 + fr, 32); }
                            v0 = v0 * c0 + (p0 * s0) * sgn; v1 = v1 * c1 + (p1 * s1) * sgn;
                        }
                        v0 = v0 * sc; v1 = v1 * sc;
                        u32x4 w; w.x = cvt_pk_bf16(v0[0], v0[1]); w.y = cvt_pk_bf16(v0[2], v0[3]); w.z = cvt_pk_bf16(v1[0], v1[1]); w.w = cvt_pk_bf16(v1[2], v1[3]);
                        *(u32x4*)(rowp + (lo + (unsigned)(bj * 128))) = w;
                    }
                }
        }
    }
};

struct EpiG2 {
    static constexpr bool PERM = true, HOOK = true;
    const bf16_t* P; bf16_t* Mout; int ldm, mcol;
    __device__ __forceinline__ void mid(f32x4 (&acc)[2][2][4][2], const pg8::Unit& u, int wr, int wc, int fr, int fq) const {
        int col8 = u.pn * 256 + wc * 32 + 8 * fq, rbase = u.pm * 256 + wr * 64 + fr;
        asm volatile("" : "+v"(col8), "+v"(rbase));
#pragma unroll
        for (int ai = 0; ai < 2; ++ai) {
            u32x4 ga[4][2], gb[4][2];
#pragma unroll
            for (int m = 0; m < 4; ++m) { const bf16_t* rowp = P + (size_t)(rbase + ai * 128 + m * 16) * NCOL + col8;
#pragma unroll
                for (int bj = 0; bj < 2; ++bj) { ga[m][bj] = *(const u32x4*)(rowp + C_GA + bj * 128); gb[m][bj] = *(const u32x4*)(rowp + C_GB + bj * 128); } }
#pragma unroll
            for (int m = 0; m < 4; ++m)
#pragma unroll
                for (int bj = 0; bj < 2; ++bj)
#pragma unroll
                    for (int w = 0; w < 4; ++w) {
                        const float a0 = bf_lo(ga[m][bj][w]), a1 = bf_hi(ga[m][bj][w]), b0 = bf_lo(gb[m][bj][w]), b1 = bf_hi(gb[m][bj][w]);
                        const float r0 = (1.0f + fast_exp(-b0)) * __builtin_amdgcn_rcpf(1.0f + fast_exp(-a0));
                        const float r1 = (1.0f + fast_exp(-b1)) * __builtin_amdgcn_rcpf(1.0f + fast_exp(-a1));
                        acc[ai][bj][m][w >> 1][(w & 1) * 2] *= r0; acc[ai][bj][m][w >> 1][(w & 1) * 2 + 1] *= r1;
                    }
            asm volatile("" ::: "memory");
        }
    }
    __device__ __forceinline__ void operator()(const f32x4 (&acc)[2][2][4][2], const pg8::Unit& u, int wr, int wc, int fr, int fq) const {
        asm volatile("" : "+v"(fr), "+v"(fq));
        const int col8 = u.pn * 256 + wc * 32 + 8 * fq, rbase = u.pm * 256 + wr * 64 + fr;
        u32x4 gb[2][4][2];
#pragma unroll
        for (int ai = 0; ai < 2; ++ai)
#pragma unroll
            for (int m = 0; m < 4; ++m) { const bf16_t* rowp = P + (size_t)(rbase + ai * 128 + m * 16) * NCOL + col8;
#pragma unroll
                for (int bj = 0; bj < 2; ++bj) gb[ai][m][bj] = *(const u32x4*)(rowp + C_GB + bj * 128); }
#pragma unroll
        for (int ai = 0; ai < 2; ++ai)
#pragma unroll
            for (int m = 0; m < 4; ++m) {
                bf16_t* mrow = Mout + (size_t)(rbase + ai * 128 + m * 16) * ldm + mcol + col8;
#pragma unroll
                for (int bj = 0; bj < 2; ++bj) {
                    u32x4 o;
#pragma unroll
                    for (int w = 0; w < 4; ++w) {
                        const float s0 = sigmoidf_(bf_lo(gb[ai][m][bj][w])), s1 = sigmoidf_(bf_hi(gb[ai][m][bj][w]));
                        o[w] = cvt_pk_bf16(acc[ai][bj][m][w >> 1][(w & 1) * 2] * s0, acc[ai][bj][m][w >> 1][(w & 1) * 2 + 1] * s1);
                    }
                    *(u32x4*)(mrow + bj * 128) = o;
                }
            }
    }
};

#if RESID_BF16
typedef bf16_t resid_t;
#else
typedef float resid_t;
#endif
struct EpiG3 {
    static constexpr bool PERM = true, HOOK = false;
    const resid_t* xin_lat; const resid_t* xin_ctx; resid_t* xout_lat; resid_t* xout_ctx; const float* gate; const float* nw; bf16_t* xs; float* ssp; LAS unsigned char* ldsc;
    __device__ __forceinline__ void mid(f32x4 (&)[2][2][4][2], const pg8::Unit&, int, int, int, int) const {}
    __device__ __forceinline__ void operator()(f32x4 (&acc)[2][2][4][2], const pg8::Unit& u, int wr, int wc, int fr, int fq) const {
        asm volatile("" : "+v"(fr), "+v"(fq));
        const bool latent = u.pm < 128;
        const int bidx = latent ? (u.pm >> 3) : 16;
        const int col8 = u.pn * 256 + wc * 32 + 8 * fq;
        {
            f32x4 gv[2][2];
#pragma unroll
            for (int bj = 0; bj < 2; ++bj)
#pragma unroll
                for (int n = 0; n < 2; ++n) gv[bj][n] = gate ? *(const f32x4*)(gate + bidx * 3072 + col8 + bj * 128 + n * 4) : (f32x4){0.f, 0.f, 0.f, 0.f};
#pragma unroll
            for (int ai = 0; ai < 2; ++ai)
#pragma unroll
                for (int bj = 0; bj < 2; ++bj)
#pragma unroll
                    for (int m = 0; m < 4; ++m)
#pragma unroll
                        for (int n = 0; n < 2; ++n) acc[ai][bj][m][n] = acc[ai][bj][m][n] * gv[bj][n];
        }
        LAS f32x4* nvl = (LAS f32x4*)(ldsc + LDS_EPI_OFF + (wr * 4 + wc) * 256);
        if (nw) { const int ln = fq * 16 + fr; if (ln < 16) nvl[ln] = *(const f32x4*)(nw + bidx * 1024 + u.pn * 256 + wc * 32 + (ln >> 3) * 128 + ((ln >> 1) & 3) * 8 + (ln & 1) * 4); }
        unsigned lo = (unsigned)((wr * 64 + fr) * DM + col8); asm volatile("" : "+v"(lo));
        const resid_t* xib = latent ? xin_lat + (size_t)u.pm * 256 * DM : xin_ctx + (size_t)(u.pm * 256 - TL) * DM;
        resid_t* xob = latent ? xout_lat + (size_t)u.pm * 256 * DM : xout_ctx + (size_t)(u.pm * 256 - TL) * DM;
        bf16_t* xsb = xs + (size_t)u.pm * 256 * DM;
        float* sspb = ssp + (size_t)u.pm * 256 * 16 + u.pn * 4 + wc;
#if RESID_BF16
#pragma unroll
        for (int ai = 0; ai < 2; ++ai) {
            u32x4 xv[4][2];
#pragma unroll
            for (int m = 0; m < 4; ++m)
#pragma unroll
                for (int bj = 0; bj < 2; ++bj) xv[m][bj] = *(const u32x4*)(xib + (size_t)(ai * 128 + m * 16) * DM + (lo + (unsigned)(bj * 128)));
#pragma unroll
            for (int m = 0; m < 4; ++m) {
#else
#pragma unroll
        for (int ai = 0; ai < 2; ++ai)
#pragma unroll
        for (int mh = 0; mh < 2; ++mh) {
            f32x4 xv[2][2][2];
#pragma unroll
            for (int m2 = 0; m2 < 2; ++m2)
#pragma unroll
                for (int bj = 0; bj < 2; ++bj)
#pragma unroll
                    for (int n = 0; n < 2; ++n) xv[m2][bj][n] = *(const f32x4*)(xib + (size_t)(ai * 128 + (mh * 2 + m2) * 16) * DM + (lo + (unsigned)(bj * 128 + n * 4)));
#pragma unroll
            for (int m2 = 0; m2 < 2; ++m2) { const int m = mh * 2 + m2;
#endif
                resid_t* xo = xob + (size_t)(ai * 128 + m * 16) * DM; bf16_t* xsr = xsb + (size_t)(ai * 128 + m * 16) * DM;
                float q = 0.f;
#pragma unroll
                for (int bj = 0; bj < 2; ++bj) {
                    const unsigned off = lo + (unsigned)(bj * 128);
#if RESID_BF16
                    const u32x4 xr = xv[m][bj];
                    const f32x4 x0 = (f32x4){bf_lo(xr[0]), bf_hi(xr[0]), bf_lo(xr[1]), bf_hi(xr[1])} + acc[ai][bj][m][0];
                    const f32x4 x1 = (f32x4){bf_lo(xr[2]), bf_hi(xr[2]), bf_lo(xr[3]), bf_hi(xr[3])} + acc[ai][bj][m][1];
                    u32x4 w; w.x = cvt_pk_bf16(x0[0], x0[1]); w.y = cvt_pk_bf16(x0[2], x0[3]); w.z = cvt_pk_bf16(x1[0], x1[1]); w.w = cvt_pk_bf16(x1[2], x1[3]);
                    *(u32x4*)(xo + off) = w;
#else
                    const f32x4 x0 = xv[m2][bj][0] + acc[ai][bj][m][0], x1 = xv[m2][bj][1] + acc[ai][bj][m][1];
                    *(f32x4*)(xo + off) = x0; *(f32x4*)(xo + off + 4) = x1;
#endif
                    q += ((x0[0] * x0[0] + x0[1] * x0[1]) + (x0[2] * x0[2] + x0[3] * x0[3])) + ((x1[0] * x1[0] + x1[1] * x1[1]) + (x1[2] * x1[2] + x1[3] * x1[3]));
                    if (nw) { const f32x4 h0 = x0 * nvl[bj * 8 + fq * 2], h1 = x1 * nvl[bj * 8 + fq * 2 + 1];
                        u32x4 ws_; ws_.x = cvt_pk_bf16(h0[0], h0[1]); ws_.y = cvt_pk_bf16(h0[2], h0[3]); ws_.z = cvt_pk_bf16(h1[0], h1[1]); ws_.w = cvt_pk_bf16(h1[2], h1[3]);
                        *(u32x4*)(xsr + off) = ws_; }
                }
                q += shx(q, fq * 16 + fr, 16); q += shx(q, fq * 16 + fr, 32);
                if (fq == 0) sspb[(unsigned)((ai * 128 + wr * 64 + m * 16 + fr) * 16)] = q;
            }
            asm volatile("" ::: "memory");
        }
    }
};

__device__ __forceinline__ s16x4 vtr(const LAS unsigned char* p) { return __builtin_bit_cast(s16x4, __builtin_amdgcn_ds_read_tr16_b64_v4i16((LAS v4i16_t*)p)); }

struct AUnit { int rowQ0, h, kh, qq0, nloc, jlo, kr_loc0, kr_ctx0; };
__device__ __forceinline__ AUnit aunit(int ua, int wave, int nlat) {
    AUnit D;
    if (ua < nlat) { const int b = ua >> 6, rem = ua & 63, qblk = rem >> 2, kh = (rem >> 1) & 1, hp = rem & 1;
        D.h = kh * 4 + hp * 2 + (wave >> 2); D.kh = kh; D.qq0 = (wave & 3) * 32; D.rowQ0 = b * SEQ + qblk * 128 + D.qq0;
        D.jlo = (qblk == 0) ? 2 : 0; D.nloc = ((qblk == 15) ? 4 : 6) - D.jlo; D.kr_loc0 = b * SEQ + qblk * 128 - 128; D.kr_ctx0 = TL + b * CTXL;
    } else { const int uc = ua - nlat, b = uc >> 3, h = uc & 7;
        D.h = h; D.kh = h >> 2; D.qq0 = 0; D.rowQ0 = TL + b * CTXL + wave * 32; D.jlo = 0; D.nloc = 0; D.kr_loc0 = 0; D.kr_ctx0 = TL + b * CTXL; }
    return D;
}
__device__ __forceinline__ void wait_vm_n(int n) {
    switch (n) {
        case 2: asm volatile("s_waitcnt vmcnt(2)" ::: "memory"); break;
        case 8: asm volatile("s_waitcnt vmcnt(8)" ::: "memory"); break;
        case 10: asm volatile("s_waitcnt vmcnt(10)" ::: "memory"); break;
        case 12: asm volatile("s_waitcnt vmcnt(12)" ::: "memory"); break;
        case 14: asm volatile("s_waitcnt vmcnt(14)" ::: "memory"); break;
        case 16: asm volatile("s_waitcnt vmcnt(16)" ::: "memory"); break;
        case 18: asm volatile("s_waitcnt vmcnt(18)" ::: "memory"); break;
        case 20: asm volatile("s_waitcnt vmcnt(20)" ::: "memory"); break;
        case 22: asm volatile("s_waitcnt vmcnt(22)" ::: "memory"); break;
        default: asm volatile("s_waitcnt vmcnt(0)" ::: "memory"); break;
    }
}
__device__ __forceinline__ void attn_phase2(LAS unsigned char* lds, int tid, const bf16_t* P, bf16_t* Oout, int opitch, int ocol, const float* sink, int bx, int G, int nlat, int ntot, int variant = 0) {
    const int lane = tid & 63, r32 = lane & 31, hi = lane >> 5;
    const int wid = __builtin_amdgcn_readfirstlane(tid >> 6);
    if (bx >= ntot) return;
    const size_t kofl = (size_t)lane * NCOL + C_K + wid * 8;
    const size_t vofl = (size_t)(16 * (wid & 3) + (lane >> 2)) * NCOL + C_V + (wid >> 2) * 32 + (lane & 3) * 8;
    int ua_c = bx, ua_s = bx;
    AUnit Dc = aunit(ua_c, wid, nlat), Ds = Dc, Dn = Dc;
    int ts = 0, NTs = Ds.nloc + 4, tc = 0, NTc = NTs, sslot = 0, cslot = 0;
    bf16x8 qr[4], qn[4]; u32x2 zb[8];
#pragma unroll
    for (int i = 0; i < 4; ++i) qn[i] = (bf16x8){0, 0, 0, 0, 0, 0, 0, 0};
#pragma unroll
    for (int i = 0; i < 8; ++i) zb[i] = (u32x2){0u, 0u};
    {   const bf16_t* qp = P + (size_t)(Dc.rowQ0 + r32) * NCOL + C_Q + Dc.h * 64 + hi * 8;
#pragma unroll
        for (int d0 = 0; d0 < 4; ++d0) qr[d0] = *(const bf16x8*)(qp + d0 * 16); }
    int nx = 0;
#define AT2_STAGE_NEXT() do { nx = 0; if (ua_s < ntot) { \
        if (ts == NTs - 1) {     \
            const bf16_t* zp_ = P + (size_t)(Ds.rowQ0 + r32) * NCOL + C_ZB + Ds.h * 64 + 4 * hi; \
            _Pragma("unroll") for (int i_ = 0; i_ < 8; ++i_) zb[i_] = *(const u32x2*)(zp_ + (i_ >> 2) * 32 + (i_ & 3) * 8); \
            nx += 8; \
            if (ua_s + G < ntot) { Dn = aunit(ua_s + G, wid, nlat); const bf16_t* qp_ = P + (size_t)(Dn.rowQ0 + r32) * NCOL + C_Q + Dn.h * 64 + hi * 8; \
                _Pragma("unroll") for (int d0_ = 0; d0_ < 4; ++d0_) qn[d0_] = *(const bf16x8*)(qp_ + d0_ * 16); nx += 4; } } \
        const int kr0_ = (ts < Ds.nloc) ? Ds.kr_loc0 + 64 * (Ds.jlo + ts) : Ds.kr_ctx0 + 64 * (ts - Ds.nloc); const bf16_t* tb_ = P + (size_t)kr0_ * NCOL + Ds.kh * 64; \
        if (variant != 2) { __builtin_amdgcn_global_load_lds((const unsigned*)(tb_ + kofl), (LAS unsigned*)(lds + sslot * 16384 + wid * 1024), 16, 0, 0); \
        __builtin_amdgcn_global_load_lds((const unsigned*)(tb_ + vofl), (LAS unsigned*)(lds + sslot * 16384 + 8192 + wid * 1024), 16, 0, 0); \
        nx += 2; } sslot = (sslot == 2) ? 0 : sslot + 1; ++ts; \
        if (ts == NTs) { ua_s += G; if (ua_s < ntot) { Ds = Dn; ts = 0; NTs = Ds.nloc + 4; } } } } while (0)
    AT2_STAGE_NEXT(); AT2_STAGE_NEXT();
    asm volatile("s_waitcnt vmcnt(2)" ::: "memory"); __builtin_amdgcn_s_barrier(); asm volatile("" ::: "memory");
    f32x16 o0, o1;
#pragma unroll
    for (int i = 0; i < 16; ++i) { o0[i] = 0.f; o1[i] = 0.f; }
    float mrun = sink[Dc.h] * LOG2E, lrun = hi ? 0.f : 1.f;
    int nst = 0;
    for (;;) {
        AT2_STAGE_NEXT();
        const bool local = tc < Dc.nloc; const int j = Dc.jlo + tc;
        const bool need = (variant != 1) && (!local || !((j == 0 && Dc.qq0 >= 64) || (j == 5 && Dc.qq0 < 64)));
        if (need) {
            const int qq = Dc.qq0 + r32;
            const LAS unsigned char* kb = lds + cslot * 16384 + hi * 1024 + r32 * 16;
            f32x16 p0, p1;
#pragma unroll
            for (int i = 0; i < 16; ++i) { p0[i] = 0.f; p1[i] = 0.f; }
#pragma unroll
            for (int d0 = 0; d0 < 4; ++d0) {
                const bf16x8 b0 = *(const LAS bf16x8*)(kb + d0 * 2048);
                const bf16x8 b1 = *(const LAS bf16x8*)(kb + d0 * 2048 + 512);
                p0 = __builtin_amdgcn_mfma_f32_32x32x16_bf16(b0, qr[d0], p0, 0, 0, 0);
                p1 = __builtin_amdgcn_mfma_f32_32x32x16_bf16(b1, qr[d0], p1, 0, 0, 0);
            }
            if (local) {
                if (j < 2) { const int lim = qq - 64 * j;
#pragma unroll
                    for (int i = 0; i < 16; ++i) { const int kk = (i & 3) + 8 * (i >> 2) + 4 * hi; if (kk < lim) p0[i] = -1e30f; if (kk + 32 < lim) p1[i] = -1e30f; }
                } else if (j >= 4) { const int lim = qq - 64 * (j - 4);
#pragma unroll
                    for (int i = 0; i < 16; ++i) { const int kk = (i & 3) + 8 * (i >> 2) + 4 * hi; if (kk > lim) p0[i] = -1e30f; if (kk + 32 > lim) p1[i] = -1e30f; }
                }
            }
            float rm = fmaxf(p0[0], p1[0]);
#pragma unroll
            for (int i = 1; i < 16; ++i) rm = fmaxf(rm, fmaxf(p0[i], p1[i]));
            rm = fmaxf(rm, shx(rm, lane, 32));
            const float mn = fmaxf(mrun, rm);
            if (__any(mn > mrun)) {
                const float f = __builtin_amdgcn_exp2f(mrun - mn);
                lrun *= f;
#pragma unroll
                for (int i = 0; i < 16; ++i) { o0[i] *= f; o1[i] *= f; }
                mrun = mn;
            }
            float ps = 0.f;
#pragma unroll
            for (int i = 0; i < 16; ++i) { p0[i] = __builtin_amdgcn_exp2f(p0[i] - mrun); p1[i] = __builtin_amdgcn_exp2f(p1[i] - mrun); ps += p0[i] + p1[i]; }
            lrun += ps;
            u32x4 pw[4];
#pragma unroll
            for (int w = 0; w < 4; ++w) { pw[0][w] = cvt_pk_bf16(p0[2 * w], p0[2 * w + 1]); pw[1][w] = cvt_pk_bf16(p0[8 + 2 * w], p0[8 + 2 * w + 1]);
                pw[2][w] = cvt_pk_bf16(p1[2 * w], p1[2 * w + 1]); pw[3][w] = cvt_pk_bf16(p1[8 + 2 * w], p1[8 + 2 * w + 1]); }
            const LAS unsigned char* vp = lds + cslot * 16384 + 8192 + ((lane >> 4) & 1) * 32 + (lane & 3) * 8 + (4 * hi + ((lane & 15) >> 2)) * 64;
#pragma unroll
            for (int s = 0; s < 4; ++s) {
                const s16x4 l0 = vtr(vp + s * 1024), h0 = vtr(vp + s * 1024 + 512);
                const s16x4 l1 = vtr(vp + 4096 + s * 1024), h1 = vtr(vp + 4096 + s * 1024 + 512);
                const bf16x8 v0 = (bf16x8){l0[0], l0[1], l0[2], l0[3], h0[0], h0[1], h0[2], h0[3]};
                const bf16x8 v1 = (bf16x8){l1[0], l1[1], l1[2], l1[3], h1[0], h1[1], h1[2], h1[3]};
                const bf16x8 pa = __builtin_bit_cast(bf16x8, pw[s]);
                o0 = __builtin_amdgcn_mfma_f32_32x32x16_bf16(v0, pa, o0, 0, 0, 0);
                o1 = __builtin_amdgcn_mfma_f32_32x32x16_bf16(v1, pa, o1, 0, 0, 0);
            }
        }
        wait_vm_n(nx + nst); nst = 0;
        asm volatile("s_waitcnt lgkmcnt(0)" ::: "memory"); __builtin_amdgcn_s_barrier(); asm volatile("" ::: "memory");
        cslot = (cslot == 2) ? 0 : cslot + 1; ++tc;
        if (tc == NTc) {
            lrun += shx(lrun, lane, 32);
            const float inv = 1.0f / lrun;
            bf16_t* oo = Oout + (size_t)(Dc.rowQ0 + r32) * opitch + ocol + Dc.h * 64 + 4 * hi;
#pragma unroll
            for (int d0 = 0; d0 < 2; ++d0)
#pragma unroll
                for (int gq = 0; gq < 4; ++gq) {
                    const u32x2 z = zb[d0 * 4 + gq];
                    const float a0 = (d0 ? o1[4 * gq + 0] : o0[4 * gq + 0]) * inv * siluf_(bf_lo(z.x));
                    const float a1 = (d0 ? o1[4 * gq + 1] : o0[4 * gq + 1]) * inv * siluf_(bf_hi(z.x));
                    const float a2 = (d0 ? o1[4 * gq + 2] : o0[4 * gq + 2]) * inv * siluf_(bf_lo(z.y));
                    const float a3 = (d0 ? o1[4 * gq + 3] : o0[4 * gq + 3]) * inv * siluf_(bf_hi(z.y));
                    u32x2 w; w.x = cvt_pk_bf16(a0, a1); w.y = cvt_pk_bf16(a2, a3);
                    *(u32x2*)(oo + d0 * 32 + gq * 8) = w;
                }
            nst = 8;
            ua_c += G; if (ua_c >= ntot) break;
            Dc = aunit(ua_c, wid, nlat); tc = 0; NTc = Dc.nloc + 4;
#pragma unroll
            for (int d0 = 0; d0 < 4; ++d0) qr[d0] = qn[d0];
#pragma unroll
            for (int i = 0; i < 16; ++i) { o0[i] = 0.f; o1[i] = 0.f; }
            mrun = sink[Dc.h] * LOG2E; lrun = hi ? 0.f : 1.f;
        }
    }
#undef AT2_STAGE_NEXT
    asm volatile("s_waitcnt vmcnt(0) lgkmcnt(0)" ::: "memory"); __builtin_amdgcn_s_barrier(); asm volatile("" ::: "memory");
}

namespace at3 {
constexpr int NSLOT = 3, SLOTB = 8192;
constexpr int LDS_K = 0, LDS_V = NSLOT * SLOTB, LDS_WS = 2 * NSLOT * SLOTB, LDS_OST = LDS_WS + 8 * 64 * 4, LDS_TOTAL = LDS_OST + 8 * 4096;
__device__ __forceinline__ int crow(int r, int hi) { return (r & 3) + 8 * (r >> 2) + 4 * hi; }
#define SBAR() __builtin_amdgcn_sched_barrier(0)
__device__ __forceinline__ void glds16(const void* sbase, unsigned voff, unsigned lds_dst) { unsigned keep;
    asm volatile("s_mov_b32 %0, m0\n\ts_mov_b32 m0, %3\n\ts_nop 4\n\tglobal_load_lds_dwordx4 %1, %2\n\ts_mov_b32 m0, %0" : "=&s"(keep) : "v"(voff), "s"(sbase), "s"(lds_dst) : "memory"); }
__device__ __forceinline__ float max3f(float a, float b, float c) { float r; asm("v_max3_f32 %0, %1, %2, %3" : "=v"(r) : "v"(a), "v"(b), "v"(c)); return r; }
__device__ __forceinline__ float max2f(float a, float b) { float r; asm("v_max_f32_e32 %0, %1, %2" : "=v"(r) : "v"(a), "v"(b)); return r; }
__device__ __forceinline__ float fadd_s(float a, float b) { float r; asm("v_add_f32_e32 %0, %1, %2" : "=v"(r) : "v"(a), "v"(b)); return r; }
__device__ __forceinline__ float fsub_s(float a, float b) { float r; asm("v_sub_f32_e32 %0, %1, %2" : "=v"(r) : "v"(a), "v"(b)); return r; }
typedef float f32x2_t __attribute__((ext_vector_type(2))); typedef __bf16 bf16x2_t __attribute__((ext_vector_type(2)));
__device__ __forceinline__ unsigned cvtpk_s(float lo, float hi) { f32x2_t v = {lo, hi}; bf16x2_t b = __builtin_convertvector(v, bf16x2_t); return __builtin_bit_cast(unsigned, b); }
#define WAIT_BAR(N) asm volatile("s_waitcnt vmcnt(" #N ") lgkmcnt(0)\n\ts_barrier" ::: "memory")
typedef const LAS char* lds_cptr;
__device__ __forceinline__ void qkt(f32x16& p0, f32x16& p1, lds_cptr Kslot, const bf16x8* qr, int r32, int hi) {
    const f32x16 negm = f32x16{};
    lds_cptr kb = Kslot + hi * 1024 + r32 * 16;
#pragma unroll
    for (int d0 = 0; d0 < 4; ++d0) {
        const bf16x8 b0 = *(const LAS bf16x8*)(kb + d0 * 2048);
        const bf16x8 b1 = *(const LAS bf16x8*)(kb + d0 * 2048 + 512);
        if (d0 == 0) { p0 = __builtin_amdgcn_mfma_f32_32x32x16_bf16(b0, qr[0], negm, 0, 0, 0); p1 = __builtin_amdgcn_mfma_f32_32x32x16_bf16(b1, qr[0], negm, 0, 0, 0); }
        else { p0 = __builtin_amdgcn_mfma_f32_32x32x16_bf16(b0, qr[d0], p0, 0, 0, 0); p1 = __builtin_amdgcn_mfma_f32_32x32x16_bf16(b1, qr[d0], p1, 0, 0, 0); } }
}
__device__ __forceinline__ void kload8(bf16x8* kf, lds_cptr kp) {
    kf[0] = *(const LAS bf16x8*)(kp);        kf[1] = *(const LAS bf16x8*)(kp + 512);
    kf[2] = *(const LAS bf16x8*)(kp + 2048); kf[3] = *(const LAS bf16x8*)(kp + 2560);
    kf[4] = *(const LAS bf16x8*)(kp + 4096); kf[5] = *(const LAS bf16x8*)(kp + 4608);
    kf[6] = *(const LAS bf16x8*)(kp + 6144); kf[7] = *(const LAS bf16x8*)(kp + 6656);
}
__device__ __forceinline__ void kload2(bf16x8* kf, lds_cptr kp, int j) { kf[2 * j] = *(const LAS bf16x8*)(kp + j * 2048); kf[2 * j + 1] = *(const LAS bf16x8*)(kp + j * 2048 + 512); }
__device__ __forceinline__ s16x4 vtr3(lds_cptr p) { return __builtin_bit_cast(s16x4, __builtin_amdgcn_ds_read_tr16_b64_v4i16((LAS v4i16_t*)p)); }
__device__ __forceinline__ float rowmax(const f32x16& p0, const f32x16& p1) {
    float a = max3f(p0[0], p0[1], p1[0]), b = max3f(p0[2], p0[3], p1[1]); a = max3f(a, p1[2], p1[3]);
#pragma unroll
    for (int r = 4; r < 16; r += 4) { a = max3f(a, p0[r], p0[r + 1]); b = max3f(b, p0[r + 2], p0[r + 3]); a = max3f(a, p1[r], p1[r + 1]); b = max3f(b, p1[r + 2], p1[r + 3]); }
    const float m = max2f(a, b);
    auto rr = __builtin_amdgcn_permlane32_swap(__float_as_uint(m), __float_as_uint(m), false, false);
    return max2f(__uint_as_float(rr[0]), __uint_as_float(rr[1]));
}
__device__ __forceinline__ void pv(f32x16* o, int vb, bf16x8 pa0, bf16x8 pa1, bf16x8 pa2, bf16x8 pa3) {
#pragma unroll
    for (int d0 = 0; d0 < 2; ++d0) { s16x4 lo[4], hi[4];
#pragma unroll
        for (int ks = 0; ks < 4; ++ks) {
            asm volatile("ds_read_b64_tr_b16 %0,%1 offset:%c2" : "=&v"(lo[ks]) : "v"(vb), "i"(d0 * 4096 + ks * 1024) : "memory");
            asm volatile("ds_read_b64_tr_b16 %0,%1 offset:%c2" : "=&v"(hi[ks]) : "v"(vb), "i"(d0 * 4096 + ks * 1024 + 512) : "memory"); }
        asm volatile("s_waitcnt lgkmcnt(0)" ::: "memory"); SBAR();
#define PK(k) (bf16x8){lo[k][0], lo[k][1], lo[k][2], lo[k][3], hi[k][0], hi[k][1], hi[k][2], hi[k][3]}
        o[d0] = __builtin_amdgcn_mfma_f32_32x32x16_bf16(pa0, PK(0), o[d0], 0, 0, 0);
        o[d0] = __builtin_amdgcn_mfma_f32_32x32x16_bf16(pa1, PK(1), o[d0], 0, 0, 0);
        o[d0] = __builtin_amdgcn_mfma_f32_32x32x16_bf16(pa2, PK(2), o[d0], 0, 0, 0);
        o[d0] = __builtin_amdgcn_mfma_f32_32x32x16_bf16(pa3, PK(3), o[d0], 0, 0, 0);
#undef PK
    }
}
__device__ __forceinline__ void wmask(f32x16& p0, f32x16& p1, int j, int qq, int hi) {
    const float NEG = -INFINITY;
    if (j < 2) { const int lim = qq - 64 * j;
#pragma unroll
        for (int r = 0; r < 16; ++r) { const int kk = (r & 3) + 8 * (r >> 2) + 4 * hi; if (kk < lim) p0[r] = NEG; if (kk + 32 < lim) p1[r] = NEG; }
    } else if (j >= 4) { const int lim = qq - 64 * (j - 4);
#pragma unroll
        for (int r = 0; r < 16; ++r) { const int kk = (r & 3) + 8 * (r >> 2) + 4 * hi; if (kk > lim) p0[r] = NEG; if (kk + 32 > lim) p1[r] = NEG; }
    }
}
template <int THRL> __device__ __forceinline__ void attn_unit(int tid_in, LAS unsigned char* shm3u, const bf16_t* P, bf16_t* Oout, int opitch, int ocol, int rowQ0, int h, int kh, int qq0, int nloc, int jlo, int kr_loc0, int kr_ctx0, float sink_l2) {
    int tid = tid_in; asm volatile("" : "+v"(tid));
    const int lane = tid & 63, r32 = lane & 31, hi = lane >> 5; const int wid = __builtin_amdgcn_readfirstlane(tid >> 6);
    const lds_cptr shm3 = (lds_cptr)shm3u;
    const unsigned lds0 = (unsigned)(uintptr_t)shm3u;
    LAS float* wsf = (LAS float*)(shm3u + LDS_WS) + wid * 64;
    const bf16_t* Qw = P + (size_t)rowQ0 * NCOL + C_Q + h * 64;
    const unsigned koffb = (unsigned)(lane * NCOL + C_K + kh * 64 + wid * 8) * 2u;
    const unsigned voffb = (unsigned)((16 * (wid & 3) + (lane >> 2)) * NCOL + C_V + kh * 64 + (wid >> 2) * 32 + (lane & 3) * 8) * 2u;
    const unsigned kdst = lds0 + LDS_K + wid * 1024, vdst = lds0 + LDS_V + wid * 1024;
#define KROW(t) (((t) < nloc) ? kr_loc0 + 64 * (jlo + (t)) : kr_ctx0 + 64 * ((t) - nloc))
#define DMA_K(t, slot) glds16(P + (size_t)KROW(t) * NCOL, koffb, (unsigned)__builtin_amdgcn_readfirstlane(kdst + (slot)))
#define DMA_V(t, slot) glds16(P + (size_t)KROW(t) * NCOL, voffb, (unsigned)__builtin_amdgcn_readfirstlane(vdst + (slot)))
    bf16x8 kf[8];
    const lds_cptr kp0 = shm3 + LDS_K + hi * 1024 + r32 * 16; const lds_cptr vp0 = shm3 + LDS_V + ((lane >> 4) & 1) * 32 + (lane & 3) * 8 + (4 * hi + ((lane & 15) >> 2)) * 64;
    const int NT = nloc + 4;
    DMA_K(0, 0); DMA_V(0, 0); DMA_K(1, SLOTB);
    bf16x8 qr[4];
#pragma unroll
    for (int d0 = 0; d0 < 4; ++d0) qr[d0] = *reinterpret_cast<const bf16x8*>(&Qw[(size_t)r32 * NCOL + d0 * 16 + hi * 8]);
    const lds_cptr qls = shm3 + LDS_OST + wid * 4096 + lane * 16;
#pragma unroll
    for (int d0 = 0; d0 < 4; ++d0) *(LAS bf16x8*)(shm3u + LDS_OST + wid * 4096 + lane * 16 + d0 * 1024) = qr[d0];
#define QLD(d) (*(const LAS bf16x8*)(qls + (d) * 1024))
    float mhat = 0.f, l_reg = 0.f; f32x16 o[2]; o[0] = f32x16{}; o[1] = f32x16{};
    const int qrel = qq0 + r32;
#define CMASK(P0, P1, t) do { if ((t) < nloc) wmask(P0, P1, jlo + (t), qrel, hi); } while (0)
    bool resc = false;
#define START(P0, P1) do { const float rm = max2f(rowmax(P0, P1), sink_l2); resc = false; \
    { const float dl = rm; mhat = fadd_s(mhat, dl); \
      _Pragma("unroll") for (int r = 0; r < 16; ++r) { P0[r] = fsub_s(P0[r], dl); P1[r] = fsub_s(P1[r], dl); } } \
    l_reg = hi ? 0.f : __builtin_amdgcn_exp2f(sink_l2 - mhat); \
    _Pragma("unroll") for (int r = 0; r < 16; ++r) P0[r] = __builtin_amdgcn_exp2f(P0[r]); } while (0)
#define RESC() do { if (resc) { asm volatile("s_waitcnt lgkmcnt(0)" ::: "memory"); \
      _Pragma("unroll") for (int r = 0; r < 16; ++r) { const float f_ = wsf[crow(r, hi)]; o[0][r] *= f_; o[1][r] *= f_; if ((r & 3) == 3) asm volatile("" ::: "memory"); } } } while (0)
    f32x16 pA0, pA1, pB0, pB1;
    int sl_prev = 0, sl_cur = 0, sl_next = SLOTB;
#define ROT() do { sl_prev = sl_cur; sl_cur = sl_next; sl_next = (sl_next == (NSLOT - 1) * SLOTB) ? 0 : sl_next + SLOTB; } while (0)
    DMA_K(2, 2 * SLOTB);
    WAIT_BAR(3);
    qkt(pA0, pA1, shm3 + LDS_K, qr, r32, hi); asm volatile("s_nop 15\n\ts_nop 7" : "+v"(pA0), "+v"(pA1)); CMASK(pA0, pA1, 0);
    START(pA0, pA1);
    _Pragma("unroll") for (int r = 0; r < 16; ++r) pA1[r] = __builtin_amdgcn_exp2f(pA1[r]);
    WAIT_BAR(0);
    DMA_K(3, 0); DMA_V(1, SLOTB);
    ROT();
    kload8(kf, kp0 + sl_cur);
    WAIT_BAR(2);
    s16x4 vlo[8], vhi[8]; u32x4 pw0, pw1, pw2, pw3;
#define PKW(P, B) cvtpk_s(P[B], P[B + 1])
#define PAF(k) __builtin_bit_cast(bf16x8, pw##k)
#define VFR(i) (bf16x8){vlo[i][0], vlo[i][1], vlo[i][2], vlo[i][3], vhi[i][0], vhi[i][1], vhi[i][2], vhi[i][3]}
#define PIN(x) asm volatile("" : "+v"(x))
#define MX3(a, b, c) __builtin_fmaxf(__builtin_fmaxf((a), (b)), (c))
#define GAPA(MF, A0, A1, A2, A3, W0, W1, PW) do { MF; sacc += A0; sacc += A1; sacc += A2; sacc += A3; PIN(sacc); W0; W1; PIN(PW); SBAR(); } while (0)
#define EX(v) __builtin_amdgcn_exp2f(v)
#define GAPB(MF, X, B) do { MF; X[B] = EX(X[B] - mhat); X[B + 1] = EX(X[B + 1] - mhat); X[B + 2] = EX(X[B + 2] - mhat); X[B + 3] = EX(X[B + 3] - mhat); PIN(X); SBAR(); } while (0)
#define VRD(i) do { vlo[i] = vtr3(vp_ + (((i) >> 2) * 4096 + ((i) & 3) * 1024)); vhi[i] = vtr3(vp_ + (((i) >> 2) * 4096 + ((i) & 3) * 1024 + 512)); } while (0)
#define KRD(G, j) do { if (G) { kload2(kf, kp0 + sl_next, j); SBAR(); } } while (0)
#define STEP(C0, C1, P0, P1, t, GK, GV, GL) do { SBAR(); \
    const lds_cptr vp_ = vp0 + sl_prev; const f32x16 zero16 = f32x16{}; \
    const bf16x8 qd0 = QLD(0), qd1 = QLD(1); VRD(0); SBAR(); float sacc = (P0[0] + P0[1]); \
    GAPA(C0 = __builtin_amdgcn_mfma_f32_32x32x16_bf16(kf[0], qd0, zero16, 0, 0, 0), P0[2], P0[3], P0[4], P0[5],     pw0[0] = PKW(P0, 0), pw0[1] = PKW(P0, 2), pw0); \
    VRD(4); SBAR(); GAPA(C1 = __builtin_amdgcn_mfma_f32_32x32x16_bf16(kf[1], qd0, zero16, 0, 0, 0), P0[6], P0[7], P0[8], P0[9],     pw0[2] = PKW(P0, 4), pw0[3] = PKW(P0, 6), pw0); \
    const bf16x8 qd2 = QLD(2), qd3 = QLD(3); VRD(1); SBAR(); GAPA(C0 = __builtin_amdgcn_mfma_f32_32x32x16_bf16(kf[2], qd1, C0, 0, 0, 0),   P0[10], P0[11], P0[12], P0[13], pw1[0] = PKW(P0, 8), pw1[1] = PKW(P0, 10), pw1); \
    VRD(5); SBAR(); GAPA(C1 = __builtin_amdgcn_mfma_f32_32x32x16_bf16(kf[3], qd1, C1, 0, 0, 0),   P0[14], P0[15], P1[0], P1[1],   pw1[2] = PKW(P0, 12), pw1[3] = PKW(P0, 14), pw1); \
    VRD(2); SBAR(); GAPA(C0 = __builtin_amdgcn_mfma_f32_32x32x16_bf16(kf[4], qd2, C0, 0, 0, 0),   P1[2], P1[3], P1[4], P1[5],     pw2[0] = PKW(P1, 0), pw2[1] = PKW(P1, 2), pw2); \
    VRD(6); SBAR(); GAPA(C1 = __builtin_amdgcn_mfma_f32_32x32x16_bf16(kf[5], qd2, C1, 0, 0, 0),   P1[6], P1[7], P1[8], P1[9],     pw2[2] = PKW(P1, 4), pw2[3] = PKW(P1, 6), pw2); \
    VRD(3); SBAR(); GAPA(C0 = __builtin_amdgcn_mfma_f32_32x32x16_bf16(kf[6], qd3, C0, 0, 0, 0),   P1[10], P1[11], P1[12], P1[13], pw3[0] = PKW(P1, 8), pw3[1] = PKW(P1, 10), pw3); \
    VRD(7); SBAR(); GAPA(C1 = __builtin_amdgcn_mfma_f32_32x32x16_bf16(kf[7], qd3, C1, 0, 0, 0),   P1[14], P1[15], 0.f, 0.f,       pw3[2] = PKW(P1, 12), pw3[3] = PKW(P1, 14), pw3); \
    l_reg += sacc; \
    if (GK) { DMA_K((t) + 3, sl_cur); } if (GV) { DMA_V((t) + 1, sl_next); } \
    CMASK(C0, C1, t); \
    { float a = MX3(C0[0], C0[1], C1[0]), b = MX3(C0[2], C0[3], C1[1]); a = MX3(a, C1[2], C1[3]); \
      _Pragma("unroll") for (int r = 4; r < 16; r += 4) { a = MX3(a, C0[r], C0[r + 1]); b = MX3(b, C0[r + 2], C0[r + 3]); a = MX3(a, C1[r], C1[r + 1]); b = MX3(b, C1[r + 2], C1[r + 3]); } \
      float rm = __builtin_fmaxf(a, b); { auto rr = __builtin_amdgcn_permlane32_swap(__float_as_uint(rm), __float_as_uint(rm), false, false); rm = __builtin_fmaxf(__uint_as_float(rr[0]), __uint_as_float(rr[1])); } \
      resc = false; rm -= mhat; \
      if (__builtin_expect(__any(rm > (float)THRL), 0)) { const float dl = __builtin_fmaxf(rm, 0.f); mhat += dl; \
        const float f = __builtin_amdgcn_exp2f(-dl); l_reg *= f; if (hi == 0) wsf[r32] = f; resc = true; } } \
    SBAR(); \
    GAPB(o[0] = __builtin_amdgcn_mfma_f32_32x32x16_bf16(PAF(0), VFR(0), o[0], 0, 0, 0), C0, 0); \
    GAPB(o[1] = __builtin_amdgcn_mfma_f32_32x32x16_bf16(PAF(0), VFR(4), o[1], 0, 0, 0), C0, 4); \
    KRD(GL, 0); GAPB(o[0] = __builtin_amdgcn_mfma_f32_32x32x16_bf16(PAF(1), VFR(1), o[0], 0, 0, 0), C0, 8); \
    KRD(GL, 1); GAPB(o[1] = __builtin_amdgcn_mfma_f32_32x32x16_bf16(PAF(1), VFR(5), o[1], 0, 0, 0), C0, 12); \
    KRD(GL, 2); GAPB(o[0] = __builtin_amdgcn_mfma_f32_32x32x16_bf16(PAF(2), VFR(2), o[0], 0, 0, 0), C1, 0); \
    KRD(GL, 3); GAPB(o[1] = __builtin_amdgcn_mfma_f32_32x32x16_bf16(PAF(2), VFR(6), o[1], 0, 0, 0), C1, 4); \
    GAPB(o[0] = __builtin_amdgcn_mfma_f32_32x32x16_bf16(PAF(3), VFR(3), o[0], 0, 0, 0), C1, 8); \
    GAPB(o[1] = __builtin_amdgcn_mfma_f32_32x32x16_bf16(PAF(3), VFR(7), o[1], 0, 0, 0), C1, 12); \
    } while (0)
    int t = 1;
#define ENDW(tt) do { if ((tt) + 3 < NT) { WAIT_BAR(2); } else if ((tt) + 2 < NT) { WAIT_BAR(1); } else { WAIT_BAR(0); } } while (0)
    for (; t + 1 < NT; t += 2) {
        STEP(pB0, pB1, pA0, pA1, t, (t + 3 < NT), (t + 1 < NT), (t + 1 < NT));       ENDW(t);     RESC(); ROT();
        STEP(pA0, pA1, pB0, pB1, t + 1, (t + 4 < NT), (t + 2 < NT), (t + 2 < NT));   ENDW(t + 1); RESC(); ROT();
    }
    STEP(pB0, pB1, pA0, pA1, NT - 1, false, false, false); RESC();
    { float sacc = pB0[0] + pB0[1]; _Pragma("unroll") for (int r = 2; r < 16; ++r) sacc += pB0[r]; _Pragma("unroll") for (int r = 0; r < 16; ++r) sacc += pB1[r]; l_reg += sacc;
      pw0 = (u32x4){PKW(pB0, 0), PKW(pB0, 2), PKW(pB0, 4), PKW(pB0, 6)}; pw1 = (u32x4){PKW(pB0, 8), PKW(pB0, 10), PKW(pB0, 12), PKW(pB0, 14)}; pw2 = (u32x4){PKW(pB1, 0), PKW(pB1, 2), PKW(pB1, 4), PKW(pB1, 6)}; pw3 = (u32x4){PKW(pB1, 8), PKW(pB1, 10), PKW(pB1, 12), PKW(pB1, 14)};
      SBAR(); int ln2 = lane_id_(); asm volatile("" : "+v"(ln2)); const int hi2 = ln2 >> 5;
      const int vb0 = (int)(lds0 + LDS_V) + ((ln2 >> 4) & 1) * 32 + (ln2 & 3) * 8 + (4 * hi2 + ((ln2 & 15) >> 2)) * 64;
      pv(o, vb0 + sl_cur, PAF(0), PAF(1), PAF(2), PAF(3)); }
#undef PKW
#undef PAF
#undef VFR
#undef PIN
#undef MX3
#undef GAPA
#undef GAPB
#undef EX
#undef VRD
#undef KRD
#undef STEP
#undef ENDW
    { auto rr = __builtin_amdgcn_permlane32_swap(__float_as_uint(l_reg), __float_as_uint(l_reg), false, false); l_reg = __uint_as_float(rr[0]) + __uint_as_float(rr[1]); }
    int lane_e = lane_id_(); asm volatile("" : "+v"(lane_e));
    const int r32_e = lane_e & 31, hi_e = lane_e >> 5;
    if (hi_e == 0) wsf[32 + r32_e] = l_reg; asm volatile("s_waitcnt lgkmcnt(0)" ::: "memory");
    float rli[16];
#pragma unroll
    for (int r = 0; r < 16; ++r) rli[r] = __builtin_amdgcn_rcpf(wsf[32 + crow(r, hi_e)]);
    {   LAS bf16_t* stg = (LAS bf16_t*)(shm3u + LDS_OST) + wid * 2048;
        u32x4 zv[4];
        const bf16_t* zrow = P + (size_t)rowQ0 * NCOL + C_ZB + h * 64;
#pragma unroll
        for (int i = 0; i < 4; ++i) { const int row = i * 8 + (lane_e >> 3), ch = lane_e & 7; zv[i] = *(const u32x4*)(zrow + (size_t)row * NCOL + ch * 8); }
#pragma unroll
        for (int r = 0; r < 16; ++r) { const int orow = crow(r, hi_e);
#pragma unroll
            for (int d0 = 0; d0 < 2; ++d0) { const unsigned short b = (unsigned short)(cvtpk_s(o[d0][r] * rli[r], 0.f) & 0xffffu); stg[orow * 64 + d0 * 32 + r32_e] = b; } }
        asm volatile("s_waitcnt lgkmcnt(0)" ::: "memory");
        bf16_t* orow_p = Oout + (size_t)rowQ0 * opitch + ocol + h * 64;
#pragma unroll
        for (int i = 0; i < 4; ++i) { const int row = i * 8 + (lane_e >> 3), ch = lane_e & 7; const u32x4 v = *(const LAS u32x4*)(stg + row * 64 + ch * 8);
            u32x4 w;
#pragma unroll
            for (int e = 0; e < 4; ++e) { w[e] = cvt_pk_bf16(bf_lo(v[e]) * siluf_(bf_lo(zv[i][e])), bf_hi(v[e]) * siluf_(bf_hi(zv[i][e]))); }
            *(u32x4*)(orow_p + (size_t)row * opitch + ch * 8) = w; } }
    asm volatile("s_waitcnt lgkmcnt(0)\n\ts_barrier" ::: "memory");
#undef DMA_K
#undef DMA_V
#undef KROW
#undef CMASK
#undef START
#undef RESC
#undef ROT
#undef QLD
}
#undef SBAR
#undef WAIT_BAR
}

__device__ __forceinline__ void conv_run8(const bf16_t* P, bf16_t* Yout, int ypitch, int ycol, const float* cw, int run, int lane) {
    const int row0 = run * 8;
    int s0, s1; if (row0 < TL) { s0 = row0 & ~2047; s1 = s0 + 2048; } else { s0 = TL + ((row0 - TL) & ~255); s1 = s0 + 256; }
    const int c0 = lane * 8;
    const bf16_t* base = P + (size_t)row0 * NCOL + c0;
    u32x4 rc[10], rb[8];
    const u32x4 z4u = (u32x4){0u, 0u, 0u, 0u};
    rc[0] = z4u; rc[9] = z4u;
    if (row0 - 1 >= s0) rc[0] = *(const u32x4*)(base - NCOL + C_CU);
#pragma unroll
    for (int i = 0; i < 8; ++i) { rc[i + 1] = *(const u32x4*)(base + (size_t)i * NCOL + C_CU); rb[i] = *(const u32x4*)(base + (size_t)i * NCOL + C_BZ); }
    if (row0 + 8 < s1) rc[9] = *(const u32x4*)(base + (size_t)8 * NCOL + C_CU);
    const f32x4 w0a = *(const f32x4*)(cw + c0), w0b = *(const f32x4*)(cw + c0 + 4);
    const f32x4 w1a = *(const f32x4*)(cw + 512 + c0), w1b = *(const f32x4*)(cw + 512 + c0 + 4);
    const f32x4 w2a = *(const f32x4*)(cw + 1024 + c0), w2b = *(const f32x4*)(cw + 1024 + c0 + 4);
#define CV_A(q_) ((f32x4){bf_lo((q_)[0]), bf_hi((q_)[0]), bf_lo((q_)[1]), bf_hi((q_)[1])})
#define CV_B(q_) ((f32x4){bf_lo((q_)[2]), bf_hi((q_)[2]), bf_lo((q_)[3]), bf_hi((q_)[3])})
    f32x4 pa = CV_A(rc[0]), pb = CV_B(rc[0]), ca = CV_A(rc[1]), cb = CV_B(rc[1]);
#pragma unroll
    for (int i = 0; i < 8; ++i) {
        const f32x4 na = CV_A(rc[i + 2]), nb = CV_B(rc[i + 2]);
        const f32x4 ya = CV_A(rb[i]) * (w0a * pa + w1a * ca + w2a * na), yb = CV_B(rb[i]) * (w0b * pb + w1b * cb + w2b * nb);
        u32x4 w; w.x = cvt_pk_bf16(ya[0], ya[1]); w.y = cvt_pk_bf16(ya[2], ya[3]); w.z = cvt_pk_bf16(yb[0], yb[1]); w.w = cvt_pk_bf16(yb[2], yb[3]);
        *(u32x4*)(Yout + (size_t)(row0 + i) * ypitch + ycol + c0) = w;
        pa = ca; pb = cb; ca = na; cb = nb;
    }
#undef CV_A
#undef CV_B
}

__device__ __forceinline__ void transpose_item(const float* W, int ldw, bf16_t* WT, int ldo, int koff, int nblk, LAS float* scr, int item, int lane, bool perm = false) {
    const int kb = item / nblk, nb = item % nblk, k0 = 64 * kb, n0 = 32 * nb, n0s = perm ? orig_col(n0) : n0;
#pragma unroll 8
    for (int i = 0; i < 32; ++i) { const int kk = 2 * i + (lane >> 5); scr[kk * 33 + (lane & 31)] = W[(size_t)(k0 + kk) * ldw + n0s + (lane & 31)]; }
    LDS_WAIT(); asm volatile("" ::: "memory");
    const int c = lane & 7;
#pragma unroll
    for (int j = 0; j < 4; ++j) { const int n = (lane >> 3) + 8 * j; const LAS float* s = scr + (8 * c) * 33 + n;
        u32x4 o; o.x = cvt_pk_bf16(s[0 * 33], s[1 * 33]); o.y = cvt_pk_bf16(s[2 * 33], s[3 * 33]); o.z = cvt_pk_bf16(s[4 * 33], s[5 * 33]); o.w = cvt_pk_bf16(s[6 * 33], s[7 * 33]);
        *(u32x4*)(WT + (size_t)(n0 + n) * ldo + koff + k0 + 8 * c) = o; }
    LDS_WAIT(); asm volatile("" ::: "memory");
}

__device__ __forceinline__ void rowmat17_item(int tid, LAS unsigned char* lds, const float* W, int ldw, int col0, const float* bias, float* out, int ldo, int scol0 = -1) {
    if (scol0 < 0) scol0 = col0;
    const int lane = tid & 63, wid = tid >> 6;
    const LAS float* tab = (const LAS float*)lds;
    LAS float* part = (LAS float*)(lds + 17 * 1024 * 4);
    float acc[17];
#pragma unroll
    for (int r = 0; r < 17; ++r) acc[r] = 0.f;
    const float* wp = W + (size_t)(wid * 128) * ldw + scol0 + lane;
    for (int k = 0; k < 128; k += 16) {
        float wv[16];
#pragma unroll
        for (int i = 0; i < 16; ++i) wv[i] = wp[(size_t)(k + i) * ldw];
#pragma unroll
        for (int q = 0; q < 4; ++q)
#pragma unroll
            for (int r = 0; r < 17; ++r) { const f32x4 t = *(const LAS f32x4*)(tab + r * 1024 + wid * 128 + k + 4 * q); acc[r] += (t[0] * wv[4 * q] + t[1] * wv[4 * q + 1]) + (t[2] * wv[4 * q + 2] + t[3] * wv[4 * q + 3]); }
    }
#pragma unroll
    for (int r = 0; r < 17; ++r) part[(wid * 17 + r) * 64 + lane] = acc[r];
    __syncthreads();
    for (int idx = tid; idx < 17 * 64; idx += 512) { const int r = idx >> 6, e = idx & 63; float s = 0.f;
#pragma unroll
        for (int w = 0; w < 8; ++w) s += part[(w * 17 + r) * 64 + e];
        if (bias) s += bias[col0 + e];
        out[(size_t)r * ldo + col0 + e] = s; }
    __syncthreads();
}


#define XB_TMO      128
#define XB_XCNT(j)  (256  + 64 * (j))
#define XB_XSUB(j)  (1280 + 64 * (j))
#define XB_XGEN(j)  (2304 + 64 * (j))
#define XB_TOP      3328
#define XB_TOPGEN   3392
#define XCD_BAR_WORDS 3456
#define XB_SPIN_CAP (1u << 18)
__device__ __forceinline__ unsigned xb_ld(unsigned* p)              { return __hip_atomic_load(p, __ATOMIC_RELAXED, __HIP_MEMORY_SCOPE_AGENT); }
__device__ __forceinline__ unsigned xb_add(unsigned* p, unsigned v) { return __hip_atomic_fetch_add(p, v, __ATOMIC_RELAXED, __HIP_MEMORY_SCOPE_AGENT); }
__device__ __forceinline__ unsigned xb_xcc_id() { return (unsigned)__builtin_amdgcn_s_getreg((3 << 11) | 20) & 0xFu; }
#define XB_SPIN(cond, bar) do { unsigned _sp = 0; while (cond) { __builtin_amdgcn_s_sleep(1); \
    if ((++_sp & 255u) == 0u) { if (xb_ld(&(bar)[XB_TMO])) break; if (_sp > XB_SPIN_CAP) { atomicAdd(&(bar)[XB_TMO], 1u); break; } } } } while (0)
struct XcdBarrier { unsigned* bar; unsigned x; volatile LAS unsigned* st; };
__device__ __forceinline__ XcdBarrier xcd_barrier_post(unsigned* bar, volatile LAS unsigned* st, int tid) {
    XcdBarrier b; b.bar = bar; b.x = xb_xcc_id(); b.st = st;
    if (tid == 0) (void)xb_add(&bar[XB_XCNT(b.x)], 1u);
    return b;
}
__device__ __forceinline__ void xcd_barrier_complete(unsigned* bar, unsigned x, unsigned& nloc, unsigned& nx) {
    const unsigned G = gridDim.x * gridDim.y * gridDim.z;
    unsigned sum, cnt, mine, sp = 0u;
    for (;;) {
        sum = 0u; cnt = 0u; mine = 0u;
#pragma unroll
        for (unsigned j = 0; j < 16; ++j) { const unsigned c = xb_ld(&bar[XB_XCNT(j)]); sum += c; cnt += (c > 0u) ? 1u : 0u; mine = (j == x) ? c : mine; }
        if (sum == G) break;
        __builtin_amdgcn_s_sleep(1);
        if ((++sp & 255u) == 0u) { if (xb_ld(&bar[XB_TMO])) break; if (sp > XB_SPIN_CAP) { atomicAdd(&bar[XB_TMO], 1u); break; } }
    }
    nloc = mine > 0u ? mine : 1u; nx = cnt > 0u ? cnt : 1u;
}
__device__ __forceinline__ void xcd_barrier(const XcdBarrier& b, int tid) {
    asm volatile("s_waitcnt vmcnt(0)" ::: "memory");
    __syncthreads();
    if (tid == 0) {
        unsigned* bar = b.bar;
        __builtin_amdgcn_s_waitcnt(0);
        unsigned nloc = b.st[0], nx = b.st[1];
        if (nloc == 0u) { xcd_barrier_complete(bar, b.x, nloc, nx); b.st[0] = nloc; b.st[1] = nx; }
        const unsigned old = xb_add(&bar[XB_XSUB(b.x)], 1u);
        const unsigned gen = old / nloc;
        if (old + 1u == (gen + 1u) * nloc) {
            __builtin_amdgcn_fence(__ATOMIC_RELEASE, "agent");
            asm volatile("s_waitcnt vmcnt(0)" ::: "memory");
            const unsigned og = xb_add(&bar[XB_TOP], 1u);
            const unsigned tg = og / nx;
            if (og + 1u == (tg + 1u) * nx) xb_add(&bar[XB_TOPGEN], 1u);
            else XB_SPIN(xb_ld(&bar[XB_TOPGEN]) == tg, bar);
            __builtin_amdgcn_fence(__ATOMIC_ACQUIRE, "agent");
            xb_add(&bar[XB_XGEN(b.x)], 1u);
            asm volatile("s_waitcnt vmcnt(0)" ::: "memory");
        } else {
            XB_SPIN(xb_ld(&bar[XB_XGEN(b.x)]) == gen, bar);
            __builtin_amdgcn_fence(__ATOMIC_ACQUIRE, "agent");
            asm volatile("s_waitcnt vmcnt(0)" ::: "memory");
        }
    }
    __syncthreads();
}

__global__ void __launch_bounds__(512, 2) fwd_kernel(Args a) {
    extern __shared__ __attribute__((aligned(16))) unsigned char lds_raw[];
    LAS unsigned char* lds = (LAS unsigned char*)lds_raw;
    unsigned char* ws0 = a.ws;
    volatile LAS unsigned* MISC = (volatile LAS unsigned*)(lds + 131072);
    const int wave0 = __builtin_amdgcn_readfirstlane((int)threadIdx.x >> 6);
#define MYTID() (wave0 * 64 + lane_id_())
    if (MYTID() < 64) MISC[MYTID()] = 0u;
    __syncthreads();
    XcdBarrier xbar; xbar.bar = (unsigned*)(ws0 + WS_CTL); xbar.x = 0; xbar.st = nullptr;
    if (a.coop) xbar = xcd_barrier_post((unsigned*)(ws0 + WS_CTL), MISC + 8, MYTID());

#define PH_PROLOG const __attribute__((address_space(4))) Args* ap = (const __attribute__((address_space(4))) Args*)__builtin_amdgcn_kernarg_segment_ptr(); asm volatile("" : "+s"(ap)); const float* x_in = ap->in[0]; const float* c_in = ap->in[1]; const float* ctx_in = ap->in[2]; const float* cctx_in = ap->in[3]; const float* norm_w = ap->in[4]; const float* w_mod = ap->in[5]; const float* b_mod = ap->in[6]; const float* w_in = ap->in[7]; const float* conv_w = ap->in[8]; const float* w_a_out = ap->in[9]; const float* w_b_out = ap->in[10]; const float* attn_sink = ap->in[11]; const float* w_o = ap->in[12]; const float* fnorm_w = ap->in[13]; unsigned char* ws = ap->ws; bf16_t* WIN_T = (bf16_t*)(ws + WS_WIN_T); bf16_t* WAB_T = (bf16_t*)(ws + WS_WAB_T); bf16_t* WO_T = (bf16_t*)(ws + WS_WO_T); float* MOD = (float*)(ws + WS_MOD); float* NW1 = (float*)(ws + WS_NW1); float* SB = (float*)(ws + WS_SB); float* ROPEC = (float*)(ws + WS_ROPE); float* ROPES = ROPEC + 64 * 16; float* SSP = (float*)(ws + WS_SSP); resid_t* XCTX = (resid_t*)(ws + WS_XCTX); bf16_t* XS = (bf16_t*)(ws + WS_XS); bf16_t* P = (bf16_t*)(ws + WS_P); float* OUT = ap->out; (void)x_in; (void)c_in; (void)ctx_in; (void)cctx_in; (void)norm_w; (void)w_mod; (void)b_mod; (void)w_in; (void)conv_w; (void)w_a_out; (void)w_b_out; (void)attn_sink; (void)w_o; (void)fnorm_w; (void)WIN_T; (void)WAB_T; (void)WO_T; (void)MOD; (void)NW1; (void)SB; (void)ROPEC; (void)ROPES; (void)SSP; (void)XCTX; (void)XS; (void)P; (void)OUT; int tid = MYTID(), bx = blockIdx.x; asm volatile("" : "+v"(tid), "+s"(bx)); const int lane = tid & 63, wave = __builtin_amdgcn_readfirstlane(tid >> 6); const int G = gridDim.x; const int gw = bx * 8 + wave, NGW = G * 8; (void)lane; (void)gw; (void)NGW;
#define DUP_ON(k) ((DUP_MASK >> (k)) & 1)
#if MK_COOP
#define SEAM_SYNC() do { if (a.coop) xcd_barrier(xbar, MYTID()); __syncthreads(); } while (0)
#else
#define SEAM_SYNC() do { } while (0)
#endif
    if (a.ph_lo == 0 && (PHMASK & 1)) { PH_PROLOG
          for (int rep = DUP_ON(0) ? 0 : 1; rep < 2; ++rep) {
            constexpr int NMOD = DEPTH * 48;
            if (bx < NMOD) {
                LAS float* tab = (LAS float*)lds;
#pragma clang loop vectorize(disable) interleave(disable) unroll(disable)
                for (int idx = tid; idx < 17 * 1024; idx += 512) { const int r = idx >> 10, k = idx & 1023; const float v = (r < 16) ? c_in[r * 1024 + k] : cctx_in[k]; tab[idx] = siluf_(v); }
                __syncthreads();
                for (int it = bx; it < NMOD; it += G) { const int l = it / 48, ec = it % 48;
                    rowmat17_item(tid, lds, w_mod + (size_t)l * 1024 * 3072, 3072, ec * 64, b_mod + l * 3072, MOD + (size_t)l * 17 * 3072, 3072); }
            }
            __syncthreads();
            if (bx == G - 1) { for (int idx = tid; idx < 64 * 16; idx += 512) { const int pos = idx >> 4, f = idx & 15; const float invf = powf(10000.0f, -(float)f / 16.0f); const float ang = (float)pos * invf;
                    ROPEC[idx] = cosf(ang); ROPES[idx] = sinf(ang); } }
            LAS float* scr = (LAS float*)(lds + wave * 16384);
            constexpr int I_IN = 16 * 168, I_A = 8 * 32, I_O = 16 * 32;
            constexpr int NITEMS = I_IN + DEPTH * (2 * I_A + I_O);
            for (int it = gw; it < NITEMS; it += NGW) {
                int r = it;
                if (r < I_IN) { transpose_item(w_in, NIN, WIN_T, 1024, 0, 168, scr, r, lane, true); continue; } r -= I_IN;
                const int l = r / (2 * I_A + I_O); r -= l * (2 * I_A + I_O);
                if (r < I_A) { transpose_item(w_a_out + (size_t)l * 512 * 1024, 1024, WAB_T + (size_t)l * 1024 * 1024, 1024, 0, 32, scr, r, lane); continue; } r -= I_A;
                if (r < I_A) { transpose_item(w_b_out + (size_t)l * 512 * 1024, 1024, WAB_T + (size_t)l * 1024 * 1024, 1024, 512, 32, scr, r, lane); continue; } r -= I_A;
                transpose_item(w_o + (size_t)l * 1024 * 1024, 1024, WO_T + (size_t)l * 1024 * 1024, 1024, 0, 32, scr, r, lane);
            }
            if (rep == 0) SEAM_SYNC();
          }
    }
    if (a.ph_lo == 0 && a.ph_hi > 1) {
#if MK_COOP
        if (a.coop) cg::this_grid().sync();
#endif
        __syncthreads();
    }
    for (int ph = (a.ph_lo == 0 ? 1 : a.ph_lo); ph < a.ph_hi; ++ph) {
        if (ph == 1 && (PHMASK & 2)) { PH_PROLOG
          for (int rep = DUP_ON(1) ? 0 : 1; rep < 2; ++rep) {
            constexpr int NSB = DEPTH * 84;
            { int curl = -1;
              for (int it = bx; it < NSB; it += G) { const int l = it / 84, nc = it % 84;
                if (l != curl) { __syncthreads(); LAS float* tab = (LAS float*)lds;
#pragma clang loop vectorize(disable) interleave(disable) unroll(disable)
                    for (int idx = tid; idx < 17 * 1024; idx += 512) { const int r = idx >> 10, k = idx & 1023; tab[idx] = MOD[((size_t)l * 17 + r) * 3072 + k]; }
                    __syncthreads(); curl = l; }
                rowmat17_item(tid, lds, w_in + (size_t)l * 1024 * NIN, NIN, nc * 64, nullptr, SB + (size_t)l * 17 * NIN, NIN, orig_col(nc * 64)); } }
            for (int idx = bx * 512 + tid; idx < DEPTH * 17 * 1024; idx += G * 512) { const int k = idx & 1023, lr = idx >> 10, l = lr / 17;
                NW1[idx] = norm_w[l * 1024 + k] * (1.0f + MOD[(size_t)lr * 3072 + 1024 + k]); }
            for (int row0 = gw * 3; row0 < TT; row0 += NGW * 3) {
                f32x4 v[3][4]; float ss[3];
#pragma unroll
                for (int q = 0; q < 3; ++q) { const int row = row0 + q; const bool lat = row < TL;
                    const f32x4* xr = (const f32x4*)(lat ? x_in + (size_t)row * DM : ctx_in + (size_t)(row - TL) * DM) + lane;
#pragma unroll
                    for (int j = 0; j < 4; ++j) v[q][j] = xr[64 * j]; }
#pragma unroll
                for (int q = 0; q < 3; ++q) { float s_ = 0.f;
#pragma unroll
                    for (int j = 0; j < 4; ++j) s_ += (v[q][j][0] * v[q][j][0] + v[q][j][1] * v[q][j][1]) + (v[q][j][2] * v[q][j][2] + v[q][j][3] * v[q][j][3]);
                    ss[q] = wave_sum(s_, lane); }
#pragma unroll
                for (int q = 0; q < 3; ++q) { const int row = row0 + q; const bool lat = row < TL; const int b = lat ? (row >> 11) : 16;
                    const f32x4* nwp = (const f32x4*)norm_w + lane; const f32x4* scp = (const f32x4*)(MOD + (size_t)b * 3072 + 1024) + lane;
                    u32x2* o8 = (u32x2*)(XS + (size_t)row * DM) + lane;
#if RESID_BF16
                    u32x2* x8 = (u32x2*)(lat ? (bf16_t*)OUT + (size_t)row * DM : XCTX + (size_t)(row - TL) * DM) + lane;
#endif
#pragma unroll
                    for (int j = 0; j < 4; ++j) { const f32x4 hh = v[q][j] * (nwp[64 * j] * (scp[64 * j] + 1.0f)); u32x2 w; w.x = cvt_pk_bf16(hh[0], hh[1]); w.y = cvt_pk_bf16(hh[2], hh[3]); o8[64 * j] = w;
#if RESID_BF16
                        u32x2 wx; wx.x = cvt_pk_bf16(v[q][j][0], v[q][j][1]); wx.y = cvt_pk_bf16(v[q][j][2], v[q][j][3]); x8[64 * j] = wx;
#endif
                    }
                    if (lane < 16) SSP[(size_t)row * 16 + lane] = (lane == 0) ? ss[q] : 0.f; }
            }
            if (rep == 0) SEAM_SYNC();
          }
        } else if (ph == NPHASE - 1 && (PHMASK & 4)) { PH_PROLOG
            for (int row = gw; row < TL; row += NGW) {
                float s = SSP[(size_t)row * 16 + (lane & 15)];
                s += shx(s, lane, 1); s += shx(s, lane, 2); s += shx(s, lane, 4); s += shx(s, lane, 8);
                const float rinv = 1.0f / sqrtf(s * (1.0f / 1024.0f) + RMS_EPS);
                f32x4* xr = (f32x4*)(OUT + (size_t)row * DM) + lane; const f32x4* fw = (const f32x4*)fnorm_w + lane;
#if RESID_BF16
                const u32x2* xb = (const u32x2*)(XS + (size_t)row * DM) + lane;
#pragma unroll
                for (int j = 0; j < 4; ++j) { const u32x2 w = xb[64 * j]; const f32x4 v = (f32x4){bf_lo(w.x), bf_hi(w.x), bf_lo(w.y), bf_hi(w.y)}; xr[64 * j] = v * rinv * fw[64 * j]; }
#else
#pragma unroll
                for (int j = 0; j < 4; ++j) { const f32x4 v = xr[64 * j]; xr[64 * j] = v * rinv * fw[64 * j]; }
#endif
            }
        } else {
            const int l = (ph - 2) >> 2, sub = (ph - 2) & 3;
            const bool lastl = (l == DEPTH - 1);
            if (sub == 0 && (PHMASK & 8)) { PH_PROLOG
                pg8::Gemm g{XS, WIN_T, DM, DM};
                pg8::Order S; if (!lastl) S.init(TT / 256, NIN / 256, G, bx); else S.init(TL / 256, NIN / 256, G, bx, NB, TL / 256, 10);
                { LAS float* rt = (LAS float*)(lds + LDS_ROPE_OFF); for (int idx = tid; idx < 2048; idx += 512) rt[idx] = ROPEC[idx]; __syncthreads(); }
                for (int rep = DUP_ON(3) ? 0 : 1; rep < 2; ++rep) { EpiG1 E{P, SSP, SB + (size_t)l * 17 * NIN, lds, rep == 0 ? PROBE_SKIP : 0};
                    pg8::gemm_phase<EpiG1, pg8::Order, true>(tid, lds, g, S, E, rep == 0 ? (unsigned)(((bx >> 3) & 31) * PROBE_STAGGER) : 0u); if (rep == 0) SEAM_SYNC(); }
            } else if (sub == 1 && (PHMASK & 16)) { PH_PROLOG
                const float* sink = attn_sink + l * 8;
                const int nlat = 1024, nctx = lastl ? 0 : 128;
              for (int rep = DUP_ON(4) ? 0 : 1; rep < 2; ++rep) {
                bf16_t* Oo = rep ? P : XS; const int opitch = rep ? NCOL : 1024, ocol = rep ? C_Q : 512, ycol = rep ? C_BZ : 0;
                if (!(rep == 0 && PROBE_AT == 2)) {
#if ATTN_V3
                    for (int ua = bx; ua < nlat + nctx; ua += G) { const AUnit D = aunit(ua, wave, nlat);
                        at3::attn_unit<8>(tid, lds, P, Oo, opitch, ocol, D.rowQ0, D.h, D.kh, D.qq0, D.nloc, D.jlo, D.kr_loc0, D.kr_ctx0, sink[D.h] * LOG2E); }
#else
                    attn_phase2(lds, tid, P, Oo, opitch, ocol, sink, bx, G, nlat, nlat + nctx, rep == 0 ? PROBE_ATV : 0);
#endif
                }
                __syncthreads();
                const int nruns = (lastl ? TL : TT) / 8;
                for (int it = (NGW - 1 - gw); it < nruns && !(rep == 0 && PROBE_AT == 1); it += NGW) conv_run8(P, Oo, opitch, ycol, conv_w + (size_t)l * 3 * 512, it, lane);
                if (rep == 0) SEAM_SYNC();
              }
            } else if (sub == 2 && (PHMASK & 32)) { PH_PROLOG
                pg8::Gemm g{P + C_BZ, WAB_T + (size_t)l * 1024 * 1024, NCOL, DM};
                pg8::Order S; S.init((lastl ? TL : TT) / 256, 4, G, bx);
                for (int rep = DUP_ON(5) ? 0 : 1; rep < 2; ++rep) {
                    EpiG2 E{P, rep ? P : XS, rep ? NCOL : 1024, rep ? C_GA : 0};
                    pg8::gemm_phase<EpiG2, pg8::Order, true>(tid, lds, g, S, E); if (rep == 0) SEAM_SYNC(); }
                if (!lastl) {
                    const int tid_t = MYTID(); int bx_t = blockIdx.x; asm volatile("" : "+s"(bx_t));
                    const int lane_t = tid_t & 63, wave_t = __builtin_amdgcn_readfirstlane(tid_t >> 6);
                    const int nunits = (TT / 256) * 4, nfull = nunits % G;
                    const int b0 = (nfull == 0) ? 0 : nfull, nb = G - b0;
                    if (bx_t >= b0) { LAS float* scr = (LAS float*)(lds + wave_t * 16384);
                        for (int it = (bx_t - b0) * 8 + wave_t; it < 16 * 168; it += nb * 8) transpose_item(w_in + (size_t)(l + 1) * 1024 * NIN, NIN, WIN_T, 1024, 0, 168, scr, it, lane_t, true);
                    }
                }
            } else if (PHMASK & 64) { PH_PROLOG
                pg8::Gemm g{P + C_GA, WO_T + (size_t)l * 1024 * 1024, NCOL, DM};
                pg8::Order S; S.init((lastl ? TL : TT) / 256, 4, G, bx);
                for (int rep = DUP_ON(6) ? 0 : 1; rep < 2; ++rep) {
                    #if RESID_BF16
                    EpiG3 E{(const bf16_t*)OUT, XCTX, lastl ? XS : (bf16_t*)OUT, XCTX, MOD + (size_t)l * 17 * 3072 + 2048, lastl ? nullptr : NW1 + (size_t)(l + 1) * 17 * 1024, XS, SSP, lds};
#else
                    EpiG3 E{l == 0 ? x_in : OUT, l == 0 ? ctx_in : XCTX, OUT, XCTX, MOD + (size_t)l * 17 * 3072 + 2048, lastl ? nullptr : NW1 + (size_t)(l + 1) * 17 * 1024, XS, SSP, lds};
#endif
                    pg8::gemm_phase<EpiG3, pg8::Order, true>(tid, lds, g, S, E); if (rep == 0) SEAM_SYNC(); }
            }
        }
        if (ph + 1 < a.ph_hi) {
#if MK_COOP
            if (a.coop) xcd_barrier(xbar, MYTID());
#endif
            __syncthreads();
        }
    }
}

extern "C" void kernel_launch(void* const* d_in, const int* in_sizes, int n_in, void* d_out, int out_size, void* d_ws, size_t ws_size, hipStream_t stream) {
    static int grid = 0;
    if (grid == 0) {
        if (n_in != 14 || in_sizes[0] != TL * DM || out_size != TL * DM || ws_size < WS_END) {
            fprintf(stderr, "kernel_launch: unexpected shapes (n_in %d, in0 %d, out %d, ws %zu need %zu); nothing launched\n", n_in, n_in > 0 ? in_sizes[0] : -1, out_size, ws_size, (size_t)WS_END); grid = -1; return; }
        int dev = 0, cus = 0;
        if (hipGetDevice(&dev) != hipSuccess || hipDeviceGetAttribute(&cus, hipDeviceAttributeMultiprocessorCount, dev) != hipSuccess || cus <= 0) cus = 256;
        if (hipFuncSetAttribute((const void*)fwd_kernel, hipFuncAttributeMaxDynamicSharedMemorySize, LDS_BYTES) != hipSuccess) { fprintf(stderr, "kernel_launch: hipFuncSetAttribute failed\n"); grid = -1; return; }
        int per_cu = 0;
        if (hipOccupancyMaxActiveBlocksPerMultiprocessor(&per_cu, (const void*)fwd_kernel, 512, LDS_BYTES) != hipSuccess || per_cu < 1) { fprintf(stderr, "kernel_launch: occupancy query says %d\n", per_cu); (void)hipGetLastError(); }
        grid = cus;
    }
    if (grid < 0) return;
    Args a{};
    for (int i = 0; i < 14; ++i) a.in[i] = (const float*)d_in[i];
    a.out = (float*)d_out; a.ws = (unsigned char*)d_ws;
#if MK_COOP
    if (hipMemsetAsync((char*)d_ws + WS_CTL, 0, CTL_ZERO_BYTES, stream) != hipSuccess) { fprintf(stderr, "kernel_launch: memset failed\n"); return; }
    a.ph_lo = 0; a.ph_hi = NPHASE; a.coop = 1;
    void* args[] = {&a};
    hipError_t e = hipLaunchCooperativeKernel((const void*)fwd_kernel, dim3(grid), dim3(512), args, LDS_BYTES, stream);
    if (e != hipSuccess) fprintf(stderr, "cooperative launch failed: %s (grid %d)\n", hipGetErrorString(e), grid);
#else
    for (int ph = 0; ph < NPHASE; ++ph) {
        a.ph_lo = ph; a.ph_hi = ph + 1; a.coop = 0;
        hipLaunchKernelGGL(fwd_kernel, dim3(grid), dim3(512), LDS_BYTES, stream, a);
    }
#endif
}
```

```cpp
#include <hip/hip_runtime.h>
#include <hip/hip_cooperative_groups.h>
#include <cstdio>
#include <cstdint>
namespace cg = cooperative_groups;

#ifndef PHMASK
#define PHMASK 127
#endif
#ifndef PROBE_SKIP
#define PROBE_SKIP 0
#endif
#ifndef PROBE_STAGGER
#define PROBE_STAGGER 0
#endif
#ifndef PROBE_AT
#define PROBE_AT 0
#endif
#ifndef PROBE_ATV
#define PROBE_ATV 0
#endif
#ifndef ATTN_V3
#define ATTN_V3 1
#endif
#ifndef RESID_BF16
#define RESID_BF16 0
#endif
#ifndef PROBE_PHASE
#define PROBE_PHASE -1
#endif
#ifndef PROBE_REPS
#define PROBE_REPS 1
#endif
#ifndef DUP_MASK
#define DUP_MASK 0
#endif
#ifndef MK_COOP
#define MK_COOP 1
#endif

#define LAS __attribute__((address_space(3)))
typedef unsigned short bf16_t;
typedef short bf16x8 __attribute__((ext_vector_type(8)));
typedef short s16x4 __attribute__((ext_vector_type(4)));
typedef short v4i16_t __attribute__((ext_vector_type(4)));
typedef float f32x4 __attribute__((ext_vector_type(4)));
typedef float f32x16 __attribute__((ext_vector_type(16)));
typedef unsigned u32x4 __attribute__((ext_vector_type(4)));
typedef unsigned u32x2 __attribute__((ext_vector_type(2)));

constexpr int DM = 1024, NB = 16, SEQ = 2048, CTXL = 256, DEPTH = 4, NIN = 5376, NCOL = 4352;
constexpr int TL = NB * SEQ, TC = NB * CTXL, TT = TL + TC;
constexpr int C_CU = 0, C_BZ = 512, C_Q = 1024, C_K = 1536, C_V = 1664, C_ZB = 1792, C_GA = 2304, C_GB = 3328;
__host__ __device__ __forceinline__ int orig_col(int c) { const int t = c >> 8, h = (c >> 7) & 1, o = c & 127; return (t < 4) ? (h ? 1024 : 512) + t * 128 + o : (t < 8) ? (h ? 1536 : 0) + (t - 4) * 128 + o : (t < 13) ? c : (h ? 4352 : 3328) + (t - 13) * 128 + o; }
constexpr float RMS_EPS = 1e-6f;
constexpr float LOG2E = 1.4426950408889634f;
constexpr float QSCALE = 0.125f * LOG2E;

constexpr size_t MiB = 1u << 20;
constexpr size_t WS_CTL = 0, CTL_ZERO_BYTES = 65536;
constexpr size_t WS_WIN_T = 1 * MiB;
constexpr size_t WS_WAB_T = 12 * MiB;
constexpr size_t WS_WO_T = 20 * MiB;
constexpr size_t WS_MOD = 28 * MiB;
constexpr size_t WS_NW1 = 29 * MiB;
constexpr size_t WS_SB = 30 * MiB;
constexpr size_t WS_ROPE = 32 * MiB;
constexpr size_t WS_SSP = 33 * MiB;
constexpr size_t WS_XCTX = 36 * MiB;
constexpr size_t WS_XS = 52 * MiB;
constexpr size_t WS_P = 124 * MiB;
constexpr size_t WS_END = WS_P + (size_t)TT * NCOL * 2;
static_assert(WS_END <= 502 * MiB && C_BZ + 512 == C_Q && C_GB + 1024 == NCOL, "ws map / P columns");

constexpr int LDS_EPI_OFF = 131072 + 1024;
constexpr int LDS_ROPE_OFF = 131072 + 1024 + 2048;
constexpr int LDS_BYTES = 131072 + 1024 + 2048 + 8192;
constexpr int NPHASE = 2 + 4 * DEPTH + 1;

struct Args { const float* in[14]; float* out; unsigned char* ws; int ph_lo, ph_hi, coop, probe; };

typedef float f32x2_c __attribute__((ext_vector_type(2))); typedef __bf16 bf16x2_c __attribute__((ext_vector_type(2)));
__device__ __forceinline__ unsigned cvt_pk_bf16(float lo, float hi) { f32x2_c v = {lo, hi}; bf16x2_c b = __builtin_convertvector(v, bf16x2_c); return __builtin_bit_cast(unsigned, b); }
__device__ __forceinline__ float bf_lo(unsigned w) { return __uint_as_float(w << 16); }
__device__ __forceinline__ float bf_hi(unsigned w) { return __uint_as_float(w & 0xffff0000u); }
__device__ __forceinline__ float fast_exp(float x) { return __builtin_amdgcn_exp2f(x * LOG2E); }
__device__ __forceinline__ float sigmoidf_(float x) { return __builtin_amdgcn_rcpf(1.0f + fast_exp(-x)); }
__device__ __forceinline__ float siluf_(float x) { return x * sigmoidf_(x); }
__device__ __forceinline__ float shx(float v, int lane, int m) { return __int_as_float(__builtin_amdgcn_ds_bpermute((lane ^ m) << 2, __float_as_int(v))); }
__device__ __forceinline__ float shl_(float v, int src) { return __int_as_float(__builtin_amdgcn_ds_bpermute(src << 2, __float_as_int(v))); }
__device__ __forceinline__ float wave_sum(float v, int lane) {
#pragma unroll
    for (int o = 1; o < 64; o <<= 1) v += shx(v, lane, o);
    return v;
}
__device__ __forceinline__ int lane_id_() { int r; asm volatile("v_mbcnt_lo_u32_b32 %0, -1, 0\n\tv_mbcnt_hi_u32_b32 %0, -1, %0" : "=v"(r)); return r; }
#define LDS_WAIT() asm volatile("s_waitcnt lgkmcnt(0)" ::: "memory")
#define VM_WAIT() asm volatile("s_waitcnt vmcnt(0)" ::: "memory")

namespace pg8 {
constexpr int BM = 256, BK = 64, HALF = 128, HTB = HALF * BK * 2, STAGE_BYTES = 8 * HTB, NXCD = 8, WGM = 8;
__host__ __device__ __forceinline__ int lds_byte(int r, int c) { const int st = (r >> 4) * 2 + (c >> 5), rr = r & 15, cc = c & 31, ob = rr * 64 + cc * 2; return st * 1024 + (ob ^ (((ob >> 9) & 1) << 5)); }
__host__ __device__ __forceinline__ void stage_rc(int b, int& R, int& C) { const int st = b / 1024, sb = b % 1024, swz = sb ^ (((sb >> 9) & 1) << 5); R = (st >> 1) * 16 + swz / 64; C = (st & 1) * 32 + (swz % 64) / 2; }
__host__ __device__ __forceinline__ int perm32(int rho) { const int n = rho >> 4, i = rho & 15; return 8 * (i >> 2) + 4 * n + (i & 3); }

struct Unit { int pm, pn; };
struct Gemm { const bf16_t* A; const bf16_t* Bt; int lda; int K; };

struct Order {
    int nM, nN, nwg, G, c, nextra, extra_pm0, extra_pn;
    __device__ void init(int nM_, int nN_, int G_, int c_, int nextra_ = 0, int epm0 = 0, int epn = 0) { nM = nM_; nN = nN_; nwg = nM * nN; G = G_; c = c_; nextra = nextra_; extra_pm0 = epm0; extra_pn = epn; }
    __device__ bool next(int i, Unit& u) const {
        const long L = (long)i * G + c; if (L >= nwg + nextra) return false;
        if (L >= nwg) { u.pm = extra_pm0 + (int)(L - nwg); u.pn = extra_pn; return true; }
        int wgid = (int)L; { const int q = nwg / NXCD, r = nwg % NXCD, xcd = wgid % NXCD, off = wgid / NXCD; wgid = (xcd < r ? xcd * (q + 1) : r * (q + 1) + (xcd - r) * q) + off; }
        const int nig = WGM * nN, gid = wgid / nig, fm = gid * WGM, gsz = (nM - fm) < WGM ? (nM - fm) : WGM;
        u.pm = fm + ((wgid % nig) % gsz); u.pn = (wgid % nig) / gsz; return true;
    }
};

template <class Epi, class Sched, bool ALIGN_EPI>
__device__ __forceinline__ void gemm_phase(int tid_in, LAS unsigned char* lds, const Gemm g, const Sched& S, const Epi& E, unsigned stagger_ticks = 0) {
    if (stagger_ticks) { const unsigned long long t0_ = __builtin_amdgcn_s_memrealtime(); while (__builtin_amdgcn_s_memrealtime() - t0_ < stagger_ticks) __builtin_amdgcn_s_sleep(8); }
    int tid = tid_in; asm volatile("" : "+v"(tid));
    const int wid = __builtin_amdgcn_readfirstlane(tid >> 6), lane = tid & 63, wr = wid >> 2, wc = wid & 3, fr = lane & 15, fq = lane >> 4;
    const int K = g.K, nt = K / BK, lda = g.lda;
    unsigned voffA[2], voffB[2];
#pragma unroll
    for (int i = 0; i < 2; ++i) { int R, C; stage_rc(tid * 16 + i * 8192, R, C); const int Rb = Epi::PERM ? ((R & ~31) + perm32(R & 31)) : R;
        voffA[i] = (unsigned)(R * lda + C) * 2u; voffB[i] = (unsigned)(Rb * K + C) * 2u; }
    const size_t kstep = (size_t)(BK * 2);
    const size_t hstepA = (size_t)HALF * lda * 2, tstepA = 2 * hstepA;
    const size_t hstepB = (size_t)HALF * K * 2, tstepB = 2 * hstepB;
    const unsigned ldsw = (unsigned)wid * 1024u;
    const int aoff = lds_byte(wr * 64 + fr, fq * 8), boff = lds_byte(wc * 32 + fr, fq * 8);
#define PG8_SA(b, h) (((b) * 2 + (h)) * HTB)
#define PG8_SB(b, h) ((4 + (b) * 2 + (h)) * HTB)
#define PG8_STAGE(bufoff, gbase, voff) do { _Pragma("unroll") for (int _i = 0; _i < 2; ++_i) \
        __builtin_amdgcn_global_load_lds((const unsigned*)((const char*)(gbase) + (voff)[_i]), (LAS unsigned*)(lds + (bufoff) + ldsw + _i * 8192), 16, 0, 0); } while (0)
#define PG8_LDA(dst, b, h) do { _Pragma("unroll") for (int m = 0; m < 4; ++m) _Pragma("unroll") for (int k = 0; k < 2; ++k) dst[m][k] = *(const LAS bf16x8*)(lds + PG8_SA(b, h) + aoff + m * 2048 + k * 1024); } while (0)
#define PG8_LDB(dst, b, h) do { _Pragma("unroll") for (int n = 0; n < 2; ++n) _Pragma("unroll") for (int k = 0; k < 2; ++k) dst[n][k] = *(const LAS bf16x8*)(lds + PG8_SB(b, h) + boff + n * 2048 + k * 1024); } while (0)
#define PG8_MMA(ai, bj, At, Bt) do { __builtin_amdgcn_s_setprio(1); _Pragma("unroll") for (int m = 0; m < 4; ++m) _Pragma("unroll") for (int n = 0; n < 2; ++n) _Pragma("unroll") for (int k = 0; k < 2; ++k) \
        acc[ai][bj][m][n] = __builtin_amdgcn_mfma_f32_16x16x32_bf16(Bt[n][k], At[m][k], acc[ai][bj][m][n], 0, 0, 0); __builtin_amdgcn_s_setprio(0); } while (0)
#define PG8_WAIT_V(n) asm volatile("s_waitcnt vmcnt(" #n ")" ::: "memory")
#define PG8_WAIT_L(n) asm volatile("s_waitcnt lgkmcnt(" #n ")" ::: "memory")
#define PG8_BAR __builtin_amdgcn_s_barrier()
#define PG8_SCHED __builtin_amdgcn_sched_barrier(0)
    Unit cur, nxt; int ui = 0;
    if (!S.next(0, cur)) return;
    f32x4 acc[2][2][4][2];
#pragma unroll
    for (int a = 0; a < 2; ++a)
#pragma unroll
        for (int b = 0; b < 2; ++b)
#pragma unroll
            for (int m = 0; m < 4; ++m)
#pragma unroll
                for (int n = 0; n < 2; ++n) acc[a][b][m][n] = (f32x4){0.f, 0.f, 0.f, 0.f};
    bf16x8 At[4][2], B0[2][2], B1[2][2];
    const char* cA = (const char*)g.A + (size_t)cur.pm * tstepA; const char* cB = (const char*)g.Bt + (size_t)cur.pn * tstepB;
    PG8_STAGE(PG8_SB(0, 0), cB, voffB); PG8_STAGE(PG8_SB(0, 1), cB + hstepB, voffB); PG8_STAGE(PG8_SA(0, 0), cA, voffA); PG8_STAGE(PG8_SA(0, 1), cA + hstepA, voffA);
    if (wr == 1) PG8_BAR;
    PG8_WAIT_V(2); PG8_BAR;
    PG8_STAGE(PG8_SB(1, 0), cB + kstep, voffB); PG8_STAGE(PG8_SA(1, 0), cA + kstep, voffA); PG8_STAGE(PG8_SB(1, 1), cB + hstepB + kstep, voffB);
    PG8_WAIT_V(6); PG8_BAR;
    for (;;) {
        const bool has_next = S.next(ui + 1, nxt);
        const char* nA = has_next ? (const char*)g.A + (size_t)nxt.pm * tstepA : cA; const char* nB = has_next ? (const char*)g.Bt + (size_t)nxt.pn * tstepB : cB;
        for (int t = 0; t < nt; t += 2) {
            if constexpr (Epi::HOOK) { if (t == (nt >> 1)) E.mid(acc, cur, wr, wc, fr, fq); }
            const bool last = (t == nt - 2);
            const char* a1 = cA + (size_t)(t + 1) * kstep;
            const char* a2 = last ? nA : cA + (size_t)(t + 2) * kstep; const char* b2 = last ? nB : cB + (size_t)(t + 2) * kstep;
            const char* a3 = a2 + kstep; const char* b3 = b2 + kstep;
            PG8_LDB(B0, 0, 0); PG8_LDB(B1, 0, 1); PG8_SCHED; PG8_LDA(At, 0, 0); PG8_STAGE(PG8_SA(1, 1), a1 + hstepA, voffA);
            PG8_WAIT_V(8); PG8_WAIT_L(0); PG8_BAR; PG8_MMA(0, 0, At, B0); PG8_MMA(0, 1, At, B1); PG8_BAR; PG8_SCHED;
            PG8_LDA(At, 0, 1); PG8_STAGE(PG8_SB(0, 0), b2, voffB); PG8_STAGE(PG8_SB(0, 1), b2 + hstepB, voffB); PG8_STAGE(PG8_SA(0, 0), a2, voffA);
            PG8_WAIT_V(8); PG8_WAIT_L(0); PG8_BAR; PG8_MMA(1, 0, At, B0); PG8_MMA(1, 1, At, B1); PG8_BAR; PG8_SCHED;
            PG8_LDB(B0, 1, 0); PG8_LDB(B1, 1, 1); PG8_SCHED; PG8_LDA(At, 1, 0); PG8_STAGE(PG8_SA(0, 1), a2 + hstepA, voffA);
            PG8_WAIT_V(8); PG8_WAIT_L(0); PG8_BAR; PG8_MMA(0, 0, At, B0); PG8_MMA(0, 1, At, B1); PG8_BAR; PG8_SCHED;
            PG8_LDA(At, 1, 1); PG8_STAGE(PG8_SB(1, 0), b3, voffB); PG8_STAGE(PG8_SB(1, 1), b3 + hstepB, voffB); PG8_STAGE(PG8_SA(1, 0), a3, voffA);
            PG8_WAIT_V(8); PG8_WAIT_L(0); PG8_BAR; PG8_MMA(1, 0, At, B0); PG8_MMA(1, 1, At, B1); PG8_BAR; PG8_SCHED;
        }
        if constexpr (ALIGN_EPI) { if (wr == 0) PG8_BAR; }
        E(acc, cur, wr, wc, fr, fq);
        if (!has_next) break;
#pragma unroll
        for (int a = 0; a < 2; ++a)
#pragma unroll
            for (int b = 0; b < 2; ++b)
#pragma unroll
                for (int m = 0; m < 4; ++m)
#pragma unroll
                    for (int n = 0; n < 2; ++n) acc[a][b][m][n] = (f32x4){0.f, 0.f, 0.f, 0.f};
        cur = nxt; cA = nA; cB = nB; ++ui;
        if constexpr (ALIGN_EPI) { if (wr == 1) PG8_BAR; }
    }
    PG8_WAIT_V(0);
    if constexpr (!ALIGN_EPI) { if (wr == 0) PG8_BAR; }
    PG8_BAR;
#undef PG8_SA
#undef PG8_SB
#undef PG8_STAGE
#undef PG8_LDA
#undef PG8_LDB
#undef PG8_MMA
#undef PG8_WAIT_V
#undef PG8_WAIT_L
#undef PG8_BAR
#undef PG8_SCHED
}
}

struct EpiG1 {
    static constexpr bool PERM = true, HOOK = false;
    bf16_t* P; const float* ssp; const float* sb; LAS unsigned char* ldsc; int skip;
    __device__ __forceinline__ void mid(f32x4 (&)[2][2][4][2], const pg8::Unit&, int, int, int, int) const {}
    __device__ __forceinline__ void operator()(const f32x4 (&acc)[2][2][4][2], const pg8::Unit& u, int wr, int wc, int fr, int fq) const {
        if (skip == 2) { if (acc[0][0][0][0][0] == 12345.678f) P[0] = 1; return; }
        asm volatile("" : "+v"(fr), "+v"(fq));
        const bool latent = u.pm < 128;
        const int bidx = latent ? (u.pm >> 3) : 16;
        const int col8 = u.pn * 256 + wc * 32 + 8 * fq;
        const float* sbr = sb + bidx * NIN + col8;
        f32x4 bv[2][2];
#pragma unroll
        for (int bj = 0; bj < 2; ++bj)
#pragma unroll
            for (int n = 0; n < 2; ++n) bv[bj][n] = *(const f32x4*)(sbr + bj * 128 + n * 4);
        const bool isq = (u.pn == 8 || u.pn == 9), isk = (u.pn == 10);
        const bool anyrope = latent && (isq || isk);
        const float sc = isq ? QSCALE : 1.0f;
        float rinv[8];
        {
            const int ln = fq * 16 + fr;
            f32x4 pv[8];
#pragma unroll
            for (int i = 0; i < 8; ++i) pv[i] = *(const f32x4*)(ssp + (size_t)(u.pm * 256 + (i >> 2) * 128 + wr * 64 + (i & 3) * 16 + (ln >> 2)) * 16 + (ln & 3) * 4);
#pragma unroll
            for (int i = 0; i < 8; ++i) { float q = (pv[i][0] + pv[i][1]) + (pv[i][2] + pv[i][3]); q += shx(q, ln, 1); q += shx(q, ln, 2);
                const float r = 1.0f / sqrtf(q * (1.0f / 1024.0f) + RMS_EPS); rinv[i] = shl_(r, 4 * fr); }
        }
        bf16_t* pb = P + (size_t)u.pm * 256 * NCOL;
        if (u.pn < 8) {
            const bool iscu = u.pn < 4;
            const unsigned lo2 = (unsigned)((wr * 64 + fr) * NCOL + (iscu ? C_CU + u.pn * 128 : C_BZ + (u.pn - 4) * 128) + wc * 32 + 8 * fq);
#pragma unroll
            for (int ai = 0; ai < 2; ++ai)
#pragma unroll
                for (int m = 0; m < 4; ++m) {
                    const float ri = rinv[ai * 4 + m];
                    bf16_t* rowp = pb + (size_t)(ai * 128 + m * 16) * NCOL;
                    const f32x4 a0 = acc[ai][0][m][0] * ri + bv[0][0], a1 = acc[ai][0][m][1] * ri + bv[0][1];
                    const f32x4 b0 = acc[ai][1][m][0] * ri + bv[1][0], b1 = acc[ai][1][m][1] * ri + bv[1][1];
                    f32x4 o0, o1;
                    if (iscu) { o0 = a0 * b0; o1 = a1 * b1; }
                    else {
#pragma unroll
                        for (int e = 0; e < 4; ++e) { o0[e] = a0[e] * siluf_(b0[e]); o1[e] = a1[e] * siluf_(b1[e]); } }
                    u32x4 w; w.x = cvt_pk_bf16(o0[0], o0[1]); w.y = cvt_pk_bf16(o0[2], o0[3]); w.z = cvt_pk_bf16(o1[0], o1[1]); w.w = cvt_pk_bf16(o1[2], o1[3]);
                    *(u32x4*)(rowp + lo2) = w;
                }
            return;
        }
        if (u.pn >= 13) {
            const unsigned lo3 = (unsigned)((wr * 64 + fr) * NCOL + (u.pn - 13) * 128 + wc * 32 + 8 * fq);
#pragma unroll
            for (int ai = 0; ai < 2; ++ai)
#pragma unroll
                for (int m = 0; m < 4; ++m) {
                    const float ri = rinv[ai * 4 + m];
                    bf16_t* rowp = pb + (size_t)(ai * 128 + m * 16) * NCOL;
                    const f32x4 a0 = acc[ai][0][m][0] * ri + bv[0][0], a1 = acc[ai][0][m][1] * ri + bv[0][1];
                    const f32x4 b0 = acc[ai][1][m][0] * ri + bv[1][0], b1 = acc[ai][1][m][1] * ri + bv[1][1];
                    f32x4 r0, r1, s0, s1;
#pragma unroll
                    for (int e = 0; e < 4; ++e) {
                        const float ea0 = 1.0f + fast_exp(-a0[e]), eb0 = 1.0f + fast_exp(-b0[e]), ea1 = 1.0f + fast_exp(-a1[e]), eb1 = 1.0f + fast_exp(-b1[e]);
                        r0[e] = eb0 * __builtin_amdgcn_rcpf(ea0); s0[e] = __builtin_amdgcn_rcpf(eb0); r1[e] = eb1 * __builtin_amdgcn_rcpf(ea1); s1[e] = __builtin_amdgcn_rcpf(eb1); }
                    u32x4 wr_, ws_;
                    wr_.x = cvt_pk_bf16(r0[0], r0[1]); wr_.y = cvt_pk_bf16(r0[2], r0[3]); wr_.z = cvt_pk_bf16(r1[0], r1[1]); wr_.w = cvt_pk_bf16(r1[2], r1[3]);
                    ws_.x = cvt_pk_bf16(s0[0], s0[1]); ws_.y = cvt_pk_bf16(s0[2], s0[3]); ws_.z = cvt_pk_bf16(s1[0], s1[1]); ws_.w = cvt_pk_bf16(s1[2], s1[3]);
                    *(u32x4*)(rowp + (lo3 + (unsigned)C_GA)) = wr_; *(u32x4*)(rowp + (lo3 + (unsigned)C_GB)) = ws_;
                }
            return;
        }
        const unsigned lo = (unsigned)((wr * 64 + fr) * NCOL + C_Q + (u.pn - 8) * 256 + wc * 32 + 8 * fq);
        if (!anyrope) {
#pragma unroll
            for (int ai = 0; ai < 2; ++ai)
#pragma unroll
                for (int m = 0; m < 4; ++m) {
                    const float ri = rinv[ai * 4 + m];
                    bf16_t* rowp = pb + (size_t)(ai * 128 + m * 16) * NCOL;
#pragma unroll
                    for (int bj = 0; bj < 2; ++bj) {
                        const f32x4 v0 = (acc[ai][bj][m][0] * ri + bv[bj][0]) * sc, v1 = (acc[ai][bj][m][1] * ri + bv[bj][1]) * sc;
                        u32x4 w; w.x = cvt_pk_bf16(v0[0], v0[1]); w.y = cvt_pk_bf16(v0[2], v0[3]); w.z = cvt_pk_bf16(v1[0], v1[1]); w.w = cvt_pk_bf16(v1[2], v1[3]);
                        *(u32x4*)(rowp + (lo + (unsigned)(bj * 128))) = w;
                    }
                }
        } else {
            const LAS f32x4* tc4 = (const LAS f32x4*)(ldsc + LDS_ROPE_OFF);
            const LAS f32x4* ts4 = tc4 + 256;
            const float sgn = (fq < 2) ? -1.0f : 1.0f;
            const bool oddw = (wc & 1) != 0;
#pragma unroll
            for (int ai = 0; ai < 2; ++ai)
#pragma unroll
                for (int m = 0; m < 4; ++m) {
                    const int t = (u.pm * 256 + ai * 128 + wr * 64 + m * 16 + fr) & 2047;
                    const int pos = oddw ? (t & 63) : (t >> 6);
                    const int ti = pos * 4 + (fq & 1) * 2;
                    const f32x4 c0 = tc4[ti], c1 = tc4[ti + 1], s0 = ts4[ti], s1 = ts4[ti + 1];
                    const float ri = rinv[ai * 4 + m];
                    bf16_t* rowp = pb + (size_t)(ai * 128 + m * 16) * NCOL;
#pragma unroll
                    for (int bj = 0; bj < 2; ++bj) {
                        f32x4 v0 = acc[ai][bj][m][0] * ri + bv[bj][0], v1 = acc[ai][bj][m][1] * ri + bv[bj][1];
                        if (isq || bj == 0) {
                            f32x4 p0, p1;
#pragma unroll
                            for (int e = 0; e < 4; ++e) { p0[e] = shx(v0[e], fq * 16 + fr, 32); p1[e] = shx(v1[e], fq * 16 + fr, 32); }
                            v0 = v0 * c0 + (p0 * s0) * sgn; v1 = v1 * c1 + (p1 * s1) * sgn;
                        }
                        v0 = v0 * sc; v1 = v1 * sc;
                        u32x4 w; w.x = cvt_pk_bf16(v0[0], v0[1]); w.y = cvt_pk_bf16(v0[2], v0[3]); w.z = cvt_pk_bf16(v1[0], v1[1]); w.w = cvt_pk_bf16(v1[2], v1[3]);
                        *(u32x4*)(rowp + (lo + (unsigned)(bj * 128))) = w;
                    }
                }
        }
    }
};

struct EpiG2 {
    static constexpr bool PERM = true, HOOK = true; static constexpr int NST = 16;
    const bf16_t* P; bf16_t* Mout; int ldm, mcol;
    __device__ __forceinline__ void mid(f32x4 (&acc)[2][2][4][2], const pg8::Unit& u, int wr, int wc, int fr, int fq) const {
        int col8 = u.pn * 256 + wc * 32 + 8 * fq, rbase = u.pm * 256 + wr * 64 + fr;
        asm volatile("" : "+v"(col8), "+v"(rbase));
        u32x4 rr[2][4][2];
#pragma unroll
        for (int ai = 0; ai < 2; ++ai)
#pragma unroll
            for (int m = 0; m < 4; ++m) { const bf16_t* rowp = P + (size_t)(rbase + ai * 128 + m * 16) * NCOL + col8;
#pragma unroll
                for (int bj = 0; bj < 2; ++bj) rr[ai][m][bj] = *(const u32x4*)(rowp + C_GA + bj * 128); }
#pragma unroll
        for (int ai = 0; ai < 2; ++ai)
#pragma unroll
            for (int m = 0; m < 4; ++m)
#pragma unroll
                for (int bj = 0; bj < 2; ++bj)
#pragma unroll
                    for (int w = 0; w < 4; ++w) { acc[ai][bj][m][w >> 1][(w & 1) * 2] *= bf_lo(rr[ai][m][bj][w]); acc[ai][bj][m][w >> 1][(w & 1) * 2 + 1] *= bf_hi(rr[ai][m][bj][w]); }
    }
    __device__ __forceinline__ void operator()(const f32x4 (&acc)[2][2][4][2], const pg8::Unit& u, int wr, int wc, int fr, int fq) const {
        asm volatile("" : "+v"(fr), "+v"(fq));
        const int col8 = u.pn * 256 + wc * 32 + 8 * fq, rbase = u.pm * 256 + wr * 64 + fr;
        u32x4 gb[2][4][2];
#pragma unroll
        for (int ai = 0; ai < 2; ++ai)
#pragma unroll
            for (int m = 0; m < 4; ++m) { const bf16_t* rowp = P + (size_t)(rbase + ai * 128 + m * 16) * NCOL + col8;
#pragma unroll
                for (int bj = 0; bj < 2; ++bj) gb[ai][m][bj] = *(const u32x4*)(rowp + C_GB + bj * 128); }
#pragma unroll
        for (int ai = 0; ai < 2; ++ai)
#pragma unroll
            for (int m = 0; m < 4; ++m) {
                bf16_t* mrow = Mout + (size_t)(rbase + ai * 128 + m * 16) * ldm + mcol + col8;
#pragma unroll
                for (int bj = 0; bj < 2; ++bj) {
                    u32x4 o;
#pragma unroll
                    for (int w = 0; w < 4; ++w)
                        o[w] = cvt_pk_bf16(acc[ai][bj][m][w >> 1][(w & 1) * 2] * bf_lo(gb[ai][m][bj][w]), acc[ai][bj][m][w >> 1][(w & 1) * 2 + 1] * bf_hi(gb[ai][m][bj][w]));
                    *(u32x4*)(mrow + bj * 128) = o;
                }
            }
    }
};

#if RESID_BF16
typedef bf16_t resid_t;
#else
typedef float resid_t;
#endif
struct EpiG3 {
    static constexpr bool PERM = true, HOOK = false;
    const resid_t* xin_lat; const resid_t* xin_ctx; resid_t* xout_lat; resid_t* xout_ctx; const float* gate; const float* nw; bf16_t* xs; float* ssp; LAS unsigned char* ldsc;
    __device__ __forceinline__ void mid(f32x4 (&)[2][2][4][2], const pg8::Unit&, int, int, int, int) const {}
    __device__ __forceinline__ void operator()(f32x4 (&acc)[2][2][4][2], const pg8::Unit& u, int wr, int wc, int fr, int fq) const {
        asm volatile("" : "+v"(fr), "+v"(fq));
        const bool latent = u.pm < 128;
        const int bidx = latent ? (u.pm >> 3) : 16;
        const int col8 = u.pn * 256 + wc * 32 + 8 * fq;
        {
            f32x4 gv[2][2];
#pragma unroll
            for (int bj = 0; bj < 2; ++bj)
#pragma unroll
                for (int n = 0; n < 2; ++n) gv[bj][n] = gate ? *(const f32x4*)(gate + bidx * 3072 + col8 + bj * 128 + n * 4) : (f32x4){0.f, 0.f, 0.f, 0.f};
#pragma unroll
            for (int ai = 0; ai < 2; ++ai)
#pragma unroll
                for (int bj = 0; bj < 2; ++bj)
#pragma unroll
                    for (int m = 0; m < 4; ++m)
#pragma unroll
                        for (int n = 0; n < 2; ++n) acc[ai][bj][m][n] = acc[ai][bj][m][n] * gv[bj][n];
        }
        LAS f32x4* nvl = (LAS f32x4*)(ldsc + LDS_EPI_OFF + (wr * 4 + wc) * 256);
        if (nw) { const int ln = fq * 16 + fr; if (ln < 16) nvl[ln] = *(const f32x4*)(nw + bidx * 1024 + u.pn * 256 + wc * 32 + (ln >> 3) * 128 + ((ln >> 1) & 3) * 8 + (ln & 1) * 4); }
        unsigned lo = (unsigned)((wr * 64 + fr) * DM + col8); asm volatile("" : "+v"(lo));
        const resid_t* xib = latent ? xin_lat + (size_t)u.pm * 256 * DM : xin_ctx + (size_t)(u.pm * 256 - TL) * DM;
        resid_t* xob = latent ? xout_lat + (size_t)u.pm * 256 * DM : xout_ctx + (size_t)(u.pm * 256 - TL) * DM;
        bf16_t* xsb = xs + (size_t)u.pm * 256 * DM;
        float* sspb = ssp + (size_t)u.pm * 256 * 16 + u.pn * 4 + wc;
#if RESID_BF16
#pragma unroll
        for (int ai = 0; ai < 2; ++ai) {
            u32x4 xv[4][2];
#pragma unroll
            for (int m = 0; m < 4; ++m)
#pragma unroll
                for (int bj = 0; bj < 2; ++bj) xv[m][bj] = *(const u32x4*)(xib + (size_t)(ai * 128 + m * 16) * DM + (lo + (unsigned)(bj * 128)));
#pragma unroll
            for (int m = 0; m < 4; ++m) {
#else
#pragma unroll
        for (int ai = 0; ai < 2; ++ai)
#pragma unroll
        for (int mh = 0; mh < 2; ++mh) {
            f32x4 xv[2][2][2];
#pragma unroll
            for (int m2 = 0; m2 < 2; ++m2)
#pragma unroll
                for (int bj = 0; bj < 2; ++bj)
#pragma unroll
                    for (int n = 0; n < 2; ++n) xv[m2][bj][n] = *(const f32x4*)(xib + (size_t)(ai * 128 + (mh * 2 + m2) * 16) * DM + (lo + (unsigned)(bj * 128 + n * 4)));
#pragma unroll
            for (int m2 = 0; m2 < 2; ++m2) { const int m = mh * 2 + m2;
#endif
                resid_t* xo = xob + (size_t)(ai * 128 + m * 16) * DM; bf16_t* xsr = xsb + (size_t)(ai * 128 + m * 16) * DM;
                float q = 0.f;
#pragma unroll
                for (int bj = 0; bj < 2; ++bj) {
                    const unsigned off = lo + (unsigned)(bj * 128);
#if RESID_BF16
                    const u32x4 xr = xv[m][bj];
                    const f32x4 x0 = (f32x4){bf_lo(xr[0]), bf_hi(xr[0]), bf_lo(xr[1]), bf_hi(xr[1])} + acc[ai][bj][m][0];
                    const f32x4 x1 = (f32x4){bf_lo(xr[2]), bf_hi(xr[2]), bf_lo(xr[3]), bf_hi(xr[3])} + acc[ai][bj][m][1];
                    u32x4 w; w.x = cvt_pk_bf16(x0[0], x0[1]); w.y = cvt_pk_bf16(x0[2], x0[3]); w.z = cvt_pk_bf16(x1[0], x1[1]); w.w = cvt_pk_bf16(x1[2], x1[3]);
                    *(u32x4*)(xo + off) = w;
#else
                    const f32x4 x0 = xv[m2][bj][0] + acc[ai][bj][m][0], x1 = xv[m2][bj][1] + acc[ai][bj][m][1];
                    *(f32x4*)(xo + off) = x0; *(f32x4*)(xo + off + 4) = x1;
#endif
                    q += ((x0[0] * x0[0] + x0[1] * x0[1]) + (x0[2] * x0[2] + x0[3] * x0[3])) + ((x1[0] * x1[0] + x1[1] * x1[1]) + (x1[2] * x1[2] + x1[3] * x1[3]));
                    if (nw) { const f32x4 h0 = x0 * nvl[bj * 8 + fq * 2], h1 = x1 * nvl[bj * 8 + fq * 2 + 1];
                        u32x4 ws_; ws_.x = cvt_pk_bf16(h0[0], h0[1]); ws_.y = cvt_pk_bf16(h0[2], h0[3]); ws_.z = cvt_pk_bf16(h1[0], h1[1]); ws_.w = cvt_pk_bf16(h1[2], h1[3]);
                        *(u32x4*)(xsr + off) = ws_; }
                }
                q += shx(q, fq * 16 + fr, 16); q += shx(q, fq * 16 + fr, 32);
                if (fq == 0) sspb[(unsigned)((ai * 128 + wr * 64 + m * 16 + fr) * 16)] = q;
            }
            asm volatile("" ::: "memory");
        }
    }
};

__device__ __forceinline__ s16x4 vtr(const LAS unsigned char* p) { return __builtin_bit_cast(s16x4, __builtin_amdgcn_ds_read_tr16_b64_v4i16((LAS v4i16_t*)p)); }

struct AUnit { int rowQ0, h, kh, qq0, nloc, jlo, kr_loc0, kr_ctx0; };
__device__ __forceinline__ AUnit aunit(int ua, int wave, int nlat) {
    AUnit D;
    if (ua < nlat) { const int b = ua >> 6, rem = ua & 63, qblk = rem >> 2, kh = (rem >> 1) & 1, hp = rem & 1;
        D.h = kh * 4 + hp * 2 + (wave >> 2); D.kh = kh; D.qq0 = (wave & 3) * 32; D.rowQ0 = b * SEQ + qblk * 128 + D.qq0;
        D.jlo = (qblk == 0) ? 2 : 0; D.nloc = ((qblk == 15) ? 4 : 6) - D.jlo; D.kr_loc0 = b * SEQ + qblk * 128 - 128; D.kr_ctx0 = TL + b * CTXL;
    } else { const int uc = ua - nlat, b = uc >> 3, h = uc & 7;
        D.h = h; D.kh = h >> 2; D.qq0 = 0; D.rowQ0 = TL + b * CTXL + wave * 32; D.jlo = 0; D.nloc = 0; D.kr_loc0 = 0; D.kr_ctx0 = TL + b * CTXL; }
    return D;
}
__device__ __forceinline__ void wait_vm_n(int n) {
    switch (n) {
        case 2: asm volatile("s_waitcnt vmcnt(2)" ::: "memory"); break;
        case 8: asm volatile("s_waitcnt vmcnt(8)" ::: "memory"); break;
        case 10: asm volatile("s_waitcnt vmcnt(10)" ::: "memory"); break;
        case 12: asm volatile("s_waitcnt vmcnt(12)" ::: "memory"); break;
        case 14: asm volatile("s_waitcnt vmcnt(14)" ::: "memory"); break;
        case 16: asm volatile("s_waitcnt vmcnt(16)" ::: "memory"); break;
        case 18: asm volatile("s_waitcnt vmcnt(18)" ::: "memory"); break;
        case 20: asm volatile("s_waitcnt vmcnt(20)" ::: "memory"); break;
        case 22: asm volatile("s_waitcnt vmcnt(22)" ::: "memory"); break;
        default: asm volatile("s_waitcnt vmcnt(0)" ::: "memory"); break;
    }
}
__device__ __forceinline__ void attn_phase2(LAS unsigned char* lds, int tid, const bf16_t* P, bf16_t* Oout, int opitch, int ocol, const float* sink, int bx, int G, int nlat, int ntot, int variant = 0) {
    const int lane = tid & 63, r32 = lane & 31, hi = lane >> 5;
    const int wid = __builtin_amdgcn_readfirstlane(tid >> 6);
    if (bx >= ntot) return;
    const size_t kofl = (size_t)lane * NCOL + C_K + wid * 8;
    const size_t vofl = (size_t)(16 * (wid & 3) + (lane >> 2)) * NCOL + C_V + (wid >> 2) * 32 + (lane & 3) * 8;
    int ua_c = bx, ua_s = bx;
    AUnit Dc = aunit(ua_c, wid, nlat), Ds = Dc, Dn = Dc;
    int ts = 0, NTs = Ds.nloc + 4, tc = 0, NTc = NTs, sslot = 0, cslot = 0;
    bf16x8 qr[4], qn[4]; u32x2 zb[8];
#pragma unroll
    for (int i = 0; i < 4; ++i) qn[i] = (bf16x8){0, 0, 0, 0, 0, 0, 0, 0};
#pragma unroll
    for (int i = 0; i < 8; ++i) zb[i] = (u32x2){0u, 0u};
    {   const bf16_t* qp = P + (size_t)(Dc.rowQ0 + r32) * NCOL + C_Q + Dc.h * 64 + hi * 8;
#pragma unroll
        for (int d0 = 0; d0 < 4; ++d0) qr[d0] = *(const bf16x8*)(qp + d0 * 16); }
    int nx = 0;
#define AT2_STAGE_NEXT() do { nx = 0; if (ua_s < ntot) { \
        if (ts == NTs - 1) {     \
            const bf16_t* zp_ = P + (size_t)(Ds.rowQ0 + r32) * NCOL + C_ZB + Ds.h * 64 + 4 * hi; \
            _Pragma("unroll") for (int i_ = 0; i_ < 8; ++i_) zb[i_] = *(const u32x2*)(zp_ + (i_ >> 2) * 32 + (i_ & 3) * 8); \
            nx += 8; \
            if (ua_s + G < ntot) { Dn = aunit(ua_s + G, wid, nlat); const bf16_t* qp_ = P + (size_t)(Dn.rowQ0 + r32) * NCOL + C_Q + Dn.h * 64 + hi * 8; \
                _Pragma("unroll") for (int d0_ = 0; d0_ < 4; ++d0_) qn[d0_] = *(const bf16x8*)(qp_ + d0_ * 16); nx += 4; } } \
        const int kr0_ = (ts < Ds.nloc) ? Ds.kr_loc0 + 64 * (Ds.jlo + ts) : Ds.kr_ctx0 + 64 * (ts - Ds.nloc); const bf16_t* tb_ = P + (size_t)kr0_ * NCOL + Ds.kh * 64; \
        if (variant != 2) { __builtin_amdgcn_global_load_lds((const unsigned*)(tb_ + kofl), (LAS unsigned*)(lds + sslot * 16384 + wid * 1024), 16, 0, 0); \
        __builtin_amdgcn_global_load_lds((const unsigned*)(tb_ + vofl), (LAS unsigned*)(lds + sslot * 16384 + 8192 + wid * 1024), 16, 0, 0); \
        nx += 2; } sslot = (sslot == 2) ? 0 : sslot + 1; ++ts; \
        if (ts == NTs) { ua_s += G; if (ua_s < ntot) { Ds = Dn; ts = 0; NTs = Ds.nloc + 4; } } } } while (0)
    AT2_STAGE_NEXT(); AT2_STAGE_NEXT();
    asm volatile("s_waitcnt vmcnt(2)" ::: "memory"); __builtin_amdgcn_s_barrier(); asm volatile("" ::: "memory");
    f32x16 o0, o1;
#pragma unroll
    for (int i = 0; i < 16; ++i) { o0[i] = 0.f; o1[i] = 0.f; }
    float mrun = sink[Dc.h] * LOG2E, lrun = hi ? 0.f : 1.f;
    int nst = 0;
    for (;;) {
        AT2_STAGE_NEXT();
        const bool local = tc < Dc.nloc; const int j = Dc.jlo + tc;
        const bool need = (variant != 1) && (!local || !((j == 0 && Dc.qq0 >= 64) || (j == 5 && Dc.qq0 < 64)));
        if (need) {
            const int qq = Dc.qq0 + r32;
            const LAS unsigned char* kb = lds + cslot * 16384 + hi * 1024 + r32 * 16;
            f32x16 p0, p1;
#pragma unroll
            for (int i = 0; i < 16; ++i) { p0[i] = 0.f; p1[i] = 0.f; }
#pragma unroll
            for (int d0 = 0; d0 < 4; ++d0) {
                const bf16x8 b0 = *(const LAS bf16x8*)(kb + d0 * 2048);
                const bf16x8 b1 = *(const LAS bf16x8*)(kb + d0 * 2048 + 512);
                p0 = __builtin_amdgcn_mfma_f32_32x32x16_bf16(b0, qr[d0], p0, 0, 0, 0);
                p1 = __builtin_amdgcn_mfma_f32_32x32x16_bf16(b1, qr[d0], p1, 0, 0, 0);
            }
            if (local) {
                if (j < 2) { const int lim = qq - 64 * j;
#pragma unroll
                    for (int i = 0; i < 16; ++i) { const int kk = (i & 3) + 8 * (i >> 2) + 4 * hi; if (kk < lim) p0[i] = -1e30f; if (kk + 32 < lim) p1[i] = -1e30f; }
                } else if (j >= 4) { const int lim = qq - 64 * (j - 4);
#pragma unroll
                    for (int i = 0; i < 16; ++i) { const int kk = (i & 3) + 8 * (i >> 2) + 4 * hi; if (kk > lim) p0[i] = -1e30f; if (kk + 32 > lim) p1[i] = -1e30f; }
                }
            }
            float rm = fmaxf(p0[0], p1[0]);
#pragma unroll
            for (int i = 1; i < 16; ++i) rm = fmaxf(rm, fmaxf(p0[i], p1[i]));
            rm = fmaxf(rm, shx(rm, lane, 32));
            const float mn = fmaxf(mrun, rm);
            if (__any(mn > mrun)) {
                const float f = __builtin_amdgcn_exp2f(mrun - mn);
                lrun *= f;
#pragma unroll
                for (int i = 0; i < 16; ++i) { o0[i] *= f; o1[i] *= f; }
                mrun = mn;
            }
            float ps = 0.f;
#pragma unroll
            for (int i = 0; i < 16; ++i) { p0[i] = __builtin_amdgcn_exp2f(p0[i] - mrun); p1[i] = __builtin_amdgcn_exp2f(p1[i] - mrun); ps += p0[i] + p1[i]; }
            lrun += ps;
            u32x4 pw[4];
#pragma unroll
            for (int w = 0; w < 4; ++w) { pw[0][w] = cvt_pk_bf16(p0[2 * w], p0[2 * w + 1]); pw[1][w] = cvt_pk_bf16(p0[8 + 2 * w], p0[8 + 2 * w + 1]);
                pw[2][w] = cvt_pk_bf16(p1[2 * w], p1[2 * w + 1]); pw[3][w] = cvt_pk_bf16(p1[8 + 2 * w], p1[8 + 2 * w + 1]); }
            const LAS unsigned char* vp = lds + cslot * 16384 + 8192 + ((lane >> 4) & 1) * 32 + (lane & 3) * 8 + (4 * hi + ((lane & 15) >> 2)) * 64;
#pragma unroll
            for (int s = 0; s < 4; ++s) {
                const s16x4 l0 = vtr(vp + s * 1024), h0 = vtr(vp + s * 1024 + 512);
                const s16x4 l1 = vtr(vp + 4096 + s * 1024), h1 = vtr(vp + 4096 + s * 1024 + 512);
                const bf16x8 v0 = (bf16x8){l0[0], l0[1], l0[2], l0[3], h0[0], h0[1], h0[2], h0[3]};
                const bf16x8 v1 = (bf16x8){l1[0], l1[1], l1[2], l1[3], h1[0], h1[1], h1[2], h1[3]};
                const bf16x8 pa = __builtin_bit_cast(bf16x8, pw[s]);
                o0 = __builtin_amdgcn_mfma_f32_32x32x16_bf16(v0, pa, o0, 0, 0, 0);
                o1 = __builtin_amdgcn_mfma_f32_32x32x16_bf16(v1, pa, o1, 0, 0, 0);
            }
        }
        wait_vm_n(nx + nst); nst = 0;
        asm volatile("s_waitcnt lgkmcnt(0)" ::: "memory"); __builtin_amdgcn_s_barrier(); asm volatile("" ::: "memory");
        cslot = (cslot == 2) ? 0 : cslot + 1; ++tc;
        if (tc == NTc) {
            lrun += shx(lrun, lane, 32);
            const float inv = 1.0f / lrun;
            bf16_t* oo = Oout + (size_t)(Dc.rowQ0 + r32) * opitch + ocol + Dc.h * 64 + 4 * hi;
#pragma unroll
            for (int d0 = 0; d0 < 2; ++d0)
#pragma unroll
                for (int gq = 0; gq < 4; ++gq) {
                    const u32x2 z = zb[d0 * 4 + gq];
                    const float a0 = (d0 ? o1[4 * gq + 0] : o0[4 * gq + 0]) * inv * siluf_(bf_lo(z.x));
                    const float a1 = (d0 ? o1[4 * gq + 1] : o0[4 * gq + 1]) * inv * siluf_(bf_hi(z.x));
                    const float a2 = (d0 ? o1[4 * gq + 2] : o0[4 * gq + 2]) * inv * siluf_(bf_lo(z.y));
                    const float a3 = (d0 ? o1[4 * gq + 3] : o0[4 * gq + 3]) * inv * siluf_(bf_hi(z.y));
                    u32x2 w; w.x = cvt_pk_bf16(a0, a1); w.y = cvt_pk_bf16(a2, a3);
                    *(u32x2*)(oo + d0 * 32 + gq * 8) = w;
                }
            nst = 8;
            ua_c += G; if (ua_c >= ntot) break;
            Dc = aunit(ua_c, wid, nlat); tc = 0; NTc = Dc.nloc + 4;
#pragma unroll
            for (int d0 = 0; d0 < 4; ++d0) qr[d0] = qn[d0];
#pragma unroll
            for (int i = 0; i < 16; ++i) { o0[i] = 0.f; o1[i] = 0.f; }
            mrun = sink[Dc.h] * LOG2E; lrun = hi ? 0.f : 1.f;
        }
    }
#undef AT2_STAGE_NEXT
    asm volatile("s_waitcnt vmcnt(0) lgkmcnt(0)" ::: "memory"); __builtin_amdgcn_s_barrier(); asm volatile("" ::: "memory");
}

namespace at3 {
constexpr int NSLOT = 3, SLOTB = 8192;
constexpr int LDS_K = 0, LDS_V = NSLOT * SLOTB, LDS_WS = 2 * NSLOT * SLOTB, LDS_OST = LDS_WS + 8 * 64 * 4, LDS_TOTAL = LDS_OST + 8 * 4096;
__device__ __forceinline__ int crow(int r, int hi) { return (r & 3) + 8 * (r >> 2) + 4 * hi; }
#define SBAR() __builtin_amdgcn_sched_barrier(0)
__device__ __forceinline__ void glds16(const void* sbase, unsigned voff, unsigned lds_dst) { unsigned keep;
    asm volatile("s_mov_b32 %0, m0\n\ts_mov_b32 m0, %3\n\ts_nop 4\n\tglobal_load_lds_dwordx4 %1, %2\n\ts_mov_b32 m0, %0" : "=&s"(keep) : "v"(voff), "s"(sbase), "s"(lds_dst) : "memory"); }
__device__ __forceinline__ float max3f(float a, float b, float c) { float r; asm("v_max3_f32 %0, %1, %2, %3" : "=v"(r) : "v"(a), "v"(b), "v"(c)); return r; }
__device__ __forceinline__ float max2f(float a, float b) { float r; asm("v_max_f32_e32 %0, %1, %2" : "=v"(r) : "v"(a), "v"(b)); return r; }
__device__ __forceinline__ float fadd_s(float a, float b) { float r; asm("v_add_f32_e32 %0, %1, %2" : "=v"(r) : "v"(a), "v"(b)); return r; }
__device__ __forceinline__ float fsub_s(float a, float b) { float r; asm("v_sub_f32_e32 %0, %1, %2" : "=v"(r) : "v"(a), "v"(b)); return r; }
typedef float f32x2_t __attribute__((ext_vector_type(2))); typedef __bf16 bf16x2_t __attribute__((ext_vector_type(2)));
__device__ __forceinline__ unsigned cvtpk_s(float lo, float hi) { f32x2_t v = {lo, hi}; bf16x2_t b = __builtin_convertvector(v, bf16x2_t); return __builtin_bit_cast(unsigned, b); }
#define WAIT_BAR(N) asm volatile("s_waitcnt vmcnt(" #N ") lgkmcnt(0)\n\ts_barrier" ::: "memory")
typedef const LAS char* lds_cptr;
__device__ __forceinline__ void qkt(f32x16& p0, f32x16& p1, lds_cptr Kslot, const bf16x8* qr, int r32, int hi) {
    const f32x16 negm = f32x16{};
    lds_cptr kb = Kslot + hi * 1024 + r32 * 16;
#pragma unroll
    for (int d0 = 0; d0 < 4; ++d0) {
        const bf16x8 b0 = *(const LAS bf16x8*)(kb + d0 * 2048);
        const bf16x8 b1 = *(const LAS bf16x8*)(kb + d0 * 2048 + 512);
        if (d0 == 0) { p0 = __builtin_amdgcn_mfma_f32_32x32x16_bf16(b0, qr[0], negm, 0, 0, 0); p1 = __builtin_amdgcn_mfma_f32_32x32x16_bf16(b1, qr[0], negm, 0, 0, 0); }
        else { p0 = __builtin_amdgcn_mfma_f32_32x32x16_bf16(b0, qr[d0], p0, 0, 0, 0); p1 = __builtin_amdgcn_mfma_f32_32x32x16_bf16(b1, qr[d0], p1, 0, 0, 0); } }
}
__device__ __forceinline__ void kload8(bf16x8* kf, lds_cptr kp) {
    kf[0] = *(const LAS bf16x8*)(kp);        kf[1] = *(const LAS bf16x8*)(kp + 512);
    kf[2] = *(const LAS bf16x8*)(kp + 2048); kf[3] = *(const LAS bf16x8*)(kp + 2560);
    kf[4] = *(const LAS bf16x8*)(kp + 4096); kf[5] = *(const LAS bf16x8*)(kp + 4608);
    kf[6] = *(const LAS bf16x8*)(kp + 6144); kf[7] = *(const LAS bf16x8*)(kp + 6656);
}
__device__ __forceinline__ void kload2(bf16x8* kf, lds_cptr kp, int j) { kf[2 * j] = *(const LAS bf16x8*)(kp + j * 2048); kf[2 * j + 1] = *(const LAS bf16x8*)(kp + j * 2048 + 512); }
__device__ __forceinline__ s16x4 vtr3(lds_cptr p) { return __builtin_bit_cast(s16x4, __builtin_amdgcn_ds_read_tr16_b64_v4i16((LAS v4i16_t*)p)); }
__device__ __forceinline__ float rowmax(const f32x16& p0, const f32x16& p1) {
    float a = max3f(p0[0], p0[1], p1[0]), b = max3f(p0[2], p0[3], p1[1]); a = max3f(a, p1[2], p1[3]);
#pragma unroll
    for (int r = 4; r < 16; r += 4) { a = max3f(a, p0[r], p0[r + 1]); b = max3f(b, p0[r + 2], p0[r + 3]); a = max3f(a, p1[r], p1[r + 1]); b = max3f(b, p1[r + 2], p1[r + 3]); }
    const float m = max2f(a, b);
    auto rr = __builtin_amdgcn_permlane32_swap(__float_as_uint(m), __float_as_uint(m), false, false);
    return max2f(__uint_as_float(rr[0]), __uint_as_float(rr[1]));
}
__device__ __forceinline__ void pv(f32x16* o, int vb, bf16x8 pa0, bf16x8 pa1, bf16x8 pa2, bf16x8 pa3) {
#pragma unroll
    for (int d0 = 0; d0 < 2; ++d0) { s16x4 lo[4], hi[4];
#pragma unroll
        for (int ks = 0; ks < 4; ++ks) {
            asm volatile("ds_read_b64_tr_b16 %0,%1 offset:%c2" : "=&v"(lo[ks]) : "v"(vb), "i"(d0 * 4096 + ks * 1024) : "memory");
            asm volatile("ds_read_b64_tr_b16 %0,%1 offset:%c2" : "=&v"(hi[ks]) : "v"(vb), "i"(d0 * 4096 + ks * 1024 + 512) : "memory"); }
        asm volatile("s_waitcnt lgkmcnt(0)" ::: "memory"); SBAR();
#define PK(k) (bf16x8){lo[k][0], lo[k][1], lo[k][2], lo[k][3], hi[k][0], hi[k][1], hi[k][2], hi[k][3]}
        o[d0] = __builtin_amdgcn_mfma_f32_32x32x16_bf16(pa0, PK(0), o[d0], 0, 0, 0);
        o[d0] = __builtin_amdgcn_mfma_f32_32x32x16_bf16(pa1, PK(1), o[d0], 0, 0, 0);
        o[d0] = __builtin_amdgcn_mfma_f32_32x32x16_bf16(pa2, PK(2), o[d0], 0, 0, 0);
        o[d0] = __builtin_amdgcn_mfma_f32_32x32x16_bf16(pa3, PK(3), o[d0], 0, 0, 0);
#undef PK
    }
}
__device__ __forceinline__ void wmask(f32x16& p0, f32x16& p1, int j, int qq, int hi) {
    const float NEG = -INFINITY;
    if (j < 2) { const int lim = qq - 64 * j;
#pragma unroll
        for (int r = 0; r < 16; ++r) { const int kk = (r & 3) + 8 * (r >> 2) + 4 * hi; if (kk < lim) p0[r] = NEG; if (kk + 32 < lim) p1[r] = NEG; }
    } else if (j >= 4) { const int lim = qq - 64 * (j - 4);
#pragma unroll
        for (int r = 0; r < 16; ++r) { const int kk = (r & 3) + 8 * (r >> 2) + 4 * hi; if (kk > lim) p0[r] = NEG; if (kk + 32 > lim) p1[r] = NEG; }
    }
}
template <int THRL> __device__ __forceinline__ void attn_unit(int tid_in, LAS unsigned char* shm3u, const bf16_t* P, bf16_t* Oout, int opitch, int ocol, int rowQ0, int h, int kh, int qq0, int nloc, int jlo, int kr_loc0, int kr_ctx0, float sink_l2, int pvar = 0) {
    int tid = tid_in; asm volatile("" : "+v"(tid));
    const int lane = tid & 63, r32 = lane & 31, hi = lane >> 5; const int wid = __builtin_amdgcn_readfirstlane(tid >> 6);
    const lds_cptr shm3 = (lds_cptr)shm3u;
    const unsigned lds0 = (unsigned)(uintptr_t)shm3u;
    LAS float* wsf = (LAS float*)(shm3u + LDS_WS) + wid * 64;
    const bf16_t* Qw = P + (size_t)rowQ0 * NCOL + C_Q + h * 64;
    const unsigned koffb = (unsigned)(lane * NCOL + C_K + kh * 64 + wid * 8) * 2u;
    const unsigned voffb = (unsigned)((16 * (wid & 3) + (lane >> 2)) * NCOL + C_V + kh * 64 + (wid >> 2) * 32 + (lane & 3) * 8) * 2u;
    const unsigned kdst = lds0 + LDS_K + wid * 1024, vdst = lds0 + LDS_V + wid * 1024;
#define KROW(t) (((t) < nloc) ? kr_loc0 + 64 * (jlo + (t)) : (pvar == 9 ? kr_loc0 + 64 * (jlo + ((t) - nloc)) : kr_ctx0 + 64 * ((t) - nloc)))
#define DMA_K(t, slot) glds16(P + (size_t)KROW(t) * NCOL, koffb, (unsigned)__builtin_amdgcn_readfirstlane(kdst + (slot)))
#define DMA_V(t, slot) glds16(P + (size_t)KROW(t) * NCOL, voffb, (unsigned)__builtin_amdgcn_readfirstlane(vdst + (slot)))
    bf16x8 kf[8];
    const lds_cptr kp0 = shm3 + LDS_K + hi * 1024 + r32 * 16; const lds_cptr vp0 = shm3 + LDS_V + ((lane >> 4) & 1) * 32 + (lane & 3) * 8 + (4 * hi + ((lane & 15) >> 2)) * 64;
    const int NT = (pvar == 2 && nloc > 0) ? nloc + 2 : (pvar == 3 && nloc > 0) ? nloc : nloc + 4;
    DMA_K(0, 0); DMA_V(0, 0); DMA_K(1, SLOTB);
    bf16x8 qr[4];
#pragma unroll
    for (int d0 = 0; d0 < 4; ++d0) qr[d0] = *reinterpret_cast<const bf16x8*>(&Qw[(size_t)r32 * NCOL + d0 * 16 + hi * 8]);
    const lds_cptr qls = shm3 + LDS_OST + wid * 4096 + lane * 16;
#pragma unroll
    for (int d0 = 0; d0 < 4; ++d0) *(LAS bf16x8*)(shm3u + LDS_OST + wid * 4096 + lane * 16 + d0 * 1024) = qr[d0];
#define QLD(d) (*(const LAS bf16x8*)(qls + (d) * 1024))
    float mhat = 0.f, l_reg = 0.f; f32x16 o[2]; o[0] = f32x16{}; o[1] = f32x16{};
    const int qrel = qq0 + r32;
#define CMASK(P0, P1, t) do { if ((t) < nloc && pvar != 1) wmask(P0, P1, jlo + (t), qrel, hi); } while (0)
    bool resc = false;
#define START(P0, P1) do { const float rm = max2f(rowmax(P0, P1), sink_l2); resc = false; \
    { const float dl = rm; mhat = fadd_s(mhat, dl); \
      _Pragma("unroll") for (int r = 0; r < 16; ++r) { P0[r] = fsub_s(P0[r], dl); P1[r] = fsub_s(P1[r], dl); } } \
    l_reg = hi ? 0.f : __builtin_amdgcn_exp2f(sink_l2 - mhat); \
    _Pragma("unroll") for (int r = 0; r < 16; ++r) P0[r] = __builtin_amdgcn_exp2f(P0[r]); } while (0)
#define RESC() do { if (resc) { asm volatile("s_waitcnt lgkmcnt(0)" ::: "memory"); \
      _Pragma("unroll") for (int r = 0; r < 16; ++r) { const float f_ = wsf[crow(r, hi)]; o[0][r] *= f_; o[1][r] *= f_; if ((r & 3) == 3) asm volatile("" ::: "memory"); } } } while (0)
    f32x16 pA0, pA1, pB0, pB1;
    int sl_prev = 0, sl_cur = 0, sl_next = SLOTB;
#define ROT() do { sl_prev = sl_cur; sl_cur = sl_next; sl_next = (sl_next == (NSLOT - 1) * SLOTB) ? 0 : sl_next + SLOTB; } while (0)
    DMA_K(2, 2 * SLOTB);
    WAIT_BAR(3);
    qkt(pA0, pA1, shm3 + LDS_K, qr, r32, hi); asm volatile("s_nop 15\n\ts_nop 7" : "+v"(pA0), "+v"(pA1)); CMASK(pA0, pA1, 0);
    START(pA0, pA1);
    _Pragma("unroll") for (int r = 0; r < 16; ++r) pA1[r] = __builtin_amdgcn_exp2f(pA1[r]);
    WAIT_BAR(0);
    DMA_K(3, 0); DMA_V(1, SLOTB);
    ROT();
    kload8(kf, kp0 + sl_cur);
    WAIT_BAR(2);
    s16x4 vlo[8], vhi[8]; u32x4 pw0, pw1, pw2, pw3;
#define PKW(P, B) cvtpk_s(P[B], P[B + 1])
#define PAF(k) __builtin_bit_cast(bf16x8, pw##k)
#define VFR(i) (bf16x8){vlo[i][0], vlo[i][1], vlo[i][2], vlo[i][3], vhi[i][0], vhi[i][1], vhi[i][2], vhi[i][3]}
#define PIN(x) asm volatile("" : "+v"(x))
#define MX3(a, b, c) __builtin_fmaxf(__builtin_fmaxf((a), (b)), (c))
#define GAPA(MF, A0, A1, A2, A3, W0, W1, PW) do { MF; sacc += A0; sacc += A1; sacc += A2; sacc += A3; PIN(sacc); W0; W1; PIN(PW); SBAR(); } while (0)
#define EX(v) ((pvar == 6 || pvar == 8) ? (v) : __builtin_amdgcn_exp2f(v))
#define GAPB(MF, X, B) do { MF; X[B] = EX(X[B] - mhat); X[B + 1] = EX(X[B + 1] - mhat); X[B + 2] = EX(X[B + 2] - mhat); X[B + 3] = EX(X[B + 3] - mhat); PIN(X); SBAR(); } while (0)
#define VRD(i) do { vlo[i] = vtr3(vp_ + (((i) >> 2) * 4096 + ((i) & 3) * 1024)); vhi[i] = vtr3(vp_ + (((i) >> 2) * 4096 + ((i) & 3) * 1024 + 512)); } while (0)
#define KRD(G, j) do { if (G) { kload2(kf, kp0 + sl_next, j); SBAR(); } } while (0)
#define MF3(A_, B_, C_) ((pvar == 7) ? (C_) : __builtin_amdgcn_mfma_f32_32x32x16_bf16(A_, B_, C_, 0, 0, 0))
#define STEP(C0, C1, P0, P1, t, GK, GV, GL) do { SBAR(); \
    const lds_cptr vp_ = vp0 + sl_prev; const f32x16 zero16 = f32x16{}; \
    const bf16x8 qd0 = QLD(0), qd1 = QLD(1); VRD(0); SBAR(); float sacc = (P0[0] + P0[1]); \
    GAPA(C0 = MF3(kf[0], qd0, zero16), P0[2], P0[3], P0[4], P0[5],     pw0[0] = PKW(P0, 0), pw0[1] = PKW(P0, 2), pw0); \
    VRD(4); SBAR(); GAPA(C1 = MF3(kf[1], qd0, zero16), P0[6], P0[7], P0[8], P0[9],     pw0[2] = PKW(P0, 4), pw0[3] = PKW(P0, 6), pw0); \
    const bf16x8 qd2 = QLD(2), qd3 = QLD(3); VRD(1); SBAR(); GAPA(C0 = MF3(kf[2], qd1, C0),   P0[10], P0[11], P0[12], P0[13], pw1[0] = PKW(P0, 8), pw1[1] = PKW(P0, 10), pw1); \
    VRD(5); SBAR(); GAPA(C1 = MF3(kf[3], qd1, C1),   P0[14], P0[15], P1[0], P1[1],   pw1[2] = PKW(P0, 12), pw1[3] = PKW(P0, 14), pw1); \
    VRD(2); SBAR(); GAPA(C0 = MF3(kf[4], qd2, C0),   P1[2], P1[3], P1[4], P1[5],     pw2[0] = PKW(P1, 0), pw2[1] = PKW(P1, 2), pw2); \
    VRD(6); SBAR(); GAPA(C1 = MF3(kf[5], qd2, C1),   P1[6], P1[7], P1[8], P1[9],     pw2[2] = PKW(P1, 4), pw2[3] = PKW(P1, 6), pw2); \
    VRD(3); SBAR(); GAPA(C0 = MF3(kf[6], qd3, C0),   P1[10], P1[11], P1[12], P1[13], pw3[0] = PKW(P1, 8), pw3[1] = PKW(P1, 10), pw3); \
    VRD(7); SBAR(); GAPA(C1 = MF3(kf[7], qd3, C1),   P1[14], P1[15], 0.f, 0.f,       pw3[2] = PKW(P1, 12), pw3[3] = PKW(P1, 14), pw3); \
    l_reg += sacc; \
    if (pvar != 5) { if (GK) { DMA_K((t) + 3, sl_cur); } if (GV) { DMA_V((t) + 1, sl_next); } } \
    CMASK(C0, C1, t); \
    if (pvar != 8) { float a = MX3(C0[0], C0[1], C1[0]), b = MX3(C0[2], C0[3], C1[1]); a = MX3(a, C1[2], C1[3]); \
      _Pragma("unroll") for (int r = 4; r < 16; r += 4) { a = MX3(a, C0[r], C0[r + 1]); b = MX3(b, C0[r + 2], C0[r + 3]); a = MX3(a, C1[r], C1[r + 1]); b = MX3(b, C1[r + 2], C1[r + 3]); } \
      float rm = __builtin_fmaxf(a, b); { auto rr = __builtin_amdgcn_permlane32_swap(__float_as_uint(rm), __float_as_uint(rm), false, false); rm = __builtin_fmaxf(__uint_as_float(rr[0]), __uint_as_float(rr[1])); } \
      resc = false; rm -= mhat; \
      if (__builtin_expect(__any(rm > (float)THRL), 0)) { const float dl = __builtin_fmaxf(rm, 0.f); mhat += dl; \
        const float f = __builtin_amdgcn_exp2f(-dl); l_reg *= f; if (hi == 0) wsf[r32] = f; resc = true; } } \
    SBAR(); \
    GAPB(o[0] = MF3(PAF(0), VFR(0), o[0]), C0, 0); \
    GAPB(o[1] = MF3(PAF(0), VFR(4), o[1]), C0, 4); \
    KRD(GL, 0); GAPB(o[0] = MF3(PAF(1), VFR(1), o[0]), C0, 8); \
    KRD(GL, 1); GAPB(o[1] = MF3(PAF(1), VFR(5), o[1]), C0, 12); \
    KRD(GL, 2); GAPB(o[0] = MF3(PAF(2), VFR(2), o[0]), C1, 0); \
    KRD(GL, 3); GAPB(o[1] = MF3(PAF(2), VFR(6), o[1]), C1, 4); \
    GAPB(o[0] = MF3(PAF(3), VFR(3), o[0]), C1, 8); \
    GAPB(o[1] = MF3(PAF(3), VFR(7), o[1]), C1, 12); \
    } while (0)
    int t = 1;
#define ENDW(tt) do { if (pvar == 4) { asm volatile("s_waitcnt vmcnt(0) lgkmcnt(0)" ::: "memory"); } else if ((tt) + 3 < NT) { WAIT_BAR(2); } else if ((tt) + 2 < NT) { WAIT_BAR(1); } else { WAIT_BAR(0); } } while (0)
    for (; t + 1 < NT; t += 2) {
        STEP(pB0, pB1, pA0, pA1, t, (t + 3 < NT), (t + 1 < NT), (t + 1 < NT));       ENDW(t);     RESC(); ROT();
        STEP(pA0, pA1, pB0, pB1, t + 1, (t + 4 < NT), (t + 2 < NT), (t + 2 < NT));   ENDW(t + 1); RESC(); ROT();
    }
    STEP(pB0, pB1, pA0, pA1, NT - 1, false, false, false); RESC();
    { float sacc = pB0[0] + pB0[1]; _Pragma("unroll") for (int r = 2; r < 16; ++r) sacc += pB0[r]; _Pragma("unroll") for (int r = 0; r < 16; ++r) sacc += pB1[r]; l_reg += sacc;
      pw0 = (u32x4){PKW(pB0, 0), PKW(pB0, 2), PKW(pB0, 4), PKW(pB0, 6)}; pw1 = (u32x4){PKW(pB0, 8), PKW(pB0, 10), PKW(pB0, 12), PKW(pB0, 14)}; pw2 = (u32x4){PKW(pB1, 0), PKW(pB1, 2), PKW(pB1, 4), PKW(pB1, 6)}; pw3 = (u32x4){PKW(pB1, 8), PKW(pB1, 10), PKW(pB1, 12), PKW(pB1, 14)};
      SBAR(); int ln2 = lane_id_(); asm volatile("" : "+v"(ln2)); const int hi2 = ln2 >> 5;
      const int vb0 = (int)(lds0 + LDS_V) + ((ln2 >> 4) & 1) * 32 + (ln2 & 3) * 8 + (4 * hi2 + ((ln2 & 15) >> 2)) * 64;
      pv(o, vb0 + sl_cur, PAF(0), PAF(1), PAF(2), PAF(3)); }
#undef PKW
#undef PAF
#undef VFR
#undef PIN
#undef MX3
#undef GAPA
#undef GAPB
#undef EX
#undef VRD
#undef KRD
#undef STEP
#undef ENDW
    { auto rr = __builtin_amdgcn_permlane32_swap(__float_as_uint(l_reg), __float_as_uint(l_reg), false, false); l_reg = __uint_as_float(rr[0]) + __uint_as_float(rr[1]); }
    int lane_e = lane_id_(); asm volatile("" : "+v"(lane_e));
    const int r32_e = lane_e & 31, hi_e = lane_e >> 5;
    if (hi_e == 0) wsf[32 + r32_e] = l_reg; asm volatile("s_waitcnt lgkmcnt(0)" ::: "memory");
    float rli[16];
#pragma unroll
    for (int r = 0; r < 16; ++r) rli[r] = __builtin_amdgcn_rcpf(wsf[32 + crow(r, hi_e)]);
    {   LAS bf16_t* stg = (LAS bf16_t*)(shm3u + LDS_OST) + wid * 2048;
        u32x4 zv[4];
        const bf16_t* zrow = P + (size_t)rowQ0 * NCOL + C_ZB + h * 64;
#pragma unroll
        for (int i = 0; i < 4; ++i) { const int row = i * 8 + (lane_e >> 3), ch = lane_e & 7; zv[i] = *(const u32x4*)(zrow + (size_t)row * NCOL + ch * 8); }
#pragma unroll
        for (int r = 0; r < 16; ++r) { const int orow = crow(r, hi_e);
#pragma unroll
            for (int d0 = 0; d0 < 2; ++d0) { const unsigned short b = (unsigned short)(cvtpk_s(o[d0][r] * rli[r], 0.f) & 0xffffu); stg[orow * 64 + d0 * 32 + r32_e] = b; } }
        asm volatile("s_waitcnt lgkmcnt(0)" ::: "memory");
        bf16_t* orow_p = Oout + (size_t)rowQ0 * opitch + ocol + h * 64;
#pragma unroll
        for (int i = 0; i < 4; ++i) { const int row = i * 8 + (lane_e >> 3), ch = lane_e & 7; const u32x4 v = *(const LAS u32x4*)(stg + row * 64 + ch * 8);
            u32x4 w;
#pragma unroll
            for (int e = 0; e < 4; ++e) { w[e] = cvt_pk_bf16(bf_lo(v[e]) * siluf_(bf_lo(zv[i][e])), bf_hi(v[e]) * siluf_(bf_hi(zv[i][e]))); }
            *(u32x4*)(orow_p + (size_t)row * opitch + ch * 8) = w; } }
    asm volatile("s_waitcnt lgkmcnt(0)\n\ts_barrier" ::: "memory");
#undef DMA_K
#undef DMA_V
#undef KROW
#undef CMASK
#undef START
#undef RESC
#undef ROT
#undef QLD
}
#undef SBAR
#undef WAIT_BAR
}

__device__ __forceinline__ void conv_run8(const bf16_t* P, bf16_t* Yout, int ypitch, int ycol, const float* cw, int run, int lane) {
    const int row0 = run * 8;
    int s0, s1; if (row0 < TL) { s0 = row0 & ~2047; s1 = s0 + 2048; } else { s0 = TL + ((row0 - TL) & ~255); s1 = s0 + 256; }
    const int c0 = lane * 8;
    const bf16_t* base = P + (size_t)row0 * NCOL + c0;
    u32x4 rc[10], rb[8];
    const u32x4 z4u = (u32x4){0u, 0u, 0u, 0u};
    rc[0] = z4u; rc[9] = z4u;
    if (row0 - 1 >= s0) rc[0] = *(const u32x4*)(base - NCOL + C_CU);
#pragma unroll
    for (int i = 0; i < 8; ++i) { rc[i + 1] = *(const u32x4*)(base + (size_t)i * NCOL + C_CU); rb[i] = *(const u32x4*)(base + (size_t)i * NCOL + C_BZ); }
    if (row0 + 8 < s1) rc[9] = *(const u32x4*)(base + (size_t)8 * NCOL + C_CU);
    const f32x4 w0a = *(const f32x4*)(cw + c0), w0b = *(const f32x4*)(cw + c0 + 4);
    const f32x4 w1a = *(const f32x4*)(cw + 512 + c0), w1b = *(const f32x4*)(cw + 512 + c0 + 4);
    const f32x4 w2a = *(const f32x4*)(cw + 1024 + c0), w2b = *(const f32x4*)(cw + 1024 + c0 + 4);
#define CV_A(q_) ((f32x4){bf_lo((q_)[0]), bf_hi((q_)[0]), bf_lo((q_)[1]), bf_hi((q_)[1])})
#define CV_B(q_) ((f32x4){bf_lo((q_)[2]), bf_hi((q_)[2]), bf_lo((q_)[3]), bf_hi((q_)[3])})
    f32x4 pa = CV_A(rc[0]), pb = CV_B(rc[0]), ca = CV_A(rc[1]), cb = CV_B(rc[1]);
#pragma unroll
    for (int i = 0; i < 8; ++i) {
        const f32x4 na = CV_A(rc[i + 2]), nb = CV_B(rc[i + 2]);
        const f32x4 ya = CV_A(rb[i]) * (w0a * pa + w1a * ca + w2a * na), yb = CV_B(rb[i]) * (w0b * pb + w1b * cb + w2b * nb);
        u32x4 w; w.x = cvt_pk_bf16(ya[0], ya[1]); w.y = cvt_pk_bf16(ya[2], ya[3]); w.z = cvt_pk_bf16(yb[0], yb[1]); w.w = cvt_pk_bf16(yb[2], yb[3]);
        *(u32x4*)(Yout + (size_t)(row0 + i) * ypitch + ycol + c0) = w;
        pa = ca; pb = cb; ca = na; cb = nb;
    }
#undef CV_A
#undef CV_B
}

__device__ __forceinline__ void transpose_item(const float* W, int ldw, bf16_t* WT, int ldo, int koff, int nblk, LAS float* scr, int item, int lane, bool perm = false) {
    const int kb = item / nblk, nb = item % nblk, k0 = 64 * kb, n0 = 32 * nb, n0s = perm ? orig_col(n0) : n0;
#pragma unroll 8
    for (int i = 0; i < 32; ++i) { const int kk = 2 * i + (lane >> 5); scr[kk * 33 + (lane & 31)] = W[(size_t)(k0 + kk) * ldw + n0s + (lane & 31)]; }
    LDS_WAIT(); asm volatile("" ::: "memory");
    const int c = lane & 7;
#pragma unroll
    for (int j = 0; j < 4; ++j) { const int n = (lane >> 3) + 8 * j; const LAS float* s = scr + (8 * c) * 33 + n;
        u32x4 o; o.x = cvt_pk_bf16(s[0 * 33], s[1 * 33]); o.y = cvt_pk_bf16(s[2 * 33], s[3 * 33]); o.z = cvt_pk_bf16(s[4 * 33], s[5 * 33]); o.w = cvt_pk_bf16(s[6 * 33], s[7 * 33]);
        *(u32x4*)(WT + (size_t)(n0 + n) * ldo + koff + k0 + 8 * c) = o; }
    LDS_WAIT(); asm volatile("" ::: "memory");
}

__device__ __forceinline__ void rowmat17_item(int tid, LAS unsigned char* lds, const float* W, int ldw, int col0, const float* bias, float* out, int ldo, int scol0 = -1) {
    if (scol0 < 0) scol0 = col0;
    const int lane = tid & 63, wid = tid >> 6;
    const LAS float* tab = (const LAS float*)lds;
    LAS float* part = (LAS float*)(lds + 17 * 1024 * 4);
    float acc[17];
#pragma unroll
    for (int r = 0; r < 17; ++r) acc[r] = 0.f;
    const float* wp = W + (size_t)(wid * 128) * ldw + scol0 + lane;
    for (int k = 0; k < 128; k += 16) {
        float wv[16];
#pragma unroll
        for (int i = 0; i < 16; ++i) wv[i] = wp[(size_t)(k + i) * ldw];
#pragma unroll
        for (int q = 0; q < 4; ++q)
#pragma unroll
            for (int r = 0; r < 17; ++r) { const f32x4 t = *(const LAS f32x4*)(tab + r * 1024 + wid * 128 + k + 4 * q); acc[r] += (t[0] * wv[4 * q] + t[1] * wv[4 * q + 1]) + (t[2] * wv[4 * q + 2] + t[3] * wv[4 * q + 3]); }
    }
#pragma unroll
    for (int r = 0; r < 17; ++r) part[(wid * 17 + r) * 64 + lane] = acc[r];
    __syncthreads();
    for (int idx = tid; idx < 17 * 64; idx += 512) { const int r = idx >> 6, e = idx & 63; float s = 0.f;
#pragma unroll
        for (int w = 0; w < 8; ++w) s += part[(w * 17 + r) * 64 + e];
        if (bias) s += bias[col0 + e];
        out[(size_t)r * ldo + col0 + e] = s; }
    __syncthreads();
}


#define XB_TMO      128
#define XB_XCNT(j)  (256  + 64 * (j))
#define XB_XSUB(j)  (1280 + 64 * (j))
#define XB_XGEN(j)  (2304 + 64 * (j))
#define XB_TOP      3328
#define XB_TOPGEN   3392
#define XCD_BAR_WORDS 3456
#define XB_SPIN_CAP (1u << 18)
__device__ __forceinline__ unsigned xb_ld(unsigned* p)              { return __hip_atomic_load(p, __ATOMIC_RELAXED, __HIP_MEMORY_SCOPE_AGENT); }
__device__ __forceinline__ unsigned xb_add(unsigned* p, unsigned v) { return __hip_atomic_fetch_add(p, v, __ATOMIC_RELAXED, __HIP_MEMORY_SCOPE_AGENT); }
__device__ __forceinline__ unsigned xb_xcc_id() { return (unsigned)__builtin_amdgcn_s_getreg((3 << 11) | 20) & 0xFu; }
#define XB_SPIN(cond, bar) do { unsigned _sp = 0; while (cond) { __builtin_amdgcn_s_sleep(1); \
    if ((++_sp & 255u) == 0u) { if (xb_ld(&(bar)[XB_TMO])) break; if (_sp > XB_SPIN_CAP) { atomicAdd(&(bar)[XB_TMO], 1u); break; } } } } while (0)
struct XcdBarrier { unsigned* bar; unsigned x; volatile LAS unsigned* st; };
__device__ __forceinline__ XcdBarrier xcd_barrier_post(unsigned* bar, volatile LAS unsigned* st, int tid) {
    XcdBarrier b; b.bar = bar; b.x = xb_xcc_id(); b.st = st;
    if (tid == 0) (void)xb_add(&bar[XB_XCNT(b.x)], 1u);
    return b;
}
__device__ __forceinline__ void xcd_barrier_complete(unsigned* bar, unsigned x, unsigned& nloc, unsigned& nx) {
    const unsigned G = gridDim.x * gridDim.y * gridDim.z;
    unsigned sum, cnt, mine, sp = 0u;
    for (;;) {
        sum = 0u; cnt = 0u; mine = 0u;
#pragma unroll
        for (unsigned j = 0; j < 16; ++j) { const unsigned c = xb_ld(&bar[XB_XCNT(j)]); sum += c; cnt += (c > 0u) ? 1u : 0u; mine = (j == x) ? c : mine; }
        if (sum == G) break;
        __builtin_amdgcn_s_sleep(1);
        if ((++sp & 255u) == 0u) { if (xb_ld(&bar[XB_TMO])) break; if (sp > XB_SPIN_CAP) { atomicAdd(&bar[XB_TMO], 1u); break; } }
    }
    nloc = mine > 0u ? mine : 1u; nx = cnt > 0u ? cnt : 1u;
}
__device__ __forceinline__ void xcd_barrier(const XcdBarrier& b, int tid) {
    asm volatile("s_waitcnt vmcnt(0)" ::: "memory");
    __syncthreads();
    if (tid == 0) {
        unsigned* bar = b.bar;
        __builtin_amdgcn_s_waitcnt(0);
        unsigned nloc = b.st[0], nx = b.st[1];
        if (nloc == 0u) { xcd_barrier_complete(bar, b.x, nloc, nx); b.st[0] = nloc; b.st[1] = nx; }
        const unsigned old = xb_add(&bar[XB_XSUB(b.x)], 1u);
        const unsigned gen = old / nloc;
        if (old + 1u == (gen + 1u) * nloc) {
            __builtin_amdgcn_fence(__ATOMIC_RELEASE, "agent");
            asm volatile("s_waitcnt vmcnt(0)" ::: "memory");
            const unsigned og = xb_add(&bar[XB_TOP], 1u);
            const unsigned tg = og / nx;
            if (og + 1u == (tg + 1u) * nx) xb_add(&bar[XB_TOPGEN], 1u);
            else XB_SPIN(xb_ld(&bar[XB_TOPGEN]) == tg, bar);
            __builtin_amdgcn_fence(__ATOMIC_ACQUIRE, "agent");
            xb_add(&bar[XB_XGEN(b.x)], 1u);
            asm volatile("s_waitcnt vmcnt(0)" ::: "memory");
        } else {
            XB_SPIN(xb_ld(&bar[XB_XGEN(b.x)]) == gen, bar);
            __builtin_amdgcn_fence(__ATOMIC_ACQUIRE, "agent");
            asm volatile("s_waitcnt vmcnt(0)" ::: "memory");
        }
    }
    __syncthreads();
}

__global__ void __launch_bounds__(512, 2) fwd_kernel(Args a) {
    extern __shared__ __attribute__((aligned(16))) unsigned char lds_raw[];
    LAS unsigned char* lds = (LAS unsigned char*)lds_raw;
    unsigned char* ws0 = a.ws;
    volatile LAS unsigned* MISC = (volatile LAS unsigned*)(lds + 131072);
    const int wave0 = __builtin_amdgcn_readfirstlane((int)threadIdx.x >> 6);
#define MYTID() (wave0 * 64 + lane_id_())
    if (MYTID() < 64) MISC[MYTID()] = 0u;
    __syncthreads();
    XcdBarrier xbar; xbar.bar = (unsigned*)(ws0 + WS_CTL); xbar.x = 0; xbar.st = nullptr;
    if (a.coop) xbar = xcd_barrier_post((unsigned*)(ws0 + WS_CTL), MISC + 8, MYTID());

#define PH_PROLOG const __attribute__((address_space(4))) Args* ap = (const __attribute__((address_space(4))) Args*)__builtin_amdgcn_kernarg_segment_ptr(); asm volatile("" : "+s"(ap)); const float* x_in = ap->in[0]; const float* c_in = ap->in[1]; const float* ctx_in = ap->in[2]; const float* cctx_in = ap->in[3]; const float* norm_w = ap->in[4]; const float* w_mod = ap->in[5]; const float* b_mod = ap->in[6]; const float* w_in = ap->in[7]; const float* conv_w = ap->in[8]; const float* w_a_out = ap->in[9]; const float* w_b_out = ap->in[10]; const float* attn_sink = ap->in[11]; const float* w_o = ap->in[12]; const float* fnorm_w = ap->in[13]; unsigned char* ws = ap->ws; bf16_t* WIN_T = (bf16_t*)(ws + WS_WIN_T); bf16_t* WAB_T = (bf16_t*)(ws + WS_WAB_T); bf16_t* WO_T = (bf16_t*)(ws + WS_WO_T); float* MOD = (float*)(ws + WS_MOD); float* NW1 = (float*)(ws + WS_NW1); float* SB = (float*)(ws + WS_SB); float* ROPEC = (float*)(ws + WS_ROPE); float* ROPES = ROPEC + 64 * 16; float* SSP = (float*)(ws + WS_SSP); resid_t* XCTX = (resid_t*)(ws + WS_XCTX); bf16_t* XS = (bf16_t*)(ws + WS_XS); bf16_t* P = (bf16_t*)(ws + WS_P); float* OUT = ap->out; (void)x_in; (void)c_in; (void)ctx_in; (void)cctx_in; (void)norm_w; (void)w_mod; (void)b_mod; (void)w_in; (void)conv_w; (void)w_a_out; (void)w_b_out; (void)attn_sink; (void)w_o; (void)fnorm_w; (void)WIN_T; (void)WAB_T; (void)WO_T; (void)MOD; (void)NW1; (void)SB; (void)ROPEC; (void)ROPES; (void)SSP; (void)XCTX; (void)XS; (void)P; (void)OUT; int tid = MYTID(), bx = blockIdx.x; asm volatile("" : "+v"(tid), "+s"(bx)); const int lane = tid & 63, wave = __builtin_amdgcn_readfirstlane(tid >> 6); const int G = gridDim.x; const int gw = bx * 8 + wave, NGW = G * 8; (void)lane; (void)gw; (void)NGW;
#define DUP_ON(k) ((DUP_MASK >> (k)) & 1)
#if MK_COOP
#define SEAM_SYNC() do { if (a.coop) xcd_barrier(xbar, MYTID()); __syncthreads(); } while (0)
#else
#define SEAM_SYNC() do { } while (0)
#endif
    if (a.ph_lo == 0 && (PHMASK & 1)) { PH_PROLOG
          for (int rep = DUP_ON(0) ? 0 : 1; rep < 2; ++rep) {
            constexpr int NMOD = DEPTH * 48;
            if (bx < NMOD) {
                LAS float* tab = (LAS float*)lds;
#pragma clang loop vectorize(disable) interleave(disable) unroll(disable)
                for (int idx = tid; idx < 17 * 1024; idx += 512) { const int r = idx >> 10, k = idx & 1023; const float v = (r < 16) ? c_in[r * 1024 + k] : cctx_in[k]; tab[idx] = siluf_(v); }
                __syncthreads();
                for (int it = bx; it < NMOD; it += G) { const int l = it / 48, ec = it % 48;
                    rowmat17_item(tid, lds, w_mod + (size_t)l * 1024 * 3072, 3072, ec * 64, b_mod + l * 3072, MOD + (size_t)l * 17 * 3072, 3072); }
            }
            __syncthreads();
            if (bx == G - 1) { for (int idx = tid; idx < 64 * 16; idx += 512) { const int pos = idx >> 4, f = idx & 15; const float invf = powf(10000.0f, -(float)f / 16.0f); const float ang = (float)pos * invf;
                    ROPEC[idx] = cosf(ang); ROPES[idx] = sinf(ang); } }
            LAS float* scr = (LAS float*)(lds + wave * 16384);
            constexpr int I_IN = 16 * 168, I_A = 8 * 32, I_O = 16 * 32;
            constexpr int NITEMS = I_IN + DEPTH * (2 * I_A + I_O);
            for (int it = gw; it < NITEMS; it += NGW) {
                int r = it;
                if (r < I_IN) { transpose_item(w_in, NIN, WIN_T, 1024, 0, 168, scr, r, lane, true); continue; } r -= I_IN;
                const int l = r / (2 * I_A + I_O); r -= l * (2 * I_A + I_O);
                if (r < I_A) { transpose_item(w_a_out + (size_t)l * 512 * 1024, 1024, WAB_T + (size_t)l * 1024 * 1024, 1024, 0, 32, scr, r, lane); continue; } r -= I_A;
                if (r < I_A) { transpose_item(w_b_out + (size_t)l * 512 * 1024, 1024, WAB_T + (size_t)l * 1024 * 1024, 1024, 512, 32, scr, r, lane); continue; } r -= I_A;
                transpose_item(w_o + (size_t)l * 1024 * 1024, 1024, WO_T + (size_t)l * 1024 * 1024, 1024, 0, 32, scr, r, lane);
            }
            if (rep == 0) SEAM_SYNC();
          }
    }
    if (a.ph_lo == 0 && a.ph_hi > 1) {
#if MK_COOP
        if (a.coop) cg::this_grid().sync();
#endif
        __syncthreads();
    }
    for (int ph = (a.ph_lo == 0 ? 1 : a.ph_lo); ph < a.ph_hi; ++ph) {
        if (ph == 1 && (PHMASK & 2)) { PH_PROLOG
          for (int rep = DUP_ON(1) ? 0 : 1; rep < 2; ++rep) {
            constexpr int NSB = DEPTH * 84;
            { int curl = -1;
              for (int it = bx; it < NSB; it += G) { const int l = it / 84, nc = it % 84;
                if (l != curl) { __syncthreads(); LAS float* tab = (LAS float*)lds;
#pragma clang loop vectorize(disable) interleave(disable) unroll(disable)
                    for (int idx = tid; idx < 17 * 1024; idx += 512) { const int r = idx >> 10, k = idx & 1023; tab[idx] = MOD[((size_t)l * 17 + r) * 3072 + k]; }
                    __syncthreads(); curl = l; }
                rowmat17_item(tid, lds, w_in + (size_t)l * 1024 * NIN, NIN, nc * 64, nullptr, SB + (size_t)l * 17 * NIN, NIN, orig_col(nc * 64)); } }
            for (int idx = bx * 512 + tid; idx < DEPTH * 17 * 1024; idx += G * 512) { const int k = idx & 1023, lr = idx >> 10, l = lr / 17;
                NW1[idx] = norm_w[l * 1024 + k] * (1.0f + MOD[(size_t)lr * 3072 + 1024 + k]); }
            for (int row0 = gw * 3; row0 < TT; row0 += NGW * 3) {
                f32x4 v[3][4]; float ss[3];
#pragma unroll
                for (int q = 0; q < 3; ++q) { const int row = row0 + q; const bool lat = row < TL;
                    const f32x4* xr = (const f32x4*)(lat ? x_in + (size_t)row * DM : ctx_in + (size_t)(row - TL) * DM) + lane;
#pragma unroll
                    for (int j = 0; j < 4; ++j) v[q][j] = xr[64 * j]; }
#pragma unroll
                for (int q = 0; q < 3; ++q) { float s_ = 0.f;
#pragma unroll
                    for (int j = 0; j < 4; ++j) s_ += (v[q][j][0] * v[q][j][0] + v[q][j][1] * v[q][j][1]) + (v[q][j][2] * v[q][j][2] + v[q][j][3] * v[q][j][3]);
                    ss[q] = wave_sum(s_, lane); }
#pragma unroll
                for (int q = 0; q < 3; ++q) { const int row = row0 + q; const bool lat = row < TL; const int b = lat ? (row >> 11) : 16;
                    const f32x4* nwp = (const f32x4*)norm_w + lane; const f32x4* scp = (const f32x4*)(MOD + (size_t)b * 3072 + 1024) + lane;
                    u32x2* o8 = (u32x2*)(XS + (size_t)row * DM) + lane;
#if RESID_BF16
                    u32x2* x8 = (u32x2*)(lat ? (bf16_t*)OUT + (size_t)row * DM : XCTX + (size_t)(row - TL) * DM) + lane;
#endif
#pragma unroll
                    for (int j = 0; j < 4; ++j) { const f32x4 hh = v[q][j] * (nwp[64 * j] * (scp[64 * j] + 1.0f)); u32x2 w; w.x = cvt_pk_bf16(hh[0], hh[1]); w.y = cvt_pk_bf16(hh[2], hh[3]); o8[64 * j] = w;
#if RESID_BF16
                        u32x2 wx; wx.x = cvt_pk_bf16(v[q][j][0], v[q][j][1]); wx.y = cvt_pk_bf16(v[q][j][2], v[q][j][3]); x8[64 * j] = wx;
#endif
                    }
                    if (lane < 16) SSP[(size_t)row * 16 + lane] = (lane == 0) ? ss[q] : 0.f; }
            }
            if (rep == 0) SEAM_SYNC();
          }
        } else if (ph == NPHASE - 1 && (PHMASK & 4)) { PH_PROLOG
            for (int row = gw; row < TL; row += NGW) {
                float s = SSP[(size_t)row * 16 + (lane & 15)];
                s += shx(s, lane, 1); s += shx(s, lane, 2); s += shx(s, lane, 4); s += shx(s, lane, 8);
                const float rinv = 1.0f / sqrtf(s * (1.0f / 1024.0f) + RMS_EPS);
                f32x4* xr = (f32x4*)(OUT + (size_t)row * DM) + lane; const f32x4* fw = (const f32x4*)fnorm_w + lane;
#if RESID_BF16
                const u32x2* xb = (const u32x2*)(XS + (size_t)row * DM) + lane;
#pragma unroll
                for (int j = 0; j < 4; ++j) { const u32x2 w = xb[64 * j]; const f32x4 v = (f32x4){bf_lo(w.x), bf_hi(w.x), bf_lo(w.y), bf_hi(w.y)}; xr[64 * j] = v * rinv * fw[64 * j]; }
#else
#pragma unroll
                for (int j = 0; j < 4; ++j) { const f32x4 v = xr[64 * j]; xr[64 * j] = v * rinv * fw[64 * j]; }
#endif
            }
        } else {
            const int l = (ph - 2) >> 2, sub = (ph - 2) & 3;
            const bool lastl = (l == DEPTH - 1);
            if (sub == 0 && (PHMASK & 8)) { PH_PROLOG
                pg8::Gemm g{XS, WIN_T, DM, DM};
                pg8::Order S; if (!lastl) S.init(TT / 256, NIN / 256, G, bx); else S.init(TL / 256, NIN / 256, G, bx, NB, TL / 256, 10);
                { LAS float* rt = (LAS float*)(lds + LDS_ROPE_OFF); for (int idx = tid; idx < 2048; idx += 512) rt[idx] = ROPEC[idx]; __syncthreads(); }
                for (int rep = DUP_ON(3) ? 0 : 1; rep < 2; ++rep) { EpiG1 E{P, SSP, SB + (size_t)l * 17 * NIN, lds, rep == 0 ? PROBE_SKIP : 0};
                    pg8::gemm_phase<EpiG1, pg8::Order, true>(tid, lds, g, S, E, rep == 0 ? (unsigned)(((bx >> 3) & 31) * PROBE_STAGGER) : 0u); if (rep == 0) SEAM_SYNC(); }
            } else if (sub == 1 && (PHMASK & 16)) { PH_PROLOG
                const float* sink = attn_sink + l * 8;
                const int nlat = 1024, nctx = lastl ? 0 : 128;
              for (int rep = DUP_ON(4) ? 0 : 1; rep < 2; ++rep) {
                bf16_t* Oo = rep ? P : XS; const int opitch = rep ? NCOL : 1024, ocol = rep ? C_Q : 512, ycol = rep ? C_BZ : 0;
                if (!(ap->probe && PROBE_AT == 2)) {
#if ATTN_V3
                    const int nsteps = (G == 256) ? (lastl ? 4 : 5) : (nlat + nctx + G - 1) / G;
                    for (int i = 0; i < nsteps; ++i) {
                        int ua;
                        if (G == 256) { const int xg = bx & 7, j = bx >> 3;
                            if (i < 4) ua = (2 * xg + (i >> 1)) * 64 + (i & 1) * 32 + j;
                            else { if (j >= 16) break; ua = nlat + (2 * xg + (j >> 3)) * 8 + (j & 7); } }
                        else { ua = bx + i * G; if (ua >= nlat + nctx) break; }
                        const AUnit D = aunit(ua, wave, nlat);
                        at3::attn_unit<8>(tid, lds, P, Oo, opitch, ocol, D.rowQ0, D.h, D.kh, D.qq0, D.nloc, D.jlo, D.kr_loc0, D.kr_ctx0, sink[D.h] * LOG2E, ap->probe ? PROBE_ATV : 0); }
#else
                    attn_phase2(lds, tid, P, Oo, opitch, ocol, sink, bx, G, nlat, nlat + nctx, rep == 0 ? PROBE_ATV : 0);
#endif
                }
                __syncthreads();
                const int nruns = (lastl ? TL : TT) / 8;
                for (int it = (NGW - 1 - gw); it < nruns && !(ap->probe && PROBE_AT == 1); it += NGW) conv_run8(P, Oo, opitch, ycol, conv_w + (size_t)l * 3 * 512, it, lane);
                if (rep == 0) SEAM_SYNC();
              }
            } else if (sub == 2 && (PHMASK & 32)) { PH_PROLOG
                pg8::Gemm g{P + C_BZ, WAB_T + (size_t)l * 1024 * 1024, NCOL, DM};
                pg8::Order S; S.init((lastl ? TL : TT) / 256, 4, G, bx);
                for (int rep = DUP_ON(5) ? 0 : 1; rep < 2; ++rep) {
                    EpiG2 E{P, rep ? P : XS, rep ? NCOL : 1024, rep ? C_GA : 0};
                    pg8::gemm_phase<EpiG2, pg8::Order, true>(tid, lds, g, S, E); if (rep == 0) SEAM_SYNC(); }
                if (!lastl) {
                    const int tid_t = MYTID(); int bx_t = blockIdx.x; asm volatile("" : "+s"(bx_t));
                    const int lane_t = tid_t & 63, wave_t = __builtin_amdgcn_readfirstlane(tid_t >> 6);
                    const int nunits = (TT / 256) * 4, nfull = nunits % G;
                    const int b0 = (nfull == 0) ? 0 : nfull, nb = G - b0;
                    if (bx_t >= b0) { LAS float* scr = (LAS float*)(lds + wave_t * 16384);
                        for (int it = (bx_t - b0) * 8 + wave_t; it < 16 * 168; it += nb * 8) transpose_item(w_in + (size_t)(l + 1) * 1024 * NIN, NIN, WIN_T, 1024, 0, 168, scr, it, lane_t, true);
                    }
                }
            } else if (PHMASK & 64) { PH_PROLOG
                pg8::Gemm g{P + C_GA, WO_T + (size_t)l * 1024 * 1024, NCOL, DM};
                pg8::Order S; S.init((lastl ? TL : TT) / 256, 4, G, bx);
                for (int rep = DUP_ON(6) ? 0 : 1; rep < 2; ++rep) {
                    #if RESID_BF16
                    EpiG3 E{(const bf16_t*)OUT, XCTX, lastl ? XS : (bf16_t*)OUT, XCTX, MOD + (size_t)l * 17 * 3072 + 2048, lastl ? nullptr : NW1 + (size_t)(l + 1) * 17 * 1024, XS, SSP, lds};
#else
                    EpiG3 E{(l == 0 && !ap->probe) ? x_in : OUT, (l == 0 && !ap->probe) ? ctx_in : XCTX, OUT, XCTX, ap->probe ? nullptr : MOD + (size_t)l * 17 * 3072 + 2048, lastl ? nullptr : NW1 + (size_t)(l + 1) * 17 * 1024, XS, SSP, lds};
#endif
                    pg8::gemm_phase<EpiG3, pg8::Order, true>(tid, lds, g, S, E); if (rep == 0) SEAM_SYNC(); }
            }
        }
        if (ph + 1 < a.ph_hi) {
#if MK_COOP
            if (a.coop) xcd_barrier(xbar, MYTID());
#endif
            __syncthreads();
        }
    }
}

extern "C" void kernel_launch(void* const* d_in, const int* in_sizes, int n_in, void* d_out, int out_size, void* d_ws, size_t ws_size, hipStream_t stream) {
    static int grid = 0;
    if (grid == 0) {
        if (n_in != 14 || in_sizes[0] != TL * DM || out_size != TL * DM || ws_size < WS_END) {
            fprintf(stderr, "kernel_launch: unexpected shapes (n_in %d, in0 %d, out %d, ws %zu need %zu); nothing launched\n", n_in, n_in > 0 ? in_sizes[0] : -1, out_size, ws_size, (size_t)WS_END); grid = -1; return; }
        int dev = 0, cus = 0;
        if (hipGetDevice(&dev) != hipSuccess || hipDeviceGetAttribute(&cus, hipDeviceAttributeMultiprocessorCount, dev) != hipSuccess || cus <= 0) cus = 256;
        if (hipFuncSetAttribute((const void*)fwd_kernel, hipFuncAttributeMaxDynamicSharedMemorySize, LDS_BYTES) != hipSuccess) { fprintf(stderr, "kernel_launch: hipFuncSetAttribute failed\n"); grid = -1; return; }
        int per_cu = 0;
        if (hipOccupancyMaxActiveBlocksPerMultiprocessor(&per_cu, (const void*)fwd_kernel, 512, LDS_BYTES) != hipSuccess || per_cu < 1) { fprintf(stderr, "kernel_launch: occupancy query says %d\n", per_cu); (void)hipGetLastError(); }
        grid = cus;
    }
    if (grid < 0) return;
    Args a{};
    for (int i = 0; i < 14; ++i) a.in[i] = (const float*)d_in[i];
    a.out = (float*)d_out; a.ws = (unsigned char*)d_ws;
#if MK_COOP
    if (hipMemsetAsync((char*)d_ws + WS_CTL, 0, CTL_ZERO_BYTES, stream) != hipSuccess) { fprintf(stderr, "kernel_launch: memset failed\n"); return; }
    a.ph_lo = 0; a.ph_hi = NPHASE; a.coop = 1;
    void* args[] = {&a};
    hipError_t e = hipLaunchCooperativeKernel((const void*)fwd_kernel, dim3(grid), dim3(512), args, LDS_BYTES, stream);
    if (e != hipSuccess) fprintf(stderr, "cooperative launch failed: %s (grid %d)\n", hipGetErrorString(e), grid);
#if PROBE_PHASE >= 0
    { Args b = a; b.ph_lo = PROBE_PHASE; b.ph_hi = PROBE_PHASE + 1; b.coop = 0; b.probe = 1;
      for (int r_ = 0; r_ < PROBE_REPS; ++r_) hipLaunchKernelGGL(fwd_kernel, dim3(grid), dim3(512), LDS_BYTES, stream, b); }
#endif
#else
    for (int ph = 0; ph < NPHASE; ++ph) {
        a.ph_lo = ph; a.ph_hi = ph + 1; a.coop = 0;
        hipLaunchKernelGGL(fwd_kernel, dim3(grid), dim3(512), LDS_BYTES, stream, a);
    }
#endif
}
```

```cpp
#include <hip/hip_runtime.h>
#include <hip/hip_cooperative_groups.h>
#include <cstdio>
#include <cstdint>
namespace cg = cooperative_groups;

#ifndef PHMASK
#define PHMASK 127
#endif
#ifndef PROBE_SKIP
#define PROBE_SKIP 0
#endif
#ifndef PROBE_STAGGER
#define PROBE_STAGGER 0
#endif
#ifndef PROBE_AT
#define PROBE_AT 0
#endif
#ifndef PROBE_ATV
#define PROBE_ATV 0
#endif
#ifndef ATTN_V3
#define ATTN_V3 1
#endif
#ifndef RESID_BF16
#define RESID_BF16 0
#endif
#ifndef PROBE_PHASE
#define PROBE_PHASE -1
#endif
#ifndef PROBE_REPS
#define PROBE_REPS 1
#endif
#ifndef DUP_MASK
#define DUP_MASK 0
#endif
#ifndef MK_COOP
#define MK_COOP 1
#endif

#define LAS __attribute__((address_space(3)))
typedef unsigned short bf16_t;
typedef short bf16x8 __attribute__((ext_vector_type(8)));
typedef short s16x4 __attribute__((ext_vector_type(4)));
typedef short v4i16_t __attribute__((ext_vector_type(4)));
typedef float f32x4 __attribute__((ext_vector_type(4)));
typedef float f32x16 __attribute__((ext_vector_type(16)));
typedef unsigned u32x4 __attribute__((ext_vector_type(4)));
typedef unsigned u32x2 __attribute__((ext_vector_type(2)));

constexpr int DM = 1024, NB = 16, SEQ = 2048, CTXL = 256, DEPTH = 4, NIN = 5376, NCOL = 4352;
constexpr int TL = NB * SEQ, TC = NB * CTXL, TT = TL + TC;
constexpr int C_CU = 0, C_BZ = 512, C_Q = 1024, C_K = 1536, C_V = 1664, C_ZB = 1792, C_GA = 2304, C_GB = 3328;
__host__ __device__ __forceinline__ int orig_col(int c) { const int t = c >> 8, h = (c >> 7) & 1, o = c & 127; return (t < 4) ? (h ? 1024 : 512) + t * 128 + o : (t < 8) ? (h ? 1536 : 0) + (t - 4) * 128 + o : (t < 13) ? c : (h ? 4352 : 3328) + (t - 13) * 128 + o; }
constexpr float RMS_EPS = 1e-6f;
constexpr float LOG2E = 1.4426950408889634f;
constexpr float QSCALE = 0.125f * LOG2E;

constexpr size_t MiB = 1u << 20;
constexpr size_t WS_CTL = 0, CTL_ZERO_BYTES = 65536;
constexpr size_t WS_WIN_T = 446 * MiB;
constexpr size_t WS_WAB_T = 12 * MiB;
constexpr size_t WS_WO_T = 20 * MiB;
constexpr size_t WS_MOD = 28 * MiB;
constexpr size_t WS_NW1 = 29 * MiB;
constexpr size_t WS_SB = 30 * MiB;
constexpr size_t WS_ROPE = 32 * MiB;
constexpr size_t WS_SSP = 440 * MiB;
constexpr int NSS = 32;
constexpr size_t WS_XCTX = 36 * MiB;
constexpr size_t WS_XS = 52 * MiB;
constexpr size_t WS_P = 124 * MiB;
constexpr size_t WS_END = WS_P + (size_t)TT * NCOL * 2;
static_assert(WS_END <= 440 * MiB && WS_SSP + (size_t)TT * NSS * 4 <= 446 * MiB && WS_WIN_T + (size_t)DEPTH * NIN * 1024 * 2 <= 502 * MiB && C_BZ + 512 == C_Q && C_GB + 1024 == NCOL, "ws map / P columns");

constexpr int LDS_RINV_OFF = 131072;
constexpr int LDS_AUX = 149504;
constexpr int LDS_EPI_OFF = LDS_AUX + 1024;
constexpr int LDS_ROPE_OFF = LDS_AUX + 1024 + 2048;
constexpr int LDS_BYTES = LDS_AUX + 1024 + 2048 + 8192;
static_assert(LDS_BYTES <= 163840, "LDS");
constexpr int NPHASE = 2 + 4 * DEPTH + 1;

struct Args { const float* in[14]; float* out; unsigned char* ws; int ph_lo, ph_hi, coop, probe; };

typedef float f32x2_c __attribute__((ext_vector_type(2))); typedef __bf16 bf16x2_c __attribute__((ext_vector_type(2)));
__device__ __forceinline__ unsigned cvt_pk_bf16(float lo, float hi) { f32x2_c v = {lo, hi}; bf16x2_c b = __builtin_convertvector(v, bf16x2_c); return __builtin_bit_cast(unsigned, b); }
__device__ __forceinline__ float bf_lo(unsigned w) { return __uint_as_float(w << 16); }
__device__ __forceinline__ float bf_hi(unsigned w) { return __uint_as_float(w & 0xffff0000u); }
__device__ __forceinline__ float fast_exp(float x) { return __builtin_amdgcn_exp2f(x * LOG2E); }
__device__ __forceinline__ float sigmoidf_(float x) { return __builtin_amdgcn_rcpf(1.0f + fast_exp(-x)); }
__device__ __forceinline__ float siluf_(float x) { return x * sigmoidf_(x); }
__device__ __forceinline__ float shx(float v, int lane, int m) { return __int_as_float(__builtin_amdgcn_ds_bpermute((lane ^ m) << 2, __float_as_int(v))); }
__device__ __forceinline__ float shl_(float v, int src) { return __int_as_float(__builtin_amdgcn_ds_bpermute(src << 2, __float_as_int(v))); }
__device__ __forceinline__ float wave_sum(float v, int lane) {
#pragma unroll
    for (int o = 1; o < 64; o <<= 1) v += shx(v, lane, o);
    return v;
}
__device__ __forceinline__ int lane_id_() { int r; asm volatile("v_mbcnt_lo_u32_b32 %0, -1, 0\n\tv_mbcnt_hi_u32_b32 %0, -1, %0" : "=v"(r)); return r; }
#define LDS_WAIT() asm volatile("s_waitcnt lgkmcnt(0)" ::: "memory")
#define VM_WAIT() asm volatile("s_waitcnt vmcnt(0)" ::: "memory")

namespace pg8 {
constexpr int BM = 256, BK = 64, HALF = 128, HTB = HALF * BK * 2, STAGE_BYTES = 8 * HTB, NXCD = 8, WGM = 8;
__host__ __device__ __forceinline__ int lds_byte(int r, int c) { const int st = (r >> 4) * 2 + (c >> 5), rr = r & 15, cc = c & 31, ob = rr * 64 + cc * 2; return st * 1024 + (ob ^ (((ob >> 9) & 1) << 5)); }
__host__ __device__ __forceinline__ void stage_rc(int b, int& R, int& C) { const int st = b / 1024, sb = b % 1024, swz = sb ^ (((sb >> 9) & 1) << 5); R = (st >> 1) * 16 + swz / 64; C = (st & 1) * 32 + (swz % 64) / 2; }
__host__ __device__ __forceinline__ int perm32(int rho) { const int n = rho >> 4, i = rho & 15; return 8 * (i >> 2) + 4 * n + (i & 3); }

struct Unit { int pm, pn, idx; };
struct Gemm { const bf16_t* A; const bf16_t* Bt; int lda; int K; };

struct Order {
    int nM, nN, nwg, G, c, nextra, extra_pm0, extra_pn;
    __device__ void init(int nM_, int nN_, int G_, int c_, int nextra_ = 0, int epm0 = 0, int epn = 0) { nM = nM_; nN = nN_; nwg = nM * nN; G = G_; c = c_; nextra = nextra_; extra_pm0 = epm0; extra_pn = epn; }
    __device__ bool next(int i, Unit& u) const {
        const int L = i * G + c; if (L >= nwg + nextra) return false;
        if (L >= nwg) { u.pm = extra_pm0 + (L - nwg); u.pn = extra_pn; return true; }
        int wgid = L; { const int q = nwg / NXCD, r = nwg % NXCD, xcd = wgid % NXCD, off = wgid / NXCD; wgid = (xcd < r ? xcd * (q + 1) : r * (q + 1) + (xcd - r) * q) + off; }
        const int nig = WGM * nN, gid = wgid / nig, fm = gid * WGM, gsz = (nM - fm) < WGM ? (nM - fm) : WGM;
        u.pm = fm + ((wgid % nig) % gsz); u.pn = (wgid % nig) / gsz; return true;
    }
};

template <class Epi, class Sched, bool ALIGN_EPI>
__device__ __forceinline__ void gemm_phase(int tid_in, LAS unsigned char* lds, const Gemm g, const Sched& S, const Epi& E, unsigned stagger_ticks = 0) {
    if (stagger_ticks) { const unsigned long long t0_ = __builtin_amdgcn_s_memrealtime(); while (__builtin_amdgcn_s_memrealtime() - t0_ < stagger_ticks) __builtin_amdgcn_s_sleep(8); }
    int tid = tid_in; asm volatile("" : "+v"(tid));
    const int wid = __builtin_amdgcn_readfirstlane(tid >> 6), lane = tid & 63, wr = wid >> 2, wc = wid & 3, fr = lane & 15, fq = lane >> 4;
    const int K = g.K, nt = K / BK, lda = g.lda;
    unsigned voffA[2], voffB[2];
#pragma unroll
    for (int i = 0; i < 2; ++i) { int R, C; stage_rc(tid * 16 + i * 8192, R, C); const int Rb = Epi::PERM ? ((R & ~31) + perm32(R & 31)) : R;
        voffA[i] = (unsigned)(R * lda + C) * 2u; voffB[i] = (unsigned)(Rb * K + C) * 2u; }
    const size_t kstep = (size_t)(BK * 2);
    const size_t hstepA = (size_t)HALF * lda * 2, tstepA = 2 * hstepA;
    const size_t hstepB = (size_t)HALF * K * 2, tstepB = 2 * hstepB;
    const unsigned ldsw = (unsigned)wid * 1024u;
    const int aoff = lds_byte(wr * 64 + fr, fq * 8), boff = lds_byte(wc * 32 + fr, fq * 8);
#define PG8_SA(b, h) (((b) * 2 + (h)) * HTB)
#define PG8_SB(b, h) ((4 + (b) * 2 + (h)) * HTB)
#define PG8_STAGE(bufoff, gbase, voff) do { _Pragma("unroll") for (int _i = 0; _i < 2; ++_i) \
        __builtin_amdgcn_global_load_lds((const unsigned*)((const char*)(gbase) + (voff)[_i]), (LAS unsigned*)(lds + (bufoff) + ldsw + _i * 8192), 16, 0, 0); } while (0)
#define PG8_LDA(dst, b, h) do { _Pragma("unroll") for (int m = 0; m < 4; ++m) _Pragma("unroll") for (int k = 0; k < 2; ++k) dst[m][k] = *(const LAS bf16x8*)(lds + PG8_SA(b, h) + aoff + m * 2048 + k * 1024); } while (0)
#define PG8_LDB(dst, b, h) do { _Pragma("unroll") for (int n = 0; n < 2; ++n) _Pragma("unroll") for (int k = 0; k < 2; ++k) dst[n][k] = *(const LAS bf16x8*)(lds + PG8_SB(b, h) + boff + n * 2048 + k * 1024); } while (0)
#define PG8_MMA(ai, bj, At, Bt) do { __builtin_amdgcn_s_setprio(1); _Pragma("unroll") for (int m = 0; m < 4; ++m) _Pragma("unroll") for (int n = 0; n < 2; ++n) _Pragma("unroll") for (int k = 0; k < 2; ++k) \
        acc[ai][bj][m][n] = __builtin_amdgcn_mfma_f32_16x16x32_bf16(Bt[n][k], At[m][k], acc[ai][bj][m][n], 0, 0, 0); __builtin_amdgcn_s_setprio(0); } while (0)
#define PG8_WAIT_V(n) asm volatile("s_waitcnt vmcnt(" #n ")" ::: "memory")
#define PG8_WAIT_L(n) asm volatile("s_waitcnt lgkmcnt(" #n ")" ::: "memory")
#define PG8_BAR __builtin_amdgcn_s_barrier()
#define PG8_SCHED __builtin_amdgcn_sched_barrier(0)
    Unit cur, nxt; int ui = 0;
    if (!S.next(0, cur)) return;
    cur.idx = 0;
    f32x4 acc[2][2][4][2];
#pragma unroll
    for (int a = 0; a < 2; ++a)
#pragma unroll
        for (int b = 0; b < 2; ++b)
#pragma unroll
            for (int m = 0; m < 4; ++m)
#pragma unroll
                for (int n = 0; n < 2; ++n) acc[a][b][m][n] = (f32x4){0.f, 0.f, 0.f, 0.f};
    bf16x8 At[4][2], B0[2][2], B1[2][2];
    const char* cA = (const char*)g.A + (size_t)cur.pm * tstepA; const char* cB = (const char*)g.Bt + (size_t)cur.pn * tstepB;
    PG8_STAGE(PG8_SB(0, 0), cB, voffB); PG8_STAGE(PG8_SB(0, 1), cB + hstepB, voffB); PG8_STAGE(PG8_SA(0, 0), cA, voffA); PG8_STAGE(PG8_SA(0, 1), cA + hstepA, voffA);
    if (wr == 1) PG8_BAR;
    PG8_WAIT_V(2); PG8_BAR;
    PG8_STAGE(PG8_SB(1, 0), cB + kstep, voffB); PG8_STAGE(PG8_SA(1, 0), cA + kstep, voffA); PG8_STAGE(PG8_SB(1, 1), cB + hstepB + kstep, voffB);
    PG8_WAIT_V(6); PG8_BAR;
    for (;;) {
        const bool has_next = S.next(ui + 1, nxt); nxt.idx = ui + 1;
        const char* nA = has_next ? (const char*)g.A + (size_t)nxt.pm * tstepA : cA; const char* nB = has_next ? (const char*)g.Bt + (size_t)nxt.pn * tstepB : cB;
        for (int t = 0; t < nt; t += 2) {
            if constexpr (Epi::HOOK) { if (t == (nt >> 1)) E.mid(acc, cur, wr, wc, fr, fq); }
            const bool last = (t == nt - 2);
            const char* a1 = cA + (size_t)(t + 1) * kstep;
            const char* a2 = last ? nA : cA + (size_t)(t + 2) * kstep; const char* b2 = last ? nB : cB + (size_t)(t + 2) * kstep;
            const char* a3 = a2 + kstep; const char* b3 = b2 + kstep;
            PG8_LDB(B0, 0, 0); PG8_LDB(B1, 0, 1); PG8_SCHED; PG8_LDA(At, 0, 0); PG8_STAGE(PG8_SA(1, 1), a1 + hstepA, voffA);
            PG8_WAIT_V(8); PG8_WAIT_L(0); PG8_BAR; PG8_MMA(0, 0, At, B0); PG8_MMA(0, 1, At, B1); PG8_BAR; PG8_SCHED;
            PG8_LDA(At, 0, 1); PG8_STAGE(PG8_SB(0, 0), b2, voffB); PG8_STAGE(PG8_SB(0, 1), b2 + hstepB, voffB); PG8_STAGE(PG8_SA(0, 0), a2, voffA);
            PG8_WAIT_V(8); PG8_WAIT_L(0); PG8_BAR; PG8_MMA(1, 0, At, B0); PG8_MMA(1, 1, At, B1); PG8_BAR; PG8_SCHED;
            PG8_LDB(B0, 1, 0); PG8_LDB(B1, 1, 1); PG8_SCHED; PG8_LDA(At, 1, 0); PG8_STAGE(PG8_SA(0, 1), a2 + hstepA, voffA);
            PG8_WAIT_V(8); PG8_WAIT_L(0); PG8_BAR; PG8_MMA(0, 0, At, B0); PG8_MMA(0, 1, At, B1); PG8_BAR; PG8_SCHED;
            PG8_LDA(At, 1, 1); PG8_STAGE(PG8_SB(1, 0), b3, voffB); PG8_STAGE(PG8_SB(1, 1), b3 + hstepB, voffB); PG8_STAGE(PG8_SA(1, 0), a3, voffA);
            PG8_WAIT_V(8); PG8_WAIT_L(0); PG8_BAR; PG8_MMA(1, 0, At, B0); PG8_MMA(1, 1, At, B1); PG8_BAR; PG8_SCHED;
        }
        if constexpr (ALIGN_EPI) { if (wr == 0) PG8_BAR; }
        E(acc, cur, wr, wc, fr, fq);
        if (!has_next) break;
#pragma unroll
        for (int a = 0; a < 2; ++a)
#pragma unroll
            for (int b = 0; b < 2; ++b)
#pragma unroll
                for (int m = 0; m < 4; ++m)
#pragma unroll
                    for (int n = 0; n < 2; ++n) acc[a][b][m][n] = (f32x4){0.f, 0.f, 0.f, 0.f};
        cur = nxt; cA = nA; cB = nB; ++ui;
        if constexpr (ALIGN_EPI) { if (wr == 1) PG8_BAR; }
    }
    PG8_WAIT_V(0);
    if constexpr (!ALIGN_EPI) { if (wr == 0) PG8_BAR; }
    PG8_BAR;
#undef PG8_SA
#undef PG8_SB
#undef PG8_STAGE
#undef PG8_LDA
#undef PG8_LDB
#undef PG8_MMA
#undef PG8_WAIT_V
#undef PG8_WAIT_L
#undef PG8_BAR
#undef PG8_SCHED
}

template <class Epi>
__device__ __forceinline__ void gemm128_phase(int tid_in, LAS unsigned char* lds, const bf16_t* A, int lda, const bf16_t* Bt, int K, int row0, int nrt, int nct, int G, int c, const Epi& E) {
    int tid = tid_in; asm volatile("" : "+v"(tid));
    const int wid = __builtin_amdgcn_readfirstlane(tid >> 6), lane = tid & 63, wr = wid >> 2, wc = wid & 3, fr = lane & 15, fq = lane >> 4;
    const int nt = K / BK;
    unsigned voffA[2], voffB[2];
#pragma unroll
    for (int i = 0; i < 2; ++i) { int R, C; stage_rc(tid * 16 + i * 8192, R, C); const int Rb = Epi::PERM ? ((R & ~31) + perm32(R & 31)) : R;
        voffA[i] = (unsigned)(R * lda + C) * 2u; voffB[i] = (unsigned)(Rb * K + C) * 2u; }
    const unsigned ldsw = (unsigned)wid * 1024u;
    const int aoff = lds_byte(wr * 64 + fr, fq * 8), boff = lds_byte(wc * 32 + fr, fq * 8);
#define G1_SA(b) ((b) * HTB)
#define G1_SB(b) ((2 + (b)) * HTB)
#define G1_STAGE(bufoff, gbase, voff) do { _Pragma("unroll") for (int _i = 0; _i < 2; ++_i) \
        __builtin_amdgcn_global_load_lds((const unsigned*)((const char*)(gbase) + (voff)[_i]), (LAS unsigned*)(lds + (bufoff) + ldsw + _i * 8192), 16, 0, 0); } while (0)
    for (int L = c; L < nrt * nct; L += G) {
        const int pm = L / nct, pn = L % nct;
        const int rowbase = row0 + pm * 128, colbase = pn * 128;
        const char* cA = (const char*)A + (size_t)rowbase * lda * 2; const char* cB = (const char*)Bt + (size_t)colbase * K * 2;
        f32x4 acc[1][1][4][2];
#pragma unroll
        for (int m = 0; m < 4; ++m)
#pragma unroll
            for (int n = 0; n < 2; ++n) acc[0][0][m][n] = (f32x4){0.f, 0.f, 0.f, 0.f};
        G1_STAGE(G1_SA(0), cA, voffA); G1_STAGE(G1_SB(0), cB, voffB);
        for (int kt = 0; kt < nt; ++kt) {
            const int b = kt & 1;
            if (kt + 1 < nt) { G1_STAGE(G1_SA(b ^ 1), cA + (size_t)(kt + 1) * (BK * 2), voffA); G1_STAGE(G1_SB(b ^ 1), cB + (size_t)(kt + 1) * (BK * 2), voffB); }
            if constexpr (Epi::HOOK) { if (kt == (nt >> 1)) E.mid128(acc, rowbase, colbase, wr, wc, fr, fq); }
            if (kt + 1 < nt) asm volatile("s_waitcnt vmcnt(4)" ::: "memory"); else asm volatile("s_waitcnt vmcnt(0)" ::: "memory");
            __builtin_amdgcn_s_barrier();
            bf16x8 At[4][2], Bf[2][2];
#pragma unroll
            for (int m = 0; m < 4; ++m)
#pragma unroll
                for (int k = 0; k < 2; ++k) At[m][k] = *(const LAS bf16x8*)(lds + G1_SA(b) + aoff + m * 2048 + k * 1024);
#pragma unroll
            for (int n = 0; n < 2; ++n)
#pragma unroll
                for (int k = 0; k < 2; ++k) Bf[n][k] = *(const LAS bf16x8*)(lds + G1_SB(b) + boff + n * 2048 + k * 1024);
            asm volatile("s_waitcnt lgkmcnt(0)" ::: "memory");
#pragma unroll
            for (int m = 0; m < 4; ++m)
#pragma unroll
                for (int n = 0; n < 2; ++n)
#pragma unroll
                    for (int k = 0; k < 2; ++k) acc[0][0][m][n] = __builtin_amdgcn_mfma_f32_16x16x32_bf16(Bf[n][k], At[m][k], acc[0][0][m][n], 0, 0, 0);
            __builtin_amdgcn_s_barrier();
        }
        E.end128(acc, rowbase, colbase, wr, wc, fr, fq);
    }
    asm volatile("s_waitcnt vmcnt(0)" ::: "memory"); __builtin_amdgcn_s_barrier();
#undef G1_SA
#undef G1_SB
#undef G1_STAGE
}
}

struct EpiG1 {
    static constexpr bool PERM = true, HOOK = false;
    bf16_t* P; const float* sb; LAS unsigned char* ldsc; int skip;
    __device__ __forceinline__ void mid(f32x4 (&)[2][2][4][2], const pg8::Unit&, int, int, int, int) const {}
    __device__ __forceinline__ void operator()(const f32x4 (&acc)[2][2][4][2], const pg8::Unit& u, int wr, int wc, int fr, int fq) const {
        if (skip == 2) { if (acc[0][0][0][0][0] == 12345.678f) P[0] = 1; return; }
        asm volatile("" : "+v"(fr), "+v"(fq));
        const bool latent = u.pm < 128;
        const int bidx = latent ? (u.pm >> 3) : 16;
        const int col8 = u.pn * 256 + wc * 32 + 8 * fq;
        const float* sbr = sb + bidx * NIN + col8;
        f32x4 bv[2][2];
#pragma unroll
        for (int bj = 0; bj < 2; ++bj)
#pragma unroll
            for (int n = 0; n < 2; ++n) bv[bj][n] = *(const f32x4*)(sbr + bj * 128 + n * 4);
        const bool isq = (u.pn == 8 || u.pn == 9), isk = (u.pn == 10);
        const bool anyrope = latent && (isq || isk);
        const float sc = isq ? QSCALE : 1.0f;
        float rinv[8];
        {   const LAS float* rt = (const LAS float*)(ldsc + LDS_RINV_OFF) + u.idx * 256 + wr * 64 + fr;
#pragma unroll
            for (int i = 0; i < 8; ++i) rinv[i] = rt[(i >> 2) * 128 + (i & 3) * 16]; }
        bf16_t* pb = P + (size_t)u.pm * 256 * NCOL;
        if (u.pn < 8) {
            const bool iscu = u.pn < 4;
            const unsigned lo2 = (unsigned)((wr * 64 + fr) * NCOL + (iscu ? C_CU + u.pn * 128 : C_BZ + (u.pn - 4) * 128) + wc * 32 + 8 * fq);
#pragma unroll
            for (int ai = 0; ai < 2; ++ai)
#pragma unroll
                for (int m = 0; m < 4; ++m) {
                    const float ri = rinv[ai * 4 + m];
                    bf16_t* rowp = pb + (size_t)(ai * 128 + m * 16) * NCOL;
                    const f32x4 a0 = acc[ai][0][m][0] * ri + bv[0][0], a1 = acc[ai][0][m][1] * ri + bv[0][1];
                    const f32x4 b0 = acc[ai][1][m][0] * ri + bv[1][0], b1 = acc[ai][1][m][1] * ri + bv[1][1];
                    f32x4 o0, o1;
                    if (iscu) { o0 = a0 * b0; o1 = a1 * b1; }
                    else {
#pragma unroll
                        for (int e = 0; e < 4; ++e) { o0[e] = a0[e] * siluf_(b0[e]); o1[e] = a1[e] * siluf_(b1[e]); } }
                    u32x4 w; w.x = cvt_pk_bf16(o0[0], o0[1]); w.y = cvt_pk_bf16(o0[2], o0[3]); w.z = cvt_pk_bf16(o1[0], o1[1]); w.w = cvt_pk_bf16(o1[2], o1[3]);
                    *(u32x4*)(rowp + lo2) = w;
                }
            return;
        }
        if (u.pn >= 13) {
            const unsigned lo3 = (unsigned)((wr * 64 + fr) * NCOL + (u.pn - 13) * 128 + wc * 32 + 8 * fq);
#pragma unroll
            for (int ai = 0; ai < 2; ++ai)
#pragma unroll
                for (int m = 0; m < 4; ++m) {
                    const float ri = rinv[ai * 4 + m];
                    bf16_t* rowp = pb + (size_t)(ai * 128 + m * 16) * NCOL;
                    const f32x4 a0 = acc[ai][0][m][0] * ri + bv[0][0], a1 = acc[ai][0][m][1] * ri + bv[0][1];
                    const f32x4 b0 = acc[ai][1][m][0] * ri + bv[1][0], b1 = acc[ai][1][m][1] * ri + bv[1][1];
                    f32x4 r0, r1, s0, s1;
#pragma unroll
                    for (int e = 0; e < 4; ++e) {
                        const float ea0 = 1.0f + fast_exp(-a0[e]), eb0 = 1.0f + fast_exp(-b0[e]), ea1 = 1.0f + fast_exp(-a1[e]), eb1 = 1.0f + fast_exp(-b1[e]);
                        r0[e] = eb0 * __builtin_amdgcn_rcpf(ea0); s0[e] = __builtin_amdgcn_rcpf(eb0); r1[e] = eb1 * __builtin_amdgcn_rcpf(ea1); s1[e] = __builtin_amdgcn_rcpf(eb1); }
                    u32x4 wr_, ws_;
                    wr_.x = cvt_pk_bf16(r0[0], r0[1]); wr_.y = cvt_pk_bf16(r0[2], r0[3]); wr_.z = cvt_pk_bf16(r1[0], r1[1]); wr_.w = cvt_pk_bf16(r1[2], r1[3]);
                    ws_.x = cvt_pk_bf16(s0[0], s0[1]); ws_.y = cvt_pk_bf16(s0[2], s0[3]); ws_.z = cvt_pk_bf16(s1[0], s1[1]); ws_.w = cvt_pk_bf16(s1[2], s1[3]);
                    *(u32x4*)(rowp + (lo3 + (unsigned)C_GA)) = wr_; *(u32x4*)(rowp + (lo3 + (unsigned)C_GB)) = ws_;
                }
            return;
        }
        const unsigned lo = (unsigned)((wr * 64 + fr) * NCOL + C_Q + (u.pn - 8) * 256 + wc * 32 + 8 * fq);
        if (!anyrope) {
#pragma unroll
            for (int ai = 0; ai < 2; ++ai)
#pragma unroll
                for (int m = 0; m < 4; ++m) {
                    const float ri = rinv[ai * 4 + m];
                    bf16_t* rowp = pb + (size_t)(ai * 128 + m * 16) * NCOL;
#pragma unroll
                    for (int bj = 0; bj < 2; ++bj) {
                        const f32x4 v0 = (acc[ai][bj][m][0] * ri + bv[bj][0]) * sc, v1 = (acc[ai][bj][m][1] * ri + bv[bj][1]) * sc;
                        u32x4 w; w.x = cvt_pk_bf16(v0[0], v0[1]); w.y = cvt_pk_bf16(v0[2], v0[3]); w.z = cvt_pk_bf16(v1[0], v1[1]); w.w = cvt_pk_bf16(v1[2], v1[3]);
                        *(u32x4*)(rowp + (lo + (unsigned)(bj * 128))) = w;
                    }
                }
        } else {
            const LAS f32x4* tc4 = (const LAS f32x4*)(ldsc + LDS_ROPE_OFF);
            const LAS f32x4* ts4 = tc4 + 256;
            const float sgn = (fq < 2) ? -1.0f : 1.0f;
            const bool oddw = (wc & 1) != 0;
#pragma unroll
            for (int ai = 0; ai < 2; ++ai)
#pragma unroll
                for (int m = 0; m < 4; ++m) {
                    const int t = (u.pm * 256 + ai * 128 + wr * 64 + m * 16 + fr) & 2047;
                    const int pos = oddw ? (t & 63) : (t >> 6);
                    const int ti = pos * 4 + (fq & 1) * 2;
                    const f32x4 c0 = tc4[ti], c1 = tc4[ti + 1], s0 = ts4[ti], s1 = ts4[ti + 1];
                    const float ri = rinv[ai * 4 + m];
                    bf16_t* rowp = pb + (size_t)(ai * 128 + m * 16) * NCOL;
#pragma unroll
                    for (int bj = 0; bj < 2; ++bj) {
                        f32x4 v0 = acc[ai][bj][m][0] * ri + bv[bj][0], v1 = acc[ai][bj][m][1] * ri + bv[bj][1];
                        if (isq || bj == 0) {
                            f32x4 p0, p1;
#pragma unroll
                            for (int e = 0; e < 4; ++e) { p0[e] = shx(v0[e], fq * 16 + fr, 32); p1[e] = shx(v1[e], fq * 16 + fr, 32); }
                            v0 = v0 * c0 + (p0 * s0) * sgn; v1 = v1 * c1 + (p1 * s1) * sgn;
                        }
                        v0 = v0 * sc; v1 = v1 * sc;
                        u32x4 w; w.x = cvt_pk_bf16(v0[0], v0[1]); w.y = cvt_pk_bf16(v0[2], v0[3]); w.z = cvt_pk_bf16(v1[0], v1[1]); w.w = cvt_pk_bf16(v1[2], v1[3]);
                        *(u32x4*)(rowp + (lo + (unsigned)(bj * 128))) = w;
                    }
                }
        }
    }
};

struct EpiG2 {
    static constexpr bool PERM = true, HOOK = true; static constexpr int NST = 16;
    const bf16_t* P; bf16_t* Mout; int ldm, mcol;
    template <int NAI, int NBJ> __device__ __forceinline__ void mid_t(f32x4 (&acc)[NAI][NBJ][4][2], int rowbase, int colbase, int wr, int wc, int fr, int fq) const {
        int col8 = colbase + wc * 32 + 8 * fq, rbase = rowbase + wr * 64 + fr;
        asm volatile("" : "+v"(col8), "+v"(rbase));
        u32x4 rr[NAI][4][NBJ];
#pragma unroll
        for (int ai = 0; ai < NAI; ++ai)
#pragma unroll
            for (int m = 0; m < 4; ++m) { const bf16_t* rowp = P + (size_t)(rbase + ai * 128 + m * 16) * NCOL + col8;
#pragma unroll
                for (int bj = 0; bj < NBJ; ++bj) rr[ai][m][bj] = *(const u32x4*)(rowp + C_GA + bj * 128); }
#pragma unroll
        for (int ai = 0; ai < NAI; ++ai)
#pragma unroll
            for (int m = 0; m < 4; ++m)
#pragma unroll
                for (int bj = 0; bj < NBJ; ++bj)
#pragma unroll
                    for (int w = 0; w < 4; ++w) { acc[ai][bj][m][w >> 1][(w & 1) * 2] *= bf_lo(rr[ai][m][bj][w]); acc[ai][bj][m][w >> 1][(w & 1) * 2 + 1] *= bf_hi(rr[ai][m][bj][w]); }
    }
    template <int NAI, int NBJ> __device__ __forceinline__ void end_t(const f32x4 (&acc)[NAI][NBJ][4][2], int rowbase, int colbase, int wr, int wc, int fr, int fq) const {
        asm volatile("" : "+v"(fr), "+v"(fq));
        const int col8 = colbase + wc * 32 + 8 * fq, rbase = rowbase + wr * 64 + fr;
        u32x4 gb[NAI][4][NBJ];
#pragma unroll
        for (int ai = 0; ai < NAI; ++ai)
#pragma unroll
            for (int m = 0; m < 4; ++m) { const bf16_t* rowp = P + (size_t)(rbase + ai * 128 + m * 16) * NCOL + col8;
#pragma unroll
                for (int bj = 0; bj < NBJ; ++bj) gb[ai][m][bj] = *(const u32x4*)(rowp + C_GB + bj * 128); }
#pragma unroll
        for (int ai = 0; ai < NAI; ++ai)
#pragma unroll
            for (int m = 0; m < 4; ++m) {
                bf16_t* mrow = Mout + (size_t)(rbase + ai * 128 + m * 16) * ldm + mcol + col8;
#pragma unroll
                for (int bj = 0; bj < NBJ; ++bj) {
                    u32x4 o;
#pragma unroll
                    for (int w = 0; w < 4; ++w)
                        o[w] = cvt_pk_bf16(acc[ai][bj][m][w >> 1][(w & 1) * 2] * bf_lo(gb[ai][m][bj][w]), acc[ai][bj][m][w >> 1][(w & 1) * 2 + 1] * bf_hi(gb[ai][m][bj][w]));
                    *(u32x4*)(mrow + bj * 128) = o;
                }
            }
    }
    __device__ __forceinline__ void mid(f32x4 (&acc)[2][2][4][2], const pg8::Unit& u, int wr, int wc, int fr, int fq) const { mid_t<2, 2>(acc, u.pm * 256, u.pn * 256, wr, wc, fr, fq); }
    __device__ __forceinline__ void operator()(const f32x4 (&acc)[2][2][4][2], const pg8::Unit& u, int wr, int wc, int fr, int fq) const { end_t<2, 2>(acc, u.pm * 256, u.pn * 256, wr, wc, fr, fq); }
    __device__ __forceinline__ void mid128(f32x4 (&acc)[1][1][4][2], int rowbase, int colbase, int wr, int wc, int fr, int fq) const { mid_t<1, 1>(acc, rowbase, colbase, wr, wc, fr, fq); }
    __device__ __forceinline__ void end128(const f32x4 (&acc)[1][1][4][2], int rowbase, int colbase, int wr, int wc, int fr, int fq) const { end_t<1, 1>(acc, rowbase, colbase, wr, wc, fr, fq); }
};

#if RESID_BF16
typedef bf16_t resid_t;
#else
typedef float resid_t;
#endif
struct EpiG3 {
    static constexpr bool PERM = true, HOOK = false;
    const resid_t* xin_lat; const resid_t* xin_ctx; resid_t* xout_lat; resid_t* xout_ctx; const float* gate; const float* nw; bf16_t* xs; float* ssp; LAS unsigned char* ldsc;
    __device__ __forceinline__ void mid(f32x4 (&)[2][2][4][2], const pg8::Unit&, int, int, int, int) const {}
    template <int NAI, int NBJ> __device__ __forceinline__ void end_t(f32x4 (&acc)[NAI][NBJ][4][2], int rowbase, int colbase, int wr, int wc, int fr, int fq) const {
        asm volatile("" : "+v"(fr), "+v"(fq));
        const bool latent = rowbase < TL;
        const int bidx = latent ? (rowbase >> 11) : 16;
        const int col8 = colbase + wc * 32 + 8 * fq;
        {
            f32x4 gv[NBJ][2];
#pragma unroll
            for (int bj = 0; bj < NBJ; ++bj)
#pragma unroll
                for (int n = 0; n < 2; ++n) gv[bj][n] = gate ? *(const f32x4*)(gate + bidx * 3072 + col8 + bj * 128 + n * 4) : (f32x4){0.f, 0.f, 0.f, 0.f};
#pragma unroll
            for (int ai = 0; ai < NAI; ++ai)
#pragma unroll
                for (int bj = 0; bj < NBJ; ++bj)
#pragma unroll
                    for (int m = 0; m < 4; ++m)
#pragma unroll
                        for (int n = 0; n < 2; ++n) acc[ai][bj][m][n] = acc[ai][bj][m][n] * gv[bj][n];
        }
        LAS f32x4* nvl = (LAS f32x4*)(ldsc + LDS_EPI_OFF + (wr * 4 + wc) * 256);
        if (nw) { const int ln = fq * 16 + fr; if (ln < 8 * NBJ) nvl[ln] = *(const f32x4*)(nw + bidx * 1024 + colbase + wc * 32 + (ln >> 3) * 128 + ((ln >> 1) & 3) * 8 + (ln & 1) * 4); }
        unsigned lo = (unsigned)((wr * 64 + fr) * DM + col8); asm volatile("" : "+v"(lo));
        const resid_t* xib = latent ? xin_lat + (size_t)rowbase * DM : xin_ctx + (size_t)(rowbase - TL) * DM;
        resid_t* xob = latent ? xout_lat + (size_t)rowbase * DM : xout_ctx + (size_t)(rowbase - TL) * DM;
        bf16_t* xsb = xs + (size_t)rowbase * DM;
        float* sspb = ssp + (size_t)rowbase * NSS + (colbase >> 5) + wc;
#if RESID_BF16
#pragma unroll
        for (int ai = 0; ai < NAI; ++ai) {
            u32x4 xv[4][NBJ];
#pragma unroll
            for (int m = 0; m < 4; ++m)
#pragma unroll
                for (int bj = 0; bj < NBJ; ++bj) xv[m][bj] = *(const u32x4*)(xib + (size_t)(ai * 128 + m * 16) * DM + (lo + (unsigned)(bj * 128)));
#pragma unroll
            for (int m = 0; m < 4; ++m) {
#else
#pragma unroll
        for (int ai = 0; ai < NAI; ++ai)
#pragma unroll
        for (int mh = 0; mh < 2; ++mh) {
            f32x4 xv[2][NBJ][2];
#pragma unroll
            for (int m2 = 0; m2 < 2; ++m2)
#pragma unroll
                for (int bj = 0; bj < NBJ; ++bj)
#pragma unroll
                    for (int n = 0; n < 2; ++n) xv[m2][bj][n] = *(const f32x4*)(xib + (size_t)(ai * 128 + (mh * 2 + m2) * 16) * DM + (lo + (unsigned)(bj * 128 + n * 4)));
#pragma unroll
            for (int m2 = 0; m2 < 2; ++m2) { const int m = mh * 2 + m2;
#endif
                resid_t* xo = xob + (size_t)(ai * 128 + m * 16) * DM; bf16_t* xsr = xsb + (size_t)(ai * 128 + m * 16) * DM;
#pragma unroll
                for (int bj = 0; bj < NBJ; ++bj) {
                    const unsigned off = lo + (unsigned)(bj * 128);
#if RESID_BF16
                    const u32x4 xr = xv[m][bj];
                    const f32x4 x0 = (f32x4){bf_lo(xr[0]), bf_hi(xr[0]), bf_lo(xr[1]), bf_hi(xr[1])} + acc[ai][bj][m][0];
                    const f32x4 x1 = (f32x4){bf_lo(xr[2]), bf_hi(xr[2]), bf_lo(xr[3]), bf_hi(xr[3])} + acc[ai][bj][m][1];
                    u32x4 w; w.x = cvt_pk_bf16(x0[0], x0[1]); w.y = cvt_pk_bf16(x0[2], x0[3]); w.z = cvt_pk_bf16(x1[0], x1[1]); w.w = cvt_pk_bf16(x1[2], x1[3]);
                    *(u32x4*)(xo + off) = w;
#else
                    const f32x4 x0 = xv[m2][bj][0] + acc[ai][bj][m][0], x1 = xv[m2][bj][1] + acc[ai][bj][m][1];
                    *(f32x4*)(xo + off) = x0; *(f32x4*)(xo + off + 4) = x1;
#endif
                    float q = ((x0[0] * x0[0] + x0[1] * x0[1]) + (x0[2] * x0[2] + x0[3] * x0[3])) + ((x1[0] * x1[0] + x1[1] * x1[1]) + (x1[2] * x1[2] + x1[3] * x1[3]));
                    q += shx(q, fq * 16 + fr, 16); q += shx(q, fq * 16 + fr, 32);
                    if (fq == 0) sspb[(unsigned)((ai * 128 + wr * 64 + m * 16 + fr) * NSS + bj * 4)] = q;
                    if (nw) { const f32x4 h0 = x0 * nvl[bj * 8 + fq * 2], h1 = x1 * nvl[bj * 8 + fq * 2 + 1];
                        u32x4 ws_; ws_.x = cvt_pk_bf16(h0[0], h0[1]); ws_.y = cvt_pk_bf16(h0[2], h0[3]); ws_.z = cvt_pk_bf16(h1[0], h1[1]); ws_.w = cvt_pk_bf16(h1[2], h1[3]);
                        *(u32x4*)(xsr + off) = ws_; }
                }
            }
            asm volatile("" ::: "memory");
        }
    }
    __device__ __forceinline__ void operator()(f32x4 (&acc)[2][2][4][2], const pg8::Unit& u, int wr, int wc, int fr, int fq) const { end_t<2, 2>(acc, u.pm * 256, u.pn * 256, wr, wc, fr, fq); }
    __device__ __forceinline__ void end128(f32x4 (&acc)[1][1][4][2], int rowbase, int colbase, int wr, int wc, int fr, int fq) const { end_t<1, 1>(acc, rowbase, colbase, wr, wc, fr, fq); }
};

__device__ __forceinline__ s16x4 vtr(const LAS unsigned char* p) { return __builtin_bit_cast(s16x4, __builtin_amdgcn_ds_read_tr16_b64_v4i16((LAS v4i16_t*)p)); }

struct AUnit { int rowQ0, h, kh, qq0, nloc, jlo, kr_loc0, kr_ctx0; };
__device__ __forceinline__ AUnit aunit(int ua, int wave, int nlat) {
    AUnit D;
    if (ua < nlat) { const int b = ua >> 6, rem = ua & 63, qblk = rem >> 2, kh = (rem >> 1) & 1, hp = rem & 1;
        D.h = kh * 4 + hp * 2 + (wave >> 2); D.kh = kh; D.qq0 = (wave & 3) * 32; D.rowQ0 = b * SEQ + qblk * 128 + D.qq0;
        D.jlo = (qblk == 0) ? 2 : 0; D.nloc = ((qblk == 15) ? 4 : 6) - D.jlo; D.kr_loc0 = b * SEQ + qblk * 128 - 128; D.kr_ctx0 = TL + b * CTXL;
    } else { const int uc = ua - nlat, b = uc >> 3, h = uc & 7;
        D.h = h; D.kh = h >> 2; D.qq0 = 0; D.rowQ0 = TL + b * CTXL + wave * 32; D.jlo = 0; D.nloc = 0; D.kr_loc0 = 0; D.kr_ctx0 = TL + b * CTXL; }
    return D;
}
__device__ __forceinline__ void wait_vm_n(int n) {
    switch (n) {
        case 2: asm volatile("s_waitcnt vmcnt(2)" ::: "memory"); break;
        case 8: asm volatile("s_waitcnt vmcnt(8)" ::: "memory"); break;
        case 10: asm volatile("s_waitcnt vmcnt(10)" ::: "memory"); break;
        case 12: asm volatile("s_waitcnt vmcnt(12)" ::: "memory"); break;
        case 14: asm volatile("s_waitcnt vmcnt(14)" ::: "memory"); break;
        case 16: asm volatile("s_waitcnt vmcnt(16)" ::: "memory"); break;
        case 18: asm volatile("s_waitcnt vmcnt(18)" ::: "memory"); break;
        case 20: asm volatile("s_waitcnt vmcnt(20)" ::: "memory"); break;
        case 22: asm volatile("s_waitcnt vmcnt(22)" ::: "memory"); break;
        default: asm volatile("s_waitcnt vmcnt(0)" ::: "memory"); break;
    }
}
__device__ __forceinline__ void attn_phase2(LAS unsigned char* lds, int tid, const bf16_t* P, bf16_t* Oout, int opitch, int ocol, const float* sink, int bx, int G, int nlat, int ntot, int variant = 0) {
    const int lane = tid & 63, r32 = lane & 31, hi = lane >> 5;
    const int wid = __builtin_amdgcn_readfirstlane(tid >> 6);
    if (bx >= ntot) return;
    const size_t kofl = (size_t)lane * NCOL + C_K + wid * 8;
    const size_t vofl = (size_t)(16 * (wid & 3) + (lane >> 2)) * NCOL + C_V + (wid >> 2) * 32 + (lane & 3) * 8;
    int ua_c = bx, ua_s = bx;
    AUnit Dc = aunit(ua_c, wid, nlat), Ds = Dc, Dn = Dc;
    int ts = 0, NTs = Ds.nloc + 4, tc = 0, NTc = NTs, sslot = 0, cslot = 0;
    bf16x8 qr[4], qn[4]; u32x2 zb[8];
#pragma unroll
    for (int i = 0; i < 4; ++i) qn[i] = (bf16x8){0, 0, 0, 0, 0, 0, 0, 0};
#pragma unroll
    for (int i = 0; i < 8; ++i) zb[i] = (u32x2){0u, 0u};
    {   const bf16_t* qp = P + (size_t)(Dc.rowQ0 + r32) * NCOL + C_Q + Dc.h * 64 + hi * 8;
#pragma unroll
        for (int d0 = 0; d0 < 4; ++d0) qr[d0] = *(const bf16x8*)(qp + d0 * 16); }
    int nx = 0;
#define AT2_STAGE_NEXT() do { nx = 0; if (ua_s < ntot) { \
        if (ts == NTs - 1) {     \
            const bf16_t* zp_ = P + (size_t)(Ds.rowQ0 + r32) * NCOL + C_ZB + Ds.h * 64 + 4 * hi; \
            _Pragma("unroll") for (int i_ = 0; i_ < 8; ++i_) zb[i_] = *(const u32x2*)(zp_ + (i_ >> 2) * 32 + (i_ & 3) * 8); \
            nx += 8; \
            if (ua_s + G < ntot) { Dn = aunit(ua_s + G, wid, nlat); const bf16_t* qp_ = P + (size_t)(Dn.rowQ0 + r32) * NCOL + C_Q + Dn.h * 64 + hi * 8; \
                _Pragma("unroll") for (int d0_ = 0; d0_ < 4; ++d0_) qn[d0_] = *(const bf16x8*)(qp_ + d0_ * 16); nx += 4; } } \
        const int kr0_ = (ts < Ds.nloc) ? Ds.kr_loc0 + 64 * (Ds.jlo + ts) : Ds.kr_ctx0 + 64 * (ts - Ds.nloc); const bf16_t* tb_ = P + (size_t)kr0_ * NCOL + Ds.kh * 64; \
        if (variant != 2) { __builtin_amdgcn_global_load_lds((const unsigned*)(tb_ + kofl), (LAS unsigned*)(lds + sslot * 16384 + wid * 1024), 16, 0, 0); \
        __builtin_amdgcn_global_load_lds((const unsigned*)(tb_ + vofl), (LAS unsigned*)(lds + sslot * 16384 + 8192 + wid * 1024), 16, 0, 0); \
        nx += 2; } sslot = (sslot == 2) ? 0 : sslot + 1; ++ts; \
        if (ts == NTs) { ua_s += G; if (ua_s < ntot) { Ds = Dn; ts = 0; NTs = Ds.nloc + 4; } } } } while (0)
    AT2_STAGE_NEXT(); AT2_STAGE_NEXT();
    asm volatile("s_waitcnt vmcnt(2)" ::: "memory"); __builtin_amdgcn_s_barrier(); asm volatile("" ::: "memory");
    f32x16 o0, o1;
#pragma unroll
    for (int i = 0; i < 16; ++i) { o0[i] = 0.f; o1[i] = 0.f; }
    float mrun = sink[Dc.h] * LOG2E, lrun = hi ? 0.f : 1.f;
    int nst = 0;
    for (;;) {
        AT2_STAGE_NEXT();
        const bool local = tc < Dc.nloc; const int j = Dc.jlo + tc;
        const bool need = (variant != 1) && (!local || !((j == 0 && Dc.qq0 >= 64) || (j == 5 && Dc.qq0 < 64)));
        if (need) {
            const int qq = Dc.qq0 + r32;
            const LAS unsigned char* kb = lds + cslot * 16384 + hi * 1024 + r32 * 16;
            f32x16 p0, p1;
#pragma unroll
            for (int i = 0; i < 16; ++i) { p0[i] = 0.f; p1[i] = 0.f; }
#pragma unroll
            for (int d0 = 0; d0 < 4; ++d0) {
                const bf16x8 b0 = *(const LAS bf16x8*)(kb + d0 * 2048);
                const bf16x8 b1 = *(const LAS bf16x8*)(kb + d0 * 2048 + 512);
                p0 = __builtin_amdgcn_mfma_f32_32x32x16_bf16(b0, qr[d0], p0, 0, 0, 0);
                p1 = __builtin_amdgcn_mfma_f32_32x32x16_bf16(b1, qr[d0], p1, 0, 0, 0);
            }
            if (local) {
                if (j < 2) { const int lim = qq - 64 * j;
#pragma unroll
                    for (int i = 0; i < 16; ++i) { const int kk = (i & 3) + 8 * (i >> 2) + 4 * hi; if (kk < lim) p0[i] = -1e30f; if (kk + 32 < lim) p1[i] = -1e30f; }
                } else if (j >= 4) { const int lim = qq - 64 * (j - 4);
#pragma unroll
                    for (int i = 0; i < 16; ++i) { const int kk = (i & 3) + 8 * (i >> 2) + 4 * hi; if (kk > lim) p0[i] = -1e30f; if (kk + 32 > lim) p1[i] = -1e30f; }
                }
            }
            float rm = fmaxf(p0[0], p1[0]);
#pragma unroll
            for (int i = 1; i < 16; ++i) rm = fmaxf(rm, fmaxf(p0[i], p1[i]));
            rm = fmaxf(rm, shx(rm, lane, 32));
            const float mn = fmaxf(mrun, rm);
            if (__any(mn > mrun)) {
                const float f = __builtin_amdgcn_exp2f(mrun - mn);
                lrun *= f;
#pragma unroll
                for (int i = 0; i < 16; ++i) { o0[i] *= f; o1[i] *= f; }
                mrun = mn;
            }
            float ps = 0.f;
#pragma unroll
            for (int i = 0; i < 16; ++i) { p0[i] = __builtin_amdgcn_exp2f(p0[i] - mrun); p1[i] = __builtin_amdgcn_exp2f(p1[i] - mrun); ps += p0[i] + p1[i]; }
            lrun += ps;
            u32x4 pw[4];
#pragma unroll
            for (int w = 0; w < 4; ++w) { pw[0][w] = cvt_pk_bf16(p0[2 * w], p0[2 * w + 1]); pw[1][w] = cvt_pk_bf16(p0[8 + 2 * w], p0[8 + 2 * w + 1]);
                pw[2][w] = cvt_pk_bf16(p1[2 * w], p1[2 * w + 1]); pw[3][w] = cvt_pk_bf16(p1[8 + 2 * w], p1[8 + 2 * w + 1]); }
            const LAS unsigned char* vp = lds + cslot * 16384 + 8192 + ((lane >> 4) & 1) * 32 + (lane & 3) * 8 + (4 * hi + ((lane & 15) >> 2)) * 64;
#pragma unroll
            for (int s = 0; s < 4; ++s) {
                const s16x4 l0 = vtr(vp + s * 1024), h0 = vtr(vp + s * 1024 + 512);
                const s16x4 l1 = vtr(vp + 4096 + s * 1024), h1 = vtr(vp + 4096 + s * 1024 + 512);
                const bf16x8 v0 = (bf16x8){l0[0], l0[1], l0[2], l0[3], h0[0], h0[1], h0[2], h0[3]};
                const bf16x8 v1 = (bf16x8){l1[0], l1[1], l1[2], l1[3], h1[0], h1[1], h1[2], h1[3]};
                const bf16x8 pa = __builtin_bit_cast(bf16x8, pw[s]);
                o0 = __builtin_amdgcn_mfma_f32_32x32x16_bf16(v0, pa, o0, 0, 0, 0);
                o1 = __builtin_amdgcn_mfma_f32_32x32x16_bf16(v1, pa, o1, 0, 0, 0);
            }
        }
        wait_vm_n(nx + nst); nst = 0;
        asm volatile("s_waitcnt lgkmcnt(0)" ::: "memory"); __builtin_amdgcn_s_barrier(); asm volatile("" ::: "memory");
        cslot = (cslot == 2) ? 0 : cslot + 1; ++tc;
        if (tc == NTc) {
            lrun += shx(lrun, lane, 32);
            const float inv = 1.0f / lrun;
            bf16_t* oo = Oout + (size_t)(Dc.rowQ0 + r32) * opitch + ocol + Dc.h * 64 + 4 * hi;
#pragma unroll
            for (int d0 = 0; d0 < 2; ++d0)
#pragma unroll
                for (int gq = 0; gq < 4; ++gq) {
                    const u32x2 z = zb[d0 * 4 + gq];
                    const float a0 = (d0 ? o1[4 * gq + 0] : o0[4 * gq + 0]) * inv * siluf_(bf_lo(z.x));
                    const float a1 = (d0 ? o1[4 * gq + 1] : o0[4 * gq + 1]) * inv * siluf_(bf_hi(z.x));
                    const float a2 = (d0 ? o1[4 * gq + 2] : o0[4 * gq + 2]) * inv * siluf_(bf_lo(z.y));
                    const float a3 = (d0 ? o1[4 * gq + 3] : o0[4 * gq + 3]) * inv * siluf_(bf_hi(z.y));
                    u32x2 w; w.x = cvt_pk_bf16(a0, a1); w.y = cvt_pk_bf16(a2, a3);
                    *(u32x2*)(oo + d0 * 32 + gq * 8) = w;
                }
            nst = 8;
            ua_c += G; if (ua_c >= ntot) break;
            Dc = aunit(ua_c, wid, nlat); tc = 0; NTc = Dc.nloc + 4;
#pragma unroll
            for (int d0 = 0; d0 < 4; ++d0) qr[d0] = qn[d0];
#pragma unroll
            for (int i = 0; i < 16; ++i) { o0[i] = 0.f; o1[i] = 0.f; }
            mrun = sink[Dc.h] * LOG2E; lrun = hi ? 0.f : 1.f;
        }
    }
#undef AT2_STAGE_NEXT
    asm volatile("s_waitcnt vmcnt(0) lgkmcnt(0)" ::: "memory"); __builtin_amdgcn_s_barrier(); asm volatile("" ::: "memory");
}

namespace at3 {
constexpr int NSLOT = 3, SLOTB = 8192;
constexpr int LDS_K = 0, LDS_V = NSLOT * SLOTB, LDS_WS = 2 * NSLOT * SLOTB, LDS_OST = LDS_WS + 8 * 64 * 4, LDS_Z = LDS_OST + 8 * 4096, LDS_Q = LDS_Z + 8 * 4096, LDS_TOTAL = LDS_Q + 8 * 4096;
__device__ __forceinline__ int crow(int r, int hi) { return (r & 3) + 8 * (r >> 2) + 4 * hi; }
#define SBAR() __builtin_amdgcn_sched_barrier(0)
__device__ __forceinline__ void glds16(const void* sbase, unsigned voff, unsigned lds_dst) { unsigned keep;
    asm volatile("s_mov_b32 %0, m0\n\ts_mov_b32 m0, %3\n\ts_nop 4\n\tglobal_load_lds_dwordx4 %1, %2\n\ts_mov_b32 m0, %0" : "=&s"(keep) : "v"(voff), "s"(sbase), "s"(lds_dst) : "memory"); }
__device__ __forceinline__ float max3f(float a, float b, float c) { float r; asm("v_max3_f32 %0, %1, %2, %3" : "=v"(r) : "v"(a), "v"(b), "v"(c)); return r; }
__device__ __forceinline__ float max2f(float a, float b) { float r; asm("v_max_f32_e32 %0, %1, %2" : "=v"(r) : "v"(a), "v"(b)); return r; }
__device__ __forceinline__ float fadd_s(float a, float b) { float r; asm("v_add_f32_e32 %0, %1, %2" : "=v"(r) : "v"(a), "v"(b)); return r; }
__device__ __forceinline__ float fsub_s(float a, float b) { float r; asm("v_sub_f32_e32 %0, %1, %2" : "=v"(r) : "v"(a), "v"(b)); return r; }
typedef float f32x2_t __attribute__((ext_vector_type(2))); typedef __bf16 bf16x2_t __attribute__((ext_vector_type(2)));
__device__ __forceinline__ unsigned cvtpk_s(float lo, float hi) { f32x2_t v = {lo, hi}; bf16x2_t b = __builtin_convertvector(v, bf16x2_t); return __builtin_bit_cast(unsigned, b); }
#define WAIT_BAR(N) asm volatile("s_waitcnt vmcnt(" #N ") lgkmcnt(0)\n\ts_barrier" ::: "memory")
typedef const LAS char* lds_cptr;
__device__ __forceinline__ void qkt(f32x16& p0, f32x16& p1, lds_cptr Kslot, lds_cptr qls, int r32, int hi) {
    const f32x16 negm = f32x16{};
    bf16x8 qr[4];
#pragma unroll
    for (int d0 = 0; d0 < 4; ++d0) qr[d0] = *(const LAS bf16x8*)(qls + d0 * 1024);
    lds_cptr kb = Kslot + hi * 1024 + r32 * 16;
#pragma unroll
    for (int d0 = 0; d0 < 4; ++d0) {
        const bf16x8 b0 = *(const LAS bf16x8*)(kb + d0 * 2048);
        const bf16x8 b1 = *(const LAS bf16x8*)(kb + d0 * 2048 + 512);
        if (d0 == 0) { p0 = __builtin_amdgcn_mfma_f32_32x32x16_bf16(b0, qr[0], negm, 0, 0, 0); p1 = __builtin_amdgcn_mfma_f32_32x32x16_bf16(b1, qr[0], negm, 0, 0, 0); }
        else { p0 = __builtin_amdgcn_mfma_f32_32x32x16_bf16(b0, qr[d0], p0, 0, 0, 0); p1 = __builtin_amdgcn_mfma_f32_32x32x16_bf16(b1, qr[d0], p1, 0, 0, 0); } }
}
__device__ __forceinline__ void kload8(bf16x8* kf, lds_cptr kp) {
    kf[0] = *(const LAS bf16x8*)(kp);        kf[1] = *(const LAS bf16x8*)(kp + 512);
    kf[2] = *(const LAS bf16x8*)(kp + 2048); kf[3] = *(const LAS bf16x8*)(kp + 2560);
    kf[4] = *(const LAS bf16x8*)(kp + 4096); kf[5] = *(const LAS bf16x8*)(kp + 4608);
    kf[6] = *(const LAS bf16x8*)(kp + 6144); kf[7] = *(const LAS bf16x8*)(kp + 6656);
}
__device__ __forceinline__ void kload2(bf16x8* kf, lds_cptr kp, int j) { kf[2 * j] = *(const LAS bf16x8*)(kp + j * 2048); kf[2 * j + 1] = *(const LAS bf16x8*)(kp + j * 2048 + 512); }
__device__ __forceinline__ s16x4 vtr3(lds_cptr p) { return __builtin_bit_cast(s16x4, __builtin_amdgcn_ds_read_tr16_b64_v4i16((LAS v4i16_t*)p)); }
__device__ __forceinline__ float rowmax(const f32x16& p0, const f32x16& p1) {
    float a = max3f(p0[0], p0[1], p1[0]), b = max3f(p0[2], p0[3], p1[1]); a = max3f(a, p1[2], p1[3]);
#pragma unroll
    for (int r = 4; r < 16; r += 4) { a = max3f(a, p0[r], p0[r + 1]); b = max3f(b, p0[r + 2], p0[r + 3]); a = max3f(a, p1[r], p1[r + 1]); b = max3f(b, p1[r + 2], p1[r + 3]); }
    const float m = max2f(a, b);
    auto rr = __builtin_amdgcn_permlane32_swap(__float_as_uint(m), __float_as_uint(m), false, false);
    return max2f(__uint_as_float(rr[0]), __uint_as_float(rr[1]));
}
__device__ __forceinline__ void pv(f32x16* o, int vb, bf16x8 pa0, bf16x8 pa1, bf16x8 pa2, bf16x8 pa3) {
#pragma unroll
    for (int d0 = 0; d0 < 2; ++d0) { s16x4 lo[4], hi[4];
#pragma unroll
        for (int ks = 0; ks < 4; ++ks) {
            asm volatile("ds_read_b64_tr_b16 %0,%1 offset:%c2" : "=&v"(lo[ks]) : "v"(vb), "i"(d0 * 4096 + ks * 1024) : "memory");
            asm volatile("ds_read_b64_tr_b16 %0,%1 offset:%c2" : "=&v"(hi[ks]) : "v"(vb), "i"(d0 * 4096 + ks * 1024 + 512) : "memory"); }
        asm volatile("s_waitcnt lgkmcnt(0)" ::: "memory"); SBAR();
#define PK(k) (bf16x8){lo[k][0], lo[k][1], lo[k][2], lo[k][3], hi[k][0], hi[k][1], hi[k][2], hi[k][3]}
        o[d0] = __builtin_amdgcn_mfma_f32_32x32x16_bf16(pa0, PK(0), o[d0], 0, 0, 0);
        o[d0] = __builtin_amdgcn_mfma_f32_32x32x16_bf16(pa1, PK(1), o[d0], 0, 0, 0);
        o[d0] = __builtin_amdgcn_mfma_f32_32x32x16_bf16(pa2, PK(2), o[d0], 0, 0, 0);
        o[d0] = __builtin_amdgcn_mfma_f32_32x32x16_bf16(pa3, PK(3), o[d0], 0, 0, 0);
#undef PK
    }
}
__device__ __forceinline__ void wmask(f32x16& p0, f32x16& p1, int j, int qq, int hi) {
    const float NEG = -INFINITY;
    if (j < 2) { const int lim = qq - 64 * j;
#pragma unroll
        for (int r = 0; r < 16; ++r) { const int kk = (r & 3) + 8 * (r >> 2) + 4 * hi; if (kk < lim) p0[r] = NEG; if (kk + 32 < lim) p1[r] = NEG; }
    } else if (j >= 4) { const int lim = qq - 64 * (j - 4);
#pragma unroll
        for (int r = 0; r < 16; ++r) { const int kk = (r & 3) + 8 * (r >> 2) + 4 * hi; if (kk > lim) p0[r] = NEG; if (kk + 32 > lim) p1[r] = NEG; }
    }
}
__device__ __forceinline__ bool unit_at(int i, int bx, int G, int wave, int nlat, int ntot, bool lastl, AUnit& D) {
    int ua;
    if (G == 256) { const int xg = bx & 7, j = bx >> 3;
        if (i < 4) ua = (2 * xg + (i >> 1)) * 64 + (i & 1) * 32 + j;
        else { if (i > 4 || lastl || j >= 16) return false; ua = nlat + (2 * xg + (j >> 3)) * 8 + (j & 7); } }
    else { ua = bx + i * G; }
    if (ua >= ntot) return false;
    D = aunit(ua, wave, nlat); return true;
}
template <int THRL> __device__ __forceinline__ void attn_run(int tid_in, LAS unsigned char* shm3u, const bf16_t* P, bf16_t* Oout, int opitch, int ocol, const float* sink, int bx, int G, int nlat, int ntot, bool lastl, int pvar = 0) {
    int tid = tid_in; asm volatile("" : "+v"(tid));
    const int lane = tid & 63, r32 = lane & 31, hi = lane >> 5; const int wid = __builtin_amdgcn_readfirstlane(tid >> 6);
    const lds_cptr shm3 = (lds_cptr)shm3u;
    const unsigned lds0 = (unsigned)(uintptr_t)shm3u;
    LAS float* wsf = (LAS float*)(shm3u + LDS_WS) + wid * 64;
    const unsigned koff0 = (unsigned)(lane * NCOL + C_K + wid * 8) * 2u;
    const unsigned voff0 = (unsigned)((16 * (wid & 3) + (lane >> 2)) * NCOL + C_V + (wid >> 2) * 32 + (lane & 3) * 8) * 2u;
    const unsigned qoff0 = (unsigned)(r32 * NCOL + hi * 8) * 2u;
    const unsigned zoff0 = (unsigned)((lane >> 3) * NCOL + (lane & 7) * 8) * 2u;
    const unsigned kdst = lds0 + LDS_K + wid * 1024, vdst = lds0 + LDS_V + wid * 1024;
#define NXS(s_) (((s_) == (NSLOT - 1) * SLOTB) ? 0 : (s_) + SLOTB)
#define KROWD(D_, t) (((t) < (D_).nloc) ? (D_).kr_loc0 + 64 * ((D_).jlo + (t)) : (D_).kr_ctx0 + 64 * ((t) - (D_).nloc))
#define DMA_KD(D_, t, slot) glds16(P + (size_t)KROWD(D_, t) * NCOL + (D_).kh * 64, koff0, (unsigned)__builtin_amdgcn_readfirstlane(kdst + (slot)))
#define DMA_VD(D_, t, slot) glds16(P + (size_t)KROWD(D_, t) * NCOL + (D_).kh * 64, voff0, (unsigned)__builtin_amdgcn_readfirstlane(vdst + (slot)))
#define DMA_K(t, slot) DMA_KD(Dc, t, slot)
#define DMA_V(t, slot) DMA_VD(Dc, t, slot)
#define PREFETCH(D_, rb_) do { const int s1_ = NXS(rb_), s2_ = NXS(s1_); DMA_KD(D_, 0, rb_); DMA_VD(D_, 0, rb_); DMA_KD(D_, 1, s1_); DMA_KD(D_, 2, s2_); \
        const bf16_t* qb_ = P + (size_t)(D_).rowQ0 * NCOL + C_Q + (D_).h * 64; \
        _Pragma("unroll") for (int d0_ = 0; d0_ < 4; ++d0_) glds16(qb_ + d0_ * 16, qoff0, (unsigned)__builtin_amdgcn_readfirstlane(lds0 + LDS_Q + wid * 4096 + d0_ * 1024)); } while (0)
#define ZDMA(D_) do { const bf16_t* zb_ = P + (size_t)(D_).rowQ0 * NCOL + C_ZB + (D_).h * 64; \
        _Pragma("unroll") for (int i_ = 0; i_ < 4; ++i_) glds16(zb_ + (size_t)(i_ * 8) * NCOL, zoff0, (unsigned)__builtin_amdgcn_readfirstlane(lds0 + LDS_Z + wid * 4096 + i_ * 1024)); } while (0)
    AUnit Dc, Dn; Dn = AUnit{};
    if (!unit_at(0, bx, G, wid, nlat, ntot, lastl, Dc)) return;
    int rb = 0; bool first = true;
    PREFETCH(Dc, rb); ZDMA(Dc);
    const lds_cptr qls = shm3 + LDS_Q + wid * 4096 + lane * 16;
#define QLD(d) (*(const LAS bf16x8*)(qls + (d) * 1024))
  for (int ui = 0;; ++ui) {
    const bool has_next = unit_at(ui + 1, bx, G, wid, nlat, ntot, lastl, Dn);
    const int nloc = Dc.nloc, jlo = Dc.jlo; const float sink_l2 = sink[Dc.h] * LOG2E;
    bf16x8 kf[8];
    const lds_cptr kp0 = shm3 + LDS_K + hi * 1024 + r32 * 16; const lds_cptr vp0 = shm3 + LDS_V + ((lane >> 4) & 1) * 32 + (lane & 3) * 8 + (4 * hi + ((lane & 15) >> 2)) * 64;
    const int NT = nloc + 4;
    float mhat = 0.f, l_reg = 0.f; f32x16 o[2]; o[0] = f32x16{}; o[1] = f32x16{};
    const int qrel = Dc.qq0 + r32;
#define CMASK(P0, P1, t) do { if ((t) < nloc) wmask(P0, P1, jlo + (t), qrel, hi); } while (0)
    bool resc = false;
#define START(P0, P1) do { const float rm = max2f(rowmax(P0, P1), sink_l2); resc = false; \
    { const float dl = rm; mhat = fadd_s(mhat, dl); \
      _Pragma("unroll") for (int r = 0; r < 16; ++r) { P0[r] = fsub_s(P0[r], dl); P1[r] = fsub_s(P1[r], dl); } } \
    l_reg = hi ? 0.f : __builtin_amdgcn_exp2f(sink_l2 - mhat); \
    _Pragma("unroll") for (int r = 0; r < 16; ++r) P0[r] = __builtin_amdgcn_exp2f(P0[r]); } while (0)
#define RESC() do { if (resc) { asm volatile("s_waitcnt lgkmcnt(0)" ::: "memory"); \
      _Pragma("unroll") for (int r = 0; r < 16; ++r) { const float f_ = wsf[crow(r, hi)]; o[0][r] *= f_; o[1][r] *= f_; if ((r & 3) == 3) asm volatile("" ::: "memory"); } } } while (0)
    f32x16 pA0, pA1, pB0, pB1;
    int sl_prev = rb, sl_cur = rb, sl_next = NXS(rb);
#define ROT() do { sl_prev = sl_cur; sl_cur = sl_next; sl_next = NXS(sl_next); } while (0)
    if (first) { WAIT_BAR(4); } else { WAIT_BAR(8); }
    qkt(pA0, pA1, shm3 + LDS_K + rb, qls, r32, hi); asm volatile("s_nop 15\n\ts_nop 7" : "+v"(pA0), "+v"(pA1)); CMASK(pA0, pA1, 0);
    START(pA0, pA1);
    _Pragma("unroll") for (int r = 0; r < 16; ++r) pA1[r] = __builtin_amdgcn_exp2f(pA1[r]);
    WAIT_BAR(8);
    DMA_K(3, rb); DMA_V(1, NXS(rb));
    ROT();
    kload8(kf, kp0 + sl_cur);
    WAIT_BAR(2);
    s16x4 vlo[8], vhi[8]; u32x4 pw0, pw1, pw2, pw3;
#define PKW(P, B) cvtpk_s(P[B], P[B + 1])
#define PAF(k) __builtin_bit_cast(bf16x8, pw##k)
#define VFR(i) (bf16x8){vlo[i][0], vlo[i][1], vlo[i][2], vlo[i][3], vhi[i][0], vhi[i][1], vhi[i][2], vhi[i][3]}
#define PIN(x) asm volatile("" : "+v"(x))
#define MX3(a, b, c) __builtin_fmaxf(__builtin_fmaxf((a), (b)), (c))
#define GAPA(MF, A0, A1, A2, A3, W0, W1, PW) do { MF; sacc += A0; sacc += A1; sacc += A2; sacc += A3; PIN(sacc); W0; W1; PIN(PW); SBAR(); } while (0)
#define EX(v) __builtin_amdgcn_exp2f(v)
#define GAPB(MF, X, B) do { MF; X[B] = EX(X[B] - mhat); X[B + 1] = EX(X[B + 1] - mhat); X[B + 2] = EX(X[B + 2] - mhat); X[B + 3] = EX(X[B + 3] - mhat); PIN(X); SBAR(); } while (0)
#define VRD(i) do { vlo[i] = vtr3(vp_ + (((i) >> 2) * 4096 + ((i) & 3) * 1024)); vhi[i] = vtr3(vp_ + (((i) >> 2) * 4096 + ((i) & 3) * 1024 + 512)); } while (0)
#define KRD(G, j) do { if (G) { kload2(kf, kp0 + sl_next, j); SBAR(); } } while (0)
#define MF3(A_, B_, C_) __builtin_amdgcn_mfma_f32_32x32x16_bf16(A_, B_, C_, 0, 0, 0)
#define STEP(C0, C1, P0, P1, t, GK, GV, GL) do { SBAR(); \
    const lds_cptr vp_ = vp0 + sl_prev; const f32x16 zero16 = f32x16{}; \
    const bf16x8 qd0 = QLD(0), qd1 = QLD(1); VRD(0); SBAR(); float sacc = (P0[0] + P0[1]); \
    GAPA(C0 = MF3(kf[0], qd0, zero16), P0[2], P0[3], P0[4], P0[5],     pw0[0] = PKW(P0, 0), pw0[1] = PKW(P0, 2), pw0); \
    VRD(4); SBAR(); GAPA(C1 = MF3(kf[1], qd0, zero16), P0[6], P0[7], P0[8], P0[9],     pw0[2] = PKW(P0, 4), pw0[3] = PKW(P0, 6), pw0); \
    const bf16x8 qd2 = QLD(2), qd3 = QLD(3); VRD(1); SBAR(); GAPA(C0 = MF3(kf[2], qd1, C0),   P0[10], P0[11], P0[12], P0[13], pw1[0] = PKW(P0, 8), pw1[1] = PKW(P0, 10), pw1); \
    VRD(5); SBAR(); GAPA(C1 = MF3(kf[3], qd1, C1),   P0[14], P0[15], P1[0], P1[1],   pw1[2] = PKW(P0, 12), pw1[3] = PKW(P0, 14), pw1); \
    VRD(2); SBAR(); GAPA(C0 = MF3(kf[4], qd2, C0),   P1[2], P1[3], P1[4], P1[5],     pw2[0] = PKW(P1, 0), pw2[1] = PKW(P1, 2), pw2); \
    VRD(6); SBAR(); GAPA(C1 = MF3(kf[5], qd2, C1),   P1[6], P1[7], P1[8], P1[9],     pw2[2] = PKW(P1, 4), pw2[3] = PKW(P1, 6), pw2); \
    VRD(3); SBAR(); GAPA(C0 = MF3(kf[6], qd3, C0),   P1[10], P1[11], P1[12], P1[13], pw3[0] = PKW(P1, 8), pw3[1] = PKW(P1, 10), pw3); \
    VRD(7); SBAR(); GAPA(C1 = MF3(kf[7], qd3, C1),   P1[14], P1[15], 0.f, 0.f,       pw3[2] = PKW(P1, 12), pw3[3] = PKW(P1, 14), pw3); \
    l_reg += sacc; \
    if (GK) { DMA_K((t) + 3, sl_cur); } if (GV) { DMA_V((t) + 1, sl_next); } \
    CMASK(C0, C1, t); \
    { float a = MX3(C0[0], C0[1], C1[0]), b = MX3(C0[2], C0[3], C1[1]); a = MX3(a, C1[2], C1[3]); \
      _Pragma("unroll") for (int r = 4; r < 16; r += 4) { a = MX3(a, C0[r], C0[r + 1]); b = MX3(b, C0[r + 2], C0[r + 3]); a = MX3(a, C1[r], C1[r + 1]); b = MX3(b, C1[r + 2], C1[r + 3]); } \
      float rm = __builtin_fmaxf(a, b); { auto rr = __builtin_amdgcn_permlane32_swap(__float_as_uint(rm), __float_as_uint(rm), false, false); rm = __builtin_fmaxf(__uint_as_float(rr[0]), __uint_as_float(rr[1])); } \
      resc = false; rm -= mhat; \
      if (__builtin_expect(__any(rm > (float)THRL), 0)) { const float dl = __builtin_fmaxf(rm, 0.f); mhat += dl; \
        const float f = __builtin_amdgcn_exp2f(-dl); l_reg *= f; if (hi == 0) wsf[r32] = f; resc = true; } } \
    SBAR(); \
    GAPB(o[0] = MF3(PAF(0), VFR(0), o[0]), C0, 0); \
    GAPB(o[1] = MF3(PAF(0), VFR(4), o[1]), C0, 4); \
    KRD(GL, 0); GAPB(o[0] = MF3(PAF(1), VFR(1), o[0]), C0, 8); \
    KRD(GL, 1); GAPB(o[1] = MF3(PAF(1), VFR(5), o[1]), C0, 12); \
    KRD(GL, 2); GAPB(o[0] = MF3(PAF(2), VFR(2), o[0]), C1, 0); \
    KRD(GL, 3); GAPB(o[1] = MF3(PAF(2), VFR(6), o[1]), C1, 4); \
    GAPB(o[0] = MF3(PAF(3), VFR(3), o[0]), C1, 8); \
    GAPB(o[1] = MF3(PAF(3), VFR(7), o[1]), C1, 12); \
    } while (0)
    int t = 1;
#define ENDW(tt) do { if ((tt) + 3 < NT) { WAIT_BAR(2); } else if ((tt) + 2 < NT) { WAIT_BAR(1); } else { WAIT_BAR(0); } } while (0)
    for (; t + 1 < NT; t += 2) {
        STEP(pB0, pB1, pA0, pA1, t, (t + 3 < NT), (t + 1 < NT), (t + 1 < NT));       ENDW(t);     RESC(); ROT();
        STEP(pA0, pA1, pB0, pB1, t + 1, (t + 4 < NT), (t + 2 < NT), (t + 2 < NT));   ENDW(t + 1); RESC(); ROT();
    }
    STEP(pB0, pB1, pA0, pA1, NT - 1, false, false, false); RESC();
    const int rn = sl_next;
    if (has_next) PREFETCH(Dn, rn);
    { float sacc = pB0[0] + pB0[1]; _Pragma("unroll") for (int r = 2; r < 16; ++r) sacc += pB0[r]; _Pragma("unroll") for (int r = 0; r < 16; ++r) sacc += pB1[r]; l_reg += sacc;
      pw0 = (u32x4){PKW(pB0, 0), PKW(pB0, 2), PKW(pB0, 4), PKW(pB0, 6)}; pw1 = (u32x4){PKW(pB0, 8), PKW(pB0, 10), PKW(pB0, 12), PKW(pB0, 14)}; pw2 = (u32x4){PKW(pB1, 0), PKW(pB1, 2), PKW(pB1, 4), PKW(pB1, 6)}; pw3 = (u32x4){PKW(pB1, 8), PKW(pB1, 10), PKW(pB1, 12), PKW(pB1, 14)};
      SBAR(); int ln2 = lane_id_(); asm volatile("" : "+v"(ln2)); const int hi2 = ln2 >> 5;
      const int vb0 = (int)(lds0 + LDS_V) + ((ln2 >> 4) & 1) * 32 + (ln2 & 3) * 8 + (4 * hi2 + ((ln2 & 15) >> 2)) * 64;
      pv(o, vb0 + sl_cur, PAF(0), PAF(1), PAF(2), PAF(3)); }
#undef PKW
#undef PAF
#undef VFR
#undef PIN
#undef MX3
#undef GAPA
#undef GAPB
#undef EX
#undef VRD
#undef KRD
#undef STEP
#undef ENDW
    { auto rr = __builtin_amdgcn_permlane32_swap(__float_as_uint(l_reg), __float_as_uint(l_reg), false, false); l_reg = __uint_as_float(rr[0]) + __uint_as_float(rr[1]); }
    int lane_e = lane_id_(); asm volatile("" : "+v"(lane_e));
    const int r32_e = lane_e & 31, hi_e = lane_e >> 5;
    if (hi_e == 0) wsf[32 + r32_e] = l_reg; asm volatile("s_waitcnt lgkmcnt(0)" ::: "memory");
    float rli[16];
#pragma unroll
    for (int r = 0; r < 16; ++r) rli[r] = __builtin_amdgcn_rcpf(wsf[32 + crow(r, hi_e)]);
    {   LAS bf16_t* stg = (LAS bf16_t*)(shm3u + LDS_OST) + wid * 2048;
        u32x4 zv[4];
#pragma unroll
        for (int i = 0; i < 4; ++i) zv[i] = *(const LAS u32x4*)(shm3u + LDS_Z + wid * 4096 + i * 1024 + lane_e * 16);
        asm volatile("s_waitcnt lgkmcnt(0)" : "+v"(zv[0]), "+v"(zv[1]), "+v"(zv[2]), "+v"(zv[3]) :: "memory");
        if (has_next) ZDMA(Dn);
#pragma unroll
        for (int r = 0; r < 16; ++r) { const int orow = crow(r, hi_e);
#pragma unroll
            for (int d0 = 0; d0 < 2; ++d0) { const unsigned short b = (unsigned short)(cvtpk_s(o[d0][r] * rli[r], 0.f) & 0xffffu); stg[orow * 64 + d0 * 32 + r32_e] = b; } }
        asm volatile("s_waitcnt lgkmcnt(0)" ::: "memory");
        bf16_t* orow_p = Oout + (size_t)Dc.rowQ0 * opitch + ocol + Dc.h * 64;
#pragma unroll
        for (int i = 0; i < 4; ++i) { const int row = i * 8 + (lane_e >> 3), ch = lane_e & 7; const u32x4 v = *(const LAS u32x4*)(stg + row * 64 + ch * 8);
            u32x4 w;
#pragma unroll
            for (int e = 0; e < 4; ++e) { w[e] = cvt_pk_bf16(bf_lo(v[e]) * siluf_(bf_lo(zv[i][e])), bf_hi(v[e]) * siluf_(bf_hi(zv[i][e]))); }
            *(u32x4*)(orow_p + (size_t)row * opitch + ch * 8) = w; } }
    asm volatile("s_waitcnt lgkmcnt(0)\n\ts_barrier" ::: "memory");
    if (!has_next) break;
    Dc = Dn; rb = rn; first = false;
  }
    asm volatile("s_waitcnt vmcnt(0)" ::: "memory");
#undef DMA_K
#undef DMA_V
#undef KROWD
#undef DMA_KD
#undef DMA_VD
#undef PREFETCH
#undef ZDMA
#undef NXS
#undef CMASK
#undef START
#undef RESC
#undef ROT
#undef QLD
}
#undef SBAR
#undef WAIT_BAR
}

__device__ __forceinline__ void conv_run8(const bf16_t* P, bf16_t* Yout, int ypitch, int ycol, const float* cw, int run, int lane) {
    const int row0 = run * 8;
    int s0, s1; if (row0 < TL) { s0 = row0 & ~2047; s1 = s0 + 2048; } else { s0 = TL + ((row0 - TL) & ~255); s1 = s0 + 256; }
    const int c0 = lane * 8;
    const bf16_t* base = P + (size_t)row0 * NCOL + c0;
    u32x4 rc[10], rb[8];
    const u32x4 z4u = (u32x4){0u, 0u, 0u, 0u};
    rc[0] = z4u; rc[9] = z4u;
    if (row0 - 1 >= s0) rc[0] = *(const u32x4*)(base - NCOL + C_CU);
#pragma unroll
    for (int i = 0; i < 8; ++i) { rc[i + 1] = *(const u32x4*)(base + (size_t)i * NCOL + C_CU); rb[i] = *(const u32x4*)(base + (size_t)i * NCOL + C_BZ); }
    if (row0 + 8 < s1) rc[9] = *(const u32x4*)(base + (size_t)8 * NCOL + C_CU);
    const f32x4 w0a = *(const f32x4*)(cw + c0), w0b = *(const f32x4*)(cw + c0 + 4);
    const f32x4 w1a = *(const f32x4*)(cw + 512 + c0), w1b = *(const f32x4*)(cw + 512 + c0 + 4);
    const f32x4 w2a = *(const f32x4*)(cw + 1024 + c0), w2b = *(const f32x4*)(cw + 1024 + c0 + 4);
#define CV_A(q_) ((f32x4){bf_lo((q_)[0]), bf_hi((q_)[0]), bf_lo((q_)[1]), bf_hi((q_)[1])})
#define CV_B(q_) ((f32x4){bf_lo((q_)[2]), bf_hi((q_)[2]), bf_lo((q_)[3]), bf_hi((q_)[3])})
    f32x4 pa = CV_A(rc[0]), pb = CV_B(rc[0]), ca = CV_A(rc[1]), cb = CV_B(rc[1]);
#pragma unroll
    for (int i = 0; i < 8; ++i) {
        const f32x4 na = CV_A(rc[i + 2]), nb = CV_B(rc[i + 2]);
        const f32x4 ya = CV_A(rb[i]) * (w0a * pa + w1a * ca + w2a * na), yb = CV_B(rb[i]) * (w0b * pb + w1b * cb + w2b * nb);
        u32x4 w; w.x = cvt_pk_bf16(ya[0], ya[1]); w.y = cvt_pk_bf16(ya[2], ya[3]); w.z = cvt_pk_bf16(yb[0], yb[1]); w.w = cvt_pk_bf16(yb[2], yb[3]);
        *(u32x4*)(Yout + (size_t)(row0 + i) * ypitch + ycol + c0) = w;
        pa = ca; pb = cb; ca = na; cb = nb;
    }
#undef CV_A
#undef CV_B
}

__device__ __forceinline__ void transpose_item(const float* W, int ldw, bf16_t* WT, int ldo, int koff, int nblk, LAS float* scr, int item, int lane, bool perm = false) {
    const int kb = item / nblk, nb = item % nblk, k0 = 64 * kb, n0 = 32 * nb, n0s = perm ? orig_col(n0) : n0;
#pragma unroll 8
    for (int i = 0; i < 32; ++i) { const int kk = 2 * i + (lane >> 5); scr[kk * 33 + (lane & 31)] = W[(size_t)(k0 + kk) * ldw + n0s + (lane & 31)]; }
    LDS_WAIT(); asm volatile("" ::: "memory");
    const int c = lane & 7;
#pragma unroll
    for (int j = 0; j < 4; ++j) { const int n = (lane >> 3) + 8 * j; const LAS float* s = scr + (8 * c) * 33 + n;
        u32x4 o; o.x = cvt_pk_bf16(s[0 * 33], s[1 * 33]); o.y = cvt_pk_bf16(s[2 * 33], s[3 * 33]); o.z = cvt_pk_bf16(s[4 * 33], s[5 * 33]); o.w = cvt_pk_bf16(s[6 * 33], s[7 * 33]);
        *(u32x4*)(WT + (size_t)(n0 + n) * ldo + koff + k0 + 8 * c) = o; }
    LDS_WAIT(); asm volatile("" ::: "memory");
}

__device__ __forceinline__ void rowmat17_item(int tid, LAS unsigned char* lds, const float* W, int ldw, int col0, const float* bias, float* out, int ldo, int scol0 = -1) {
    if (scol0 < 0) scol0 = col0;
    const int lane = tid & 63, wid = tid >> 6;
    const LAS float* tab = (const LAS float*)lds;
    LAS float* part = (LAS float*)(lds + 17 * 1024 * 4);
    float acc[17];
#pragma unroll
    for (int r = 0; r < 17; ++r) acc[r] = 0.f;
    const float* wp = W + (size_t)(wid * 128) * ldw + scol0 + lane;
#pragma unroll 2
    for (int k = 0; k < 128; k += 8) {
        float wv[8];
#pragma unroll
        for (int i = 0; i < 8; ++i) wv[i] = wp[(size_t)(k + i) * ldw];
#pragma unroll
        for (int q = 0; q < 2; ++q)
#pragma unroll
            for (int r = 0; r < 17; ++r) { const f32x4 t = *(const LAS f32x4*)(tab + r * 1024 + wid * 128 + k + 4 * q); acc[r] += (t[0] * wv[4 * q] + t[1] * wv[4 * q + 1]) + (t[2] * wv[4 * q + 2] + t[3] * wv[4 * q + 3]); }
    }
#pragma unroll
    for (int r = 0; r < 17; ++r) part[(wid * 17 + r) * 64 + lane] = acc[r];
    __syncthreads();
    for (int idx = tid; idx < 17 * 64; idx += 512) { const int r = idx >> 6, e = idx & 63; float s = 0.f;
#pragma unroll
        for (int w = 0; w < 8; ++w) s += part[(w * 17 + r) * 64 + e];
        if (bias) s += bias[col0 + e];
        out[(size_t)r * ldo + col0 + e] = s; }
    __syncthreads();
}


#define XB_TMO      128
#define XB_XCNT(j)  (256  + 64 * (j))
#define XB_XSUB(j)  (1280 + 64 * (j))
#define XB_XGEN(j)  (2304 + 64 * (j))
#define XB_TOP      3328
#define XB_TOPGEN   3392
#define XCD_BAR_WORDS 3456
#define XB_SPIN_CAP (1u << 18)
__device__ __forceinline__ unsigned xb_ld(unsigned* p)              { return __hip_atomic_load(p, __ATOMIC_RELAXED, __HIP_MEMORY_SCOPE_AGENT); }
__device__ __forceinline__ unsigned xb_add(unsigned* p, unsigned v) { return __hip_atomic_fetch_add(p, v, __ATOMIC_RELAXED, __HIP_MEMORY_SCOPE_AGENT); }
__device__ __forceinline__ unsigned xb_xcc_id() { return (unsigned)__builtin_amdgcn_s_getreg((3 << 11) | 20) & 0xFu; }
#define XB_SPIN(cond, bar) do { unsigned _sp = 0; while (cond) { __builtin_amdgcn_s_sleep(1); \
    if ((++_sp & 255u) == 0u) { if (xb_ld(&(bar)[XB_TMO])) break; if (_sp > XB_SPIN_CAP) { atomicAdd(&(bar)[XB_TMO], 1u); break; } } } } while (0)
struct XcdBarrier { unsigned* bar; unsigned x; volatile LAS unsigned* st; };
__device__ __forceinline__ XcdBarrier xcd_barrier_post(unsigned* bar, volatile LAS unsigned* st, int tid) {
    XcdBarrier b; b.bar = bar; b.x = xb_xcc_id(); b.st = st;
    if (tid == 0) (void)xb_add(&bar[XB_XCNT(b.x)], 1u);
    return b;
}
__device__ __forceinline__ void xcd_barrier_complete(unsigned* bar, unsigned x, unsigned& nloc, unsigned& nx) {
    const unsigned G = gridDim.x * gridDim.y * gridDim.z;
    unsigned sum, cnt, mine, sp = 0u;
    for (;;) {
        sum = 0u; cnt = 0u; mine = 0u;
#pragma unroll
        for (unsigned j = 0; j < 16; ++j) { const unsigned c = xb_ld(&bar[XB_XCNT(j)]); sum += c; cnt += (c > 0u) ? 1u : 0u; mine = (j == x) ? c : mine; }
        if (sum == G) break;
        __builtin_amdgcn_s_sleep(1);
        if ((++sp & 255u) == 0u) { if (xb_ld(&bar[XB_TMO])) break; if (sp > XB_SPIN_CAP) { atomicAdd(&bar[XB_TMO], 1u); break; } }
    }
    nloc = mine > 0u ? mine : 1u; nx = cnt > 0u ? cnt : 1u;
}
__device__ __forceinline__ void xcd_barrier(const XcdBarrier& b, int tid) {
    asm volatile("s_waitcnt vmcnt(0)" ::: "memory");
    __syncthreads();
    if (tid == 0) {
        unsigned* bar = b.bar;
        __builtin_amdgcn_s_waitcnt(0);
        unsigned nloc = b.st[0], nx = b.st[1];
        if (nloc == 0u) { xcd_barrier_complete(bar, b.x, nloc, nx); b.st[0] = nloc; b.st[1] = nx; }
        const unsigned old = xb_add(&bar[XB_XSUB(b.x)], 1u);
        const unsigned gen = old / nloc;
        if (old + 1u == (gen + 1u) * nloc) {
            __builtin_amdgcn_fence(__ATOMIC_RELEASE, "agent");
            asm volatile("s_waitcnt vmcnt(0)" ::: "memory");
            const unsigned og = xb_add(&bar[XB_TOP], 1u);
            const unsigned tg = og / nx;
            if (og + 1u == (tg + 1u) * nx) xb_add(&bar[XB_TOPGEN], 1u);
            else XB_SPIN(xb_ld(&bar[XB_TOPGEN]) == tg, bar);
            __builtin_amdgcn_fence(__ATOMIC_ACQUIRE, "agent");
            xb_add(&bar[XB_XGEN(b.x)], 1u);
            asm volatile("s_waitcnt vmcnt(0)" ::: "memory");
        } else {
            XB_SPIN(xb_ld(&bar[XB_XGEN(b.x)]) == gen, bar);
            __builtin_amdgcn_fence(__ATOMIC_ACQUIRE, "agent");
            asm volatile("s_waitcnt vmcnt(0)" ::: "memory");
        }
    }
    __syncthreads();
}

__global__ void __launch_bounds__(512, 2) fwd_kernel(Args a) {
    extern __shared__ __attribute__((aligned(16))) unsigned char lds_raw[];
    LAS unsigned char* lds = (LAS unsigned char*)lds_raw;
    unsigned char* ws0 = a.ws;
    volatile LAS unsigned* MISC = (volatile LAS unsigned*)(lds + LDS_AUX);
    const int wave0 = __builtin_amdgcn_readfirstlane((int)threadIdx.x >> 6);
#define MYTID() (wave0 * 64 + lane_id_())
    if (MYTID() < 64) MISC[MYTID()] = 0u;
    __syncthreads();
    XcdBarrier xbar; xbar.bar = (unsigned*)(ws0 + WS_CTL); xbar.x = 0; xbar.st = nullptr;
    if (a.coop) xbar = xcd_barrier_post((unsigned*)(ws0 + WS_CTL), MISC + 8, MYTID());

#define PH_PROLOG const __attribute__((address_space(4))) Args* ap = (const __attribute__((address_space(4))) Args*)__builtin_amdgcn_kernarg_segment_ptr(); asm volatile("" : "+s"(ap)); const float* x_in = ap->in[0]; const float* c_in = ap->in[1]; const float* ctx_in = ap->in[2]; const float* cctx_in = ap->in[3]; const float* norm_w = ap->in[4]; const float* w_mod = ap->in[5]; const float* b_mod = ap->in[6]; const float* w_in = ap->in[7]; const float* conv_w = ap->in[8]; const float* w_a_out = ap->in[9]; const float* w_b_out = ap->in[10]; const float* attn_sink = ap->in[11]; const float* w_o = ap->in[12]; const float* fnorm_w = ap->in[13]; unsigned char* ws = ap->ws; bf16_t* WIN_T = (bf16_t*)(ws + WS_WIN_T); bf16_t* WAB_T = (bf16_t*)(ws + WS_WAB_T); bf16_t* WO_T = (bf16_t*)(ws + WS_WO_T); float* MOD = (float*)(ws + WS_MOD); float* NW1 = (float*)(ws + WS_NW1); float* SB = (float*)(ws + WS_SB); float* ROPEC = (float*)(ws + WS_ROPE); float* ROPES = ROPEC + 64 * 16; float* SSP = (float*)(ws + WS_SSP); resid_t* XCTX = (resid_t*)(ws + WS_XCTX); bf16_t* XS = (bf16_t*)(ws + WS_XS); bf16_t* P = (bf16_t*)(ws + WS_P); float* OUT = ap->out; (void)x_in; (void)c_in; (void)ctx_in; (void)cctx_in; (void)norm_w; (void)w_mod; (void)b_mod; (void)w_in; (void)conv_w; (void)w_a_out; (void)w_b_out; (void)attn_sink; (void)w_o; (void)fnorm_w; (void)WIN_T; (void)WAB_T; (void)WO_T; (void)MOD; (void)NW1; (void)SB; (void)ROPEC; (void)ROPES; (void)SSP; (void)XCTX; (void)XS; (void)P; (void)OUT; int tid = MYTID(), bx = blockIdx.x; asm volatile("" : "+v"(tid), "+s"(bx)); const int lane = tid & 63, wave = __builtin_amdgcn_readfirstlane(tid >> 6); const int G = gridDim.x; const int gw = bx * 8 + wave, NGW = G * 8; (void)lane; (void)gw; (void)NGW;
#define DUP_ON(k) ((DUP_MASK >> (k)) & 1)
#if MK_COOP
#define SEAM_SYNC() do { if (a.coop) xcd_barrier(xbar, MYTID()); __syncthreads(); } while (0)
#else
#define SEAM_SYNC() do { } while (0)
#endif
    if (a.ph_lo == 0 && (PHMASK & 1)) { PH_PROLOG
          for (int rep = DUP_ON(0) ? 0 : 1; rep < 2; ++rep) {
            constexpr int NMOD = DEPTH * 48;
            if (bx < NMOD) {
                LAS float* tab = (LAS float*)lds;
#pragma clang loop vectorize(disable) interleave(disable) unroll(disable)
                for (int idx = tid; idx < 17 * 1024; idx += 512) { const int r = idx >> 10, k = idx & 1023; const float v = (r < 16) ? c_in[r * 1024 + k] : cctx_in[k]; tab[idx] = siluf_(v); }
                __syncthreads();
                for (int it = bx; it < NMOD; it += G) { const int l = it / 48, ec = it % 48;
                    rowmat17_item(tid, lds, w_mod + (size_t)l * 1024 * 3072, 3072, ec * 64, b_mod + l * 3072, MOD + (size_t)l * 17 * 3072, 3072); }
            }
            __syncthreads();
            if (bx == G - 1) { for (int idx = tid; idx < 64 * 16; idx += 512) { const int pos = idx >> 4, f = idx & 15; const float invf = powf(10000.0f, -(float)f / 16.0f); const float ang = (float)pos * invf;
                    ROPEC[idx] = cosf(ang); ROPES[idx] = sinf(ang); } }
            LAS float* scr = (LAS float*)(lds + wave * 16384);
            constexpr int I_IN = 16 * 168, I_A = 8 * 32, I_O = 16 * 32;
            constexpr int NITEMS = DEPTH * (I_IN + 2 * I_A + I_O);
            for (int it = gw; it < NITEMS; it += NGW) {
                int r = it;
                const int l = r / (I_IN + 2 * I_A + I_O); r -= l * (I_IN + 2 * I_A + I_O);
                if (r < I_IN) { transpose_item(w_in + (size_t)l * 1024 * NIN, NIN, WIN_T + (size_t)l * NIN * 1024, 1024, 0, 168, scr, r, lane, true); continue; } r -= I_IN;
                if (r < I_A) { transpose_item(w_a_out + (size_t)l * 512 * 1024, 1024, WAB_T + (size_t)l * 1024 * 1024, 1024, 0, 32, scr, r, lane); continue; } r -= I_A;
                if (r < I_A) { transpose_item(w_b_out + (size_t)l * 512 * 1024, 1024, WAB_T + (size_t)l * 1024 * 1024, 1024, 512, 32, scr, r, lane); continue; } r -= I_A;
                transpose_item(w_o + (size_t)l * 1024 * 1024, 1024, WO_T + (size_t)l * 1024 * 1024, 1024, 0, 32, scr, r, lane);
            }
            if (rep == 0) SEAM_SYNC();
          }
    }
    if (a.ph_lo == 0 && a.ph_hi > 1) {
#if MK_COOP
        if (a.coop) cg::this_grid().sync();
#endif
        __syncthreads();
    }
    for (int ph = (a.ph_lo == 0 ? 1 : a.ph_lo); ph < a.ph_hi; ++ph) {
        if (ph == 1 && (PHMASK & 2)) { PH_PROLOG
          for (int rep = DUP_ON(1) ? 0 : 1; rep < 2; ++rep) {
            constexpr int NSB = DEPTH * 84;
            { int curl = -1;
              for (int it = bx; it < NSB; it += G) { const int l = it / 84, nc = it % 84;
                if (l != curl) { __syncthreads(); LAS float* tab = (LAS float*)lds;
#pragma clang loop vectorize(disable) interleave(disable) unroll(disable)
                    for (int idx = tid; idx < 17 * 1024; idx += 512) { const int r = idx >> 10, k = idx & 1023; tab[idx] = MOD[((size_t)l * 17 + r) * 3072 + k]; }
                    __syncthreads(); curl = l; }
                rowmat17_item(tid, lds, w_in + (size_t)l * 1024 * NIN, NIN, nc * 64, nullptr, SB + (size_t)l * 17 * NIN, NIN, orig_col(nc * 64)); } }
            for (int idx = bx * 512 + tid; idx < DEPTH * 17 * 1024; idx += G * 512) { const int k = idx & 1023, lr = idx >> 10, l = lr / 17;
                NW1[idx] = norm_w[l * 1024 + k] * (1.0f + MOD[(size_t)lr * 3072 + 1024 + k]); }
            for (int row0 = gw * 3; row0 < TT; row0 += NGW * 3) {
                f32x4 v[3][4]; float ss[3];
#pragma unroll
                for (int q = 0; q < 3; ++q) { const int row = row0 + q; const bool lat = row < TL;
                    const f32x4* xr = (const f32x4*)(lat ? x_in + (size_t)row * DM : ctx_in + (size_t)(row - TL) * DM) + lane;
#pragma unroll
                    for (int j = 0; j < 4; ++j) v[q][j] = xr[64 * j]; }
#pragma unroll
                for (int q = 0; q < 3; ++q) { float s_ = 0.f;
#pragma unroll
                    for (int j = 0; j < 4; ++j) s_ += (v[q][j][0] * v[q][j][0] + v[q][j][1] * v[q][j][1]) + (v[q][j][2] * v[q][j][2] + v[q][j][3] * v[q][j][3]);
                    ss[q] = wave_sum(s_, lane); }
#pragma unroll
                for (int q = 0; q < 3; ++q) { const int row = row0 + q; const bool lat = row < TL; const int b = lat ? (row >> 11) : 16;
                    const f32x4* nwp = (const f32x4*)norm_w + lane; const f32x4* scp = (const f32x4*)(MOD + (size_t)b * 3072 + 1024) + lane;
                    u32x2* o8 = (u32x2*)(XS + (size_t)row * DM) + lane;
#if RESID_BF16
                    u32x2* x8 = (u32x2*)(lat ? (bf16_t*)OUT + (size_t)row * DM : XCTX + (size_t)(row - TL) * DM) + lane;
#endif
#pragma unroll
                    for (int j = 0; j < 4; ++j) { const f32x4 hh = v[q][j] * (nwp[64 * j] * (scp[64 * j] + 1.0f)); u32x2 w; w.x = cvt_pk_bf16(hh[0], hh[1]); w.y = cvt_pk_bf16(hh[2], hh[3]); o8[64 * j] = w;
#if RESID_BF16
                        u32x2 wx; wx.x = cvt_pk_bf16(v[q][j][0], v[q][j][1]); wx.y = cvt_pk_bf16(v[q][j][2], v[q][j][3]); x8[64 * j] = wx;
#endif
                    }
                    if (lane < NSS) SSP[(size_t)row * NSS + lane] = (lane == 0) ? ss[q] : 0.f; }
            }
            if (rep == 0) SEAM_SYNC();
          }
        } else if (ph == NPHASE - 1 && (PHMASK & 4)) { PH_PROLOG
            for (int row = gw; row < TL; row += NGW) {
                float s = SSP[(size_t)row * NSS + (lane & 31)];
                s += shx(s, lane, 1); s += shx(s, lane, 2); s += shx(s, lane, 4); s += shx(s, lane, 8); s += shx(s, lane, 16);
                const float rinv = 1.0f / sqrtf(s * (1.0f / 1024.0f) + RMS_EPS);
                f32x4* xr = (f32x4*)(OUT + (size_t)row * DM) + lane; const f32x4* fw = (const f32x4*)fnorm_w + lane;
#if RESID_BF16
                const u32x2* xb = (const u32x2*)(XS + (size_t)row * DM) + lane;
#pragma unroll
                for (int j = 0; j < 4; ++j) { const u32x2 w = xb[64 * j]; const f32x4 v = (f32x4){bf_lo(w.x), bf_hi(w.x), bf_lo(w.y), bf_hi(w.y)}; xr[64 * j] = v * rinv * fw[64 * j]; }
#else
#pragma unroll
                for (int j = 0; j < 4; ++j) { const f32x4 v = xr[64 * j]; xr[64 * j] = v * rinv * fw[64 * j]; }
#endif
            }
        } else {
            const int l = (ph - 2) >> 2, sub = (ph - 2) & 3;
            const bool lastl = (l == DEPTH - 1);
            if (sub == 0 && (PHMASK & 8)) { PH_PROLOG
                pg8::Gemm g{XS, WIN_T + (size_t)l * NIN * 1024, DM, DM};
                pg8::Order S; if (!lastl) S.init(TT / 256, NIN / 256, G, bx); else S.init(TL / 256, NIN / 256, G, bx, NB, TL / 256, 10);
                { LAS float* rt = (LAS float*)(lds + LDS_ROPE_OFF); for (int idx = tid; idx < 2048; idx += 512) rt[idx] = ROPEC[idx]; }
                {
                    LAS float* rv = (LAS float*)(lds + LDS_RINV_OFF);
                    int nun = 0; { pg8::Unit uu; while (nun < 12 && S.next(nun, uu)) ++nun; }
#pragma unroll 2
                    for (int rr = tid; rr < nun * 256; rr += 512) { pg8::Unit uu; S.next(rr >> 8, uu);
                        const f32x4* sp = (const f32x4*)(SSP + (size_t)(uu.pm * 256 + (rr & 255)) * NSS);
                        f32x4 a4 = (sp[0] + sp[1]) + (sp[2] + sp[3]); a4 = a4 + ((sp[4] + sp[5]) + (sp[6] + sp[7]));
                        rv[rr] = 1.0f / sqrtf(((a4[0] + a4[1]) + (a4[2] + a4[3])) * (1.0f / 1024.0f) + RMS_EPS); }
                    __syncthreads(); }
                for (int rep = DUP_ON(3) ? 0 : 1; rep < 2; ++rep) { EpiG1 E{P, SB + (size_t)l * 17 * NIN, lds, rep == 0 ? PROBE_SKIP : 0};
                    pg8::gemm_phase<EpiG1, pg8::Order, true>(tid, lds, g, S, E, rep == 0 ? (unsigned)(((bx >> 3) & 31) * PROBE_STAGGER) : 0u); if (rep == 0) SEAM_SYNC(); }
            } else if (sub == 1 && (PHMASK & 16)) { PH_PROLOG
                const float* sink = attn_sink + l * 8;
                const int nlat = 1024, nctx = lastl ? 0 : 128;
              for (int rep = DUP_ON(4) ? 0 : 1; rep < 2; ++rep) {
                bf16_t* Oo = rep ? P : XS; const int opitch = rep ? NCOL : 1024, ocol = rep ? C_Q : 512, ycol = rep ? C_BZ : 0;
                if (!(ap->probe && PROBE_AT == 2)) {
#if ATTN_V3
                    at3::attn_run<8>(tid, lds, P, Oo, opitch, ocol, sink, bx, G, nlat, nlat + nctx, lastl);
#else
                    attn_phase2(lds, tid, P, Oo, opitch, ocol, sink, bx, G, nlat, nlat + nctx, rep == 0 ? PROBE_ATV : 0);
#endif
                }
                __syncthreads();
                const int nruns = (lastl ? TL : TT) / 8;
                for (int it = (NGW - 1 - gw); it < nruns && !(ap->probe && PROBE_AT == 1); it += NGW) conv_run8(P, Oo, opitch, ycol, conv_w + (size_t)l * 3 * 512, it, lane);
                if (rep == 0) SEAM_SYNC();
              }
            } else if (sub == 2 && (PHMASK & 32)) { PH_PROLOG
                pg8::Gemm g{P + C_BZ, WAB_T + (size_t)l * 1024 * 1024, NCOL, DM};
                pg8::Order S; S.init(TL / 256, 4, G, bx);
                { EpiG2 E{P, P, NCOL, C_GA};
                    pg8::gemm_phase<EpiG2, pg8::Order, true>(tid, lds, g, S, E);
                    if (!lastl) pg8::gemm128_phase<EpiG2>(MYTID(), lds, P + C_BZ, NCOL, WAB_T + (size_t)l * 1024 * 1024, DM, TL, TC / 128, 8, G, bx, E); }
            } else if (PHMASK & 64) { PH_PROLOG
                pg8::Gemm g{P + C_GA, WO_T + (size_t)l * 1024 * 1024, NCOL, DM};
                pg8::Order S; S.init(TL / 256, 4, G, bx);
                {
                    #if RESID_BF16
                    EpiG3 E{(const bf16_t*)OUT, XCTX, lastl ? XS : (bf16_t*)OUT, XCTX, MOD + (size_t)l * 17 * 3072 + 2048, lastl ? nullptr : NW1 + (size_t)(l + 1) * 17 * 1024, XS, SSP, lds};
#else
                    EpiG3 E{(l == 0 && !ap->probe) ? x_in : OUT, (l == 0 && !ap->probe) ? ctx_in : XCTX, OUT, XCTX, ap->probe ? nullptr : MOD + (size_t)l * 17 * 3072 + 2048, lastl ? nullptr : NW1 + (size_t)(l + 1) * 17 * 1024, XS, SSP, lds};
#endif
                    pg8::gemm_phase<EpiG3, pg8::Order, true>(tid, lds, g, S, E);
                    if (!lastl) pg8::gemm128_phase<EpiG3>(MYTID(), lds, P + C_GA, NCOL, WO_T + (size_t)l * 1024 * 1024, DM, TL, TC / 128, 8, G, bx, E); }
            }
        }
        if (ph + 1 < a.ph_hi) {
#if MK_COOP
            if (a.coop) xcd_barrier(xbar, MYTID());
#endif
            __syncthreads();
        }
    }
}

extern "C" void kernel_launch(void* const* d_in, const int* in_sizes, int n_in, void* d_out, int out_size, void* d_ws, size_t ws_size, hipStream_t stream) {
    static int grid = 0;
    if (grid == 0) {
        if (n_in != 14 || in_sizes[0] != TL * DM || out_size != TL * DM || ws_size < WS_END) {
            fprintf(stderr, "kernel_launch: unexpected shapes (n_in %d, in0 %d, out %d, ws %zu need %zu); nothing launched\n", n_in, n_in > 0 ? in_sizes[0] : -1, out_size, ws_size, (size_t)WS_END); grid = -1; return; }
        int dev = 0, cus = 0;
        if (hipGetDevice(&dev) != hipSuccess || hipDeviceGetAttribute(&cus, hipDeviceAttributeMultiprocessorCount, dev) != hipSuccess || cus <= 0) cus = 256;
        if (hipFuncSetAttribute((const void*)fwd_kernel, hipFuncAttributeMaxDynamicSharedMemorySize, LDS_BYTES) != hipSuccess) { fprintf(stderr, "kernel_launch: hipFuncSetAttribute failed\n"); grid = -1; return; }
        int per_cu = 0;
        if (hipOccupancyMaxActiveBlocksPerMultiprocessor(&per_cu, (const void*)fwd_kernel, 512, LDS_BYTES) != hipSuccess || per_cu < 1) { fprintf(stderr, "kernel_launch: occupancy query says %d\n", per_cu); (void)hipGetLastError(); }
        grid = cus;
    }
    if (grid < 0) return;
    Args a{};
    for (int i = 0; i < 14; ++i) a.in[i] = (const float*)d_in[i];
    a.out = (float*)d_out; a.ws = (unsigned char*)d_ws;
#if MK_COOP
    if (hipMemsetAsync((char*)d_ws + WS_CTL, 0, CTL_ZERO_BYTES, stream) != hipSuccess) { fprintf(stderr, "kernel_launch: memset failed\n"); return; }
    a.ph_lo = 0; a.ph_hi = NPHASE; a.coop = 1;
    void* args[] = {&a};
    hipError_t e = hipLaunchCooperativeKernel((const void*)fwd_kernel, dim3(grid), dim3(512), args, LDS_BYTES, stream);
    if (e != hipSuccess) fprintf(stderr, "cooperative launch failed: %s (grid %d)\n", hipGetErrorString(e), grid);
#if PROBE_PHASE >= 0
    { Args b = a; b.ph_lo = PROBE_PHASE; b.ph_hi = PROBE_PHASE + 1; b.coop = 0; b.probe = 1;
      for (int r_ = 0; r_ < PROBE_REPS; ++r_) hipLaunchKernelGGL(fwd_kernel, dim3(grid), dim3(512), LDS_BYTES, stream, b); }
#endif
#else
    for (int ph = 0; ph < NPHASE; ++ph) {
        a.ph_lo = ph; a.ph_hi = ph + 1; a.coop = 0;
        hipLaunchKernelGGL(fwd_kernel, dim3(grid), dim3(512), LDS_BYTES, stream, a);
    }
#endif
}
```

```cpp
#include <hip/hip_runtime.h>
#include <hip/hip_cooperative_groups.h>
#include <cstdio>
#include <cstdint>
namespace cg = cooperative_groups;

#ifndef PHMASK
#define PHMASK 127
#endif
#ifndef PROBE_SKIP
#define PROBE_SKIP 0
#endif
#ifndef PROBE_STAGGER
#define PROBE_STAGGER 0
#endif
#ifndef PROBE_AT
#define PROBE_AT 0
#endif
#ifndef PROBE_ATV
#define PROBE_ATV 0
#endif
#ifndef ATTN_V3
#define ATTN_V3 1
#endif
#ifndef RESID_BF16
#define RESID_BF16 1
#endif
#ifndef PROBE_PHASE
#define PROBE_PHASE -1
#endif
#ifndef PROBE_REPS
#define PROBE_REPS 1
#endif
#ifndef DUP_MASK
#define DUP_MASK 0
#endif
#ifndef MK_COOP
#define MK_COOP 1
#endif

#define LAS __attribute__((address_space(3)))
typedef unsigned short bf16_t;
typedef short bf16x8 __attribute__((ext_vector_type(8)));
typedef short s16x4 __attribute__((ext_vector_type(4)));
typedef short v4i16_t __attribute__((ext_vector_type(4)));
typedef float f32x4 __attribute__((ext_vector_type(4)));
typedef float f32x16 __attribute__((ext_vector_type(16)));
typedef unsigned u32x4 __attribute__((ext_vector_type(4)));
typedef unsigned u32x2 __attribute__((ext_vector_type(2)));

constexpr int DM = 1024, NB = 16, SEQ = 2048, CTXL = 256, DEPTH = 4, NIN = 5376, NCOL = 4352;
constexpr int TL = NB * SEQ, TC = NB * CTXL, TT = TL + TC;
constexpr int C_CU = 0, C_BZ = 512, C_Q = 1024, C_K = 1536, C_V = 1664, C_ZB = 1792, C_GA = 2304, C_GB = 3328;
__host__ __device__ __forceinline__ int orig_col(int c) { const int t = c >> 8, h = (c >> 7) & 1, o = c & 127; return (t < 4) ? (h ? 1024 : 512) + t * 128 + o : (t < 8) ? (h ? 1536 : 0) + (t - 4) * 128 + o : (t < 13) ? c : (h ? 4352 : 3328) + (t - 13) * 128 + o; }
constexpr float RMS_EPS = 1e-6f;
constexpr float LOG2E = 1.4426950408889634f;
constexpr float QSCALE = 0.125f * LOG2E;

constexpr size_t MiB = 1u << 20;
constexpr size_t WS_CTL = 0, CTL_ZERO_BYTES = 65536;
constexpr size_t WS_WIN_T = 446 * MiB;
constexpr size_t WS_WAB_T = 12 * MiB;
constexpr size_t WS_WO_T = 20 * MiB;
constexpr size_t WS_MOD = 28 * MiB;
constexpr size_t WS_NW1 = 29 * MiB;
constexpr size_t WS_SB = 30 * MiB;
constexpr size_t WS_ROPE = 32 * MiB;
constexpr size_t WS_SSP = 440 * MiB;
constexpr int NSS = 32;
constexpr size_t WS_XCTX = 36 * MiB;
constexpr size_t WS_XS = 52 * MiB;
constexpr size_t WS_P = 124 * MiB;
constexpr size_t WS_END = WS_P + (size_t)TT * NCOL * 2;
static_assert(WS_END <= 440 * MiB && WS_SSP + (size_t)TT * NSS * 4 <= 446 * MiB && WS_WIN_T + (size_t)DEPTH * NIN * 1024 * 2 <= 502 * MiB && C_BZ + 512 == C_Q && C_GB + 1024 == NCOL, "ws map / P columns");

constexpr int LDS_RINV_OFF = 131072;
constexpr int LDS_AUX = 149504;
constexpr int LDS_EPI_OFF = LDS_AUX + 1024;
constexpr int LDS_ROPE_OFF = LDS_AUX + 1024 + 2048;
constexpr int LDS_BYTES = LDS_AUX + 1024 + 2048 + 8192;
static_assert(LDS_BYTES <= 163840, "LDS");
constexpr int NPHASE = 2 + 4 * DEPTH + 1;

struct Args { const float* in[14]; float* out; unsigned char* ws; int ph_lo, ph_hi, coop, probe; };

typedef float f32x2_c __attribute__((ext_vector_type(2))); typedef __bf16 bf16x2_c __attribute__((ext_vector_type(2)));
__device__ __forceinline__ unsigned cvt_pk_bf16(float lo, float hi) { f32x2_c v = {lo, hi}; bf16x2_c b = __builtin_convertvector(v, bf16x2_c); return __builtin_bit_cast(unsigned, b); }
__device__ __forceinline__ float bf_lo(unsigned w) { return __uint_as_float(w << 16); }
__device__ __forceinline__ float bf_hi(unsigned w) { return __uint_as_float(w & 0xffff0000u); }
#ifndef RESID_HALF
#define RESID_HALF 1
#endif
typedef _Float16 h16x2_c __attribute__((ext_vector_type(2)));
#if RESID_HALF
__device__ __forceinline__ unsigned r16_pk(float lo, float hi) { f32x2_c v = {__builtin_amdgcn_fmed3f(lo, -65504.0f, 65504.0f), __builtin_amdgcn_fmed3f(hi, -65504.0f, 65504.0f)}; h16x2_c b = __builtin_convertvector(v, h16x2_c); return __builtin_bit_cast(unsigned, b); }
__device__ __forceinline__ float r16_lo(unsigned w) { return (float)__builtin_bit_cast(h16x2_c, w)[0]; }
__device__ __forceinline__ float r16_hi(unsigned w) { return (float)__builtin_bit_cast(h16x2_c, w)[1]; }
#else
__device__ __forceinline__ unsigned r16_pk(float lo, float hi) { return cvt_pk_bf16(lo, hi); }
__device__ __forceinline__ float r16_lo(unsigned w) { return bf_lo(w); }
__device__ __forceinline__ float r16_hi(unsigned w) { return bf_hi(w); }
#endif
__device__ __forceinline__ float fast_exp(float x) { return __builtin_amdgcn_exp2f(x * LOG2E); }
__device__ __forceinline__ float sigmoidf_(float x) { return __builtin_amdgcn_rcpf(1.0f + fast_exp(-x)); }
__device__ __forceinline__ float siluf_(float x) { return x * sigmoidf_(x); }
__device__ __forceinline__ float shx(float v, int lane, int m) { return __int_as_float(__builtin_amdgcn_ds_bpermute((lane ^ m) << 2, __float_as_int(v))); }
__device__ __forceinline__ float shl_(float v, int src) { return __int_as_float(__builtin_amdgcn_ds_bpermute(src << 2, __float_as_int(v))); }
__device__ __forceinline__ float wave_sum(float v, int lane) {
#pragma unroll
    for (int o = 1; o < 64; o <<= 1) v += shx(v, lane, o);
    return v;
}
__device__ __forceinline__ int lane_id_() { int r; asm volatile("v_mbcnt_lo_u32_b32 %0, -1, 0\n\tv_mbcnt_hi_u32_b32 %0, -1, %0" : "=v"(r)); return r; }
#define LDS_WAIT() asm volatile("s_waitcnt lgkmcnt(0)" ::: "memory")
#define VM_WAIT() asm volatile("s_waitcnt vmcnt(0)" ::: "memory")

namespace pg8 {
constexpr int BM = 256, BK = 64, HALF = 128, HTB = HALF * BK * 2, STAGE_BYTES = 8 * HTB, NXCD = 8, WGM = 8;
__host__ __device__ __forceinline__ int lds_byte(int r, int c) { const int st = (r >> 4) * 2 + (c >> 5), rr = r & 15, cc = c & 31, ob = rr * 64 + cc * 2; return st * 1024 + (ob ^ (((ob >> 9) & 1) << 5)); }
__host__ __device__ __forceinline__ void stage_rc(int b, int& R, int& C) { const int st = b / 1024, sb = b % 1024, swz = sb ^ (((sb >> 9) & 1) << 5); R = (st >> 1) * 16 + swz / 64; C = (st & 1) * 32 + (swz % 64) / 2; }
__host__ __device__ __forceinline__ int perm32(int rho) { const int n = rho >> 4, i = rho & 15; return 8 * (i >> 2) + 4 * n + (i & 3); }

struct Unit { int pm, pn, idx; };
struct Gemm { const bf16_t* A; const bf16_t* Bt; int lda; int K; };

struct Order {
    int nM, nN, nwg, G, c, nextra, extra_pm0, extra_pn;
    __device__ void init(int nM_, int nN_, int G_, int c_, int nextra_ = 0, int epm0 = 0, int epn = 0) { nM = nM_; nN = nN_; nwg = nM * nN; G = G_; c = c_; nextra = nextra_; extra_pm0 = epm0; extra_pn = epn; }
    __device__ bool next(int i, Unit& u) const {
        const int L = i * G + c; if (L >= nwg + nextra) return false;
        if (L >= nwg) { u.pm = extra_pm0 + (L - nwg); u.pn = extra_pn; return true; }
        int wgid = L; { const int q = nwg / NXCD, r = nwg % NXCD, xcd = wgid % NXCD, off = wgid / NXCD; wgid = (xcd < r ? xcd * (q + 1) : r * (q + 1) + (xcd - r) * q) + off; }
        const int nig = WGM * nN, gid = wgid / nig, fm = gid * WGM, gsz = (nM - fm) < WGM ? (nM - fm) : WGM;
        u.pm = fm + ((wgid % nig) % gsz); u.pn = (wgid % nig) / gsz; return true;
    }
};

template <class Epi, class Sched, bool ALIGN_EPI>
__device__ __forceinline__ void gemm_phase(int tid_in, LAS unsigned char* lds, const Gemm g, const Sched& S, const Epi& E, unsigned stagger_ticks = 0) {
    if (stagger_ticks) { const unsigned long long t0_ = __builtin_amdgcn_s_memrealtime(); while (__builtin_amdgcn_s_memrealtime() - t0_ < stagger_ticks) __builtin_amdgcn_s_sleep(8); }
    int tid = tid_in; asm volatile("" : "+v"(tid));
    const int wid = __builtin_amdgcn_readfirstlane(tid >> 6), lane = tid & 63, wr = wid >> 2, wc = wid & 3, fr = lane & 15, fq = lane >> 4;
    const int K = g.K, nt = K / BK, lda = g.lda;
    unsigned voffA[2], voffB[2];
#pragma unroll
    for (int i = 0; i < 2; ++i) { int R, C; stage_rc(tid * 16 + i * 8192, R, C); const int Rb = Epi::PERM ? ((R & ~31) + perm32(R & 31)) : R;
        voffA[i] = (unsigned)(R * lda + C) * 2u; voffB[i] = (unsigned)(Rb * K + C) * 2u; }
    const size_t kstep = (size_t)(BK * 2);
    const size_t hstepA = (size_t)HALF * lda * 2, tstepA = 2 * hstepA;
    const size_t hstepB = (size_t)HALF * K * 2, tstepB = 2 * hstepB;
    const unsigned ldsw = (unsigned)wid * 1024u;
    const int aoff = lds_byte(wr * 64 + fr, fq * 8), boff = lds_byte(wc * 32 + fr, fq * 8);
#define PG8_SA(b, h) (((b) * 2 + (h)) * HTB)
#define PG8_SB(b, h) ((4 + (b) * 2 + (h)) * HTB)
#define PG8_STAGE(bufoff, gbase, voff) do { _Pragma("unroll") for (int _i = 0; _i < 2; ++_i) \
        __builtin_amdgcn_global_load_lds((const unsigned*)((const char*)(gbase) + (voff)[_i]), (LAS unsigned*)(lds + (bufoff) + ldsw + _i * 8192), 16, 0, 0); } while (0)
#define PG8_LDA(dst, b, h) do { _Pragma("unroll") for (int m = 0; m < 4; ++m) _Pragma("unroll") for (int k = 0; k < 2; ++k) dst[m][k] = *(const LAS bf16x8*)(lds + PG8_SA(b, h) + aoff + m * 2048 + k * 1024); } while (0)
#define PG8_LDB(dst, b, h) do { _Pragma("unroll") for (int n = 0; n < 2; ++n) _Pragma("unroll") for (int k = 0; k < 2; ++k) dst[n][k] = *(const LAS bf16x8*)(lds + PG8_SB(b, h) + boff + n * 2048 + k * 1024); } while (0)
#define PG8_MMA(ai, bj, At, Bt) do { __builtin_amdgcn_s_setprio(1); _Pragma("unroll") for (int m = 0; m < 4; ++m) _Pragma("unroll") for (int n = 0; n < 2; ++n) _Pragma("unroll") for (int k = 0; k < 2; ++k) \
        acc[ai][bj][m][n] = __builtin_amdgcn_mfma_f32_16x16x32_bf16(Bt[n][k], At[m][k], acc[ai][bj][m][n], 0, 0, 0); __builtin_amdgcn_s_setprio(0); } while (0)
#define PG8_WAIT_V(n) asm volatile("s_waitcnt vmcnt(" #n ")" ::: "memory")
#define PG8_WAIT_L(n) asm volatile("s_waitcnt lgkmcnt(" #n ")" ::: "memory")
#define PG8_BAR __builtin_amdgcn_s_barrier()
#define PG8_SCHED __builtin_amdgcn_sched_barrier(0)
    Unit cur, nxt; int ui = 0;
    if (!S.next(0, cur)) return;
    cur.idx = 0;
    f32x4 acc[2][2][4][2];
#pragma unroll
    for (int a = 0; a < 2; ++a)
#pragma unroll
        for (int b = 0; b < 2; ++b)
#pragma unroll
            for (int m = 0; m < 4; ++m)
#pragma unroll
                for (int n = 0; n < 2; ++n) acc[a][b][m][n] = (f32x4){0.f, 0.f, 0.f, 0.f};
    bf16x8 At[4][2], B0[2][2], B1[2][2];
    const char* cA = (const char*)g.A + (size_t)cur.pm * tstepA; const char* cB = (const char*)g.Bt + (size_t)cur.pn * tstepB;
    PG8_STAGE(PG8_SB(0, 0), cB, voffB); PG8_STAGE(PG8_SB(0, 1), cB + hstepB, voffB); PG8_STAGE(PG8_SA(0, 0), cA, voffA); PG8_STAGE(PG8_SA(0, 1), cA + hstepA, voffA);
    if (wr == 1) PG8_BAR;
    PG8_WAIT_V(2); PG8_BAR;
    PG8_STAGE(PG8_SB(1, 0), cB + kstep, voffB); PG8_STAGE(PG8_SA(1, 0), cA + kstep, voffA); PG8_STAGE(PG8_SB(1, 1), cB + hstepB + kstep, voffB);
    PG8_WAIT_V(6); PG8_BAR;
    for (;;) {
        const bool has_next = S.next(ui + 1, nxt); nxt.idx = ui + 1;
        const char* nA = has_next ? (const char*)g.A + (size_t)nxt.pm * tstepA : cA; const char* nB = has_next ? (const char*)g.Bt + (size_t)nxt.pn * tstepB : cB;
        for (int t = 0; t < nt; t += 2) {
            if constexpr (Epi::HOOK) { if (t == (nt >> 1)) E.mid(acc, cur, wr, wc, fr, fq); }
            const bool last = (t == nt - 2);
            const char* a1 = cA + (size_t)(t + 1) * kstep;
            const char* a2 = last ? nA : cA + (size_t)(t + 2) * kstep; const char* b2 = last ? nB : cB + (size_t)(t + 2) * kstep;
            const char* a3 = a2 + kstep; const char* b3 = b2 + kstep;
            PG8_LDB(B0, 0, 0); PG8_LDB(B1, 0, 1); PG8_SCHED; PG8_LDA(At, 0, 0); PG8_STAGE(PG8_SA(1, 1), a1 + hstepA, voffA);
            PG8_WAIT_V(8); PG8_WAIT_L(0); PG8_BAR; PG8_MMA(0, 0, At, B0); PG8_MMA(0, 1, At, B1); PG8_BAR; PG8_SCHED;
            PG8_LDA(At, 0, 1); PG8_STAGE(PG8_SB(0, 0), b2, voffB); PG8_STAGE(PG8_SB(0, 1), b2 + hstepB, voffB); PG8_STAGE(PG8_SA(0, 0), a2, voffA);
            PG8_WAIT_V(8); PG8_WAIT_L(0); PG8_BAR; PG8_MMA(1, 0, At, B0); PG8_MMA(1, 1, At, B1); PG8_BAR; PG8_SCHED;
            PG8_LDB(B0, 1, 0); PG8_LDB(B1, 1, 1); PG8_SCHED; PG8_LDA(At, 1, 0); PG8_STAGE(PG8_SA(0, 1), a2 + hstepA, voffA);
            PG8_WAIT_V(8); PG8_WAIT_L(0); PG8_BAR; PG8_MMA(0, 0, At, B0); PG8_MMA(0, 1, At, B1); PG8_BAR; PG8_SCHED;
            PG8_LDA(At, 1, 1); PG8_STAGE(PG8_SB(1, 0), b3, voffB); PG8_STAGE(PG8_SB(1, 1), b3 + hstepB, voffB); PG8_STAGE(PG8_SA(1, 0), a3, voffA);
            PG8_WAIT_V(8); PG8_WAIT_L(0); PG8_BAR; PG8_MMA(1, 0, At, B0); PG8_MMA(1, 1, At, B1); PG8_BAR; PG8_SCHED;
        }
        if constexpr (ALIGN_EPI) { if (wr == 0) PG8_BAR; }
        E(acc, cur, wr, wc, fr, fq);
        if (!has_next) break;
#pragma unroll
        for (int a = 0; a < 2; ++a)
#pragma unroll
            for (int b = 0; b < 2; ++b)
#pragma unroll
                for (int m = 0; m < 4; ++m)
#pragma unroll
                    for (int n = 0; n < 2; ++n) acc[a][b][m][n] = (f32x4){0.f, 0.f, 0.f, 0.f};
        cur = nxt; cA = nA; cB = nB; ++ui;
        if constexpr (ALIGN_EPI) { if (wr == 1) PG8_BAR; }
    }
    PG8_WAIT_V(0);
    if constexpr (!ALIGN_EPI) { if (wr == 0) PG8_BAR; }
    PG8_BAR;
#undef PG8_SA
#undef PG8_SB
#undef PG8_STAGE
#undef PG8_LDA
#undef PG8_LDB
#undef PG8_MMA
#undef PG8_WAIT_V
#undef PG8_WAIT_L
#undef PG8_BAR
#undef PG8_SCHED
}

template <class Epi>
__device__ __forceinline__ void gemm128_phase(int tid_in, LAS unsigned char* lds, const bf16_t* A, int lda, const bf16_t* Bt, int K, int row0, int nrt, int nct, int G, int c, const Epi& E) {
    int tid = tid_in; asm volatile("" : "+v"(tid));
    const int wid = __builtin_amdgcn_readfirstlane(tid >> 6), lane = tid & 63, wr = wid >> 2, wc = wid & 3, fr = lane & 15, fq = lane >> 4;
    const int nt = K / BK;
    unsigned voffA[2], voffB[2];
#pragma unroll
    for (int i = 0; i < 2; ++i) { int R, C; stage_rc(tid * 16 + i * 8192, R, C); const int Rb = Epi::PERM ? ((R & ~31) + perm32(R & 31)) : R;
        voffA[i] = (unsigned)(R * lda + C) * 2u; voffB[i] = (unsigned)(Rb * K + C) * 2u; }
    const unsigned ldsw = (unsigned)wid * 1024u;
    const int aoff = lds_byte(wr * 64 + fr, fq * 8), boff = lds_byte(wc * 32 + fr, fq * 8);
#define G1_SA(b) ((b) * HTB)
#define G1_SB(b) ((2 + (b)) * HTB)
#define G1_STAGE(bufoff, gbase, voff) do { _Pragma("unroll") for (int _i = 0; _i < 2; ++_i) \
        __builtin_amdgcn_global_load_lds((const unsigned*)((const char*)(gbase) + (voff)[_i]), (LAS unsigned*)(lds + (bufoff) + ldsw + _i * 8192), 16, 0, 0); } while (0)
    for (int L = c; L < nrt * nct; L += G) {
        const int pm = L / nct, pn = L % nct;
        const int rowbase = row0 + pm * 128, colbase = pn * 128;
        const char* cA = (const char*)A + (size_t)rowbase * lda * 2; const char* cB = (const char*)Bt + (size_t)colbase * K * 2;
        f32x4 acc[1][1][4][2];
#pragma unroll
        for (int m = 0; m < 4; ++m)
#pragma unroll
            for (int n = 0; n < 2; ++n) acc[0][0][m][n] = (f32x4){0.f, 0.f, 0.f, 0.f};
        G1_STAGE(G1_SA(0), cA, voffA); G1_STAGE(G1_SB(0), cB, voffB);
        for (int kt = 0; kt < nt; ++kt) {
            const int b = kt & 1;
            if (kt + 1 < nt) { G1_STAGE(G1_SA(b ^ 1), cA + (size_t)(kt + 1) * (BK * 2), voffA); G1_STAGE(G1_SB(b ^ 1), cB + (size_t)(kt + 1) * (BK * 2), voffB); }
            if constexpr (Epi::HOOK) { if (kt == (nt >> 1)) E.mid128(acc, rowbase, colbase, wr, wc, fr, fq); }
            if (kt + 1 < nt) asm volatile("s_waitcnt vmcnt(4)" ::: "memory"); else asm volatile("s_waitcnt vmcnt(0)" ::: "memory");
            __builtin_amdgcn_s_barrier();
            bf16x8 At[4][2], Bf[2][2];
#pragma unroll
            for (int m = 0; m < 4; ++m)
#pragma unroll
                for (int k = 0; k < 2; ++k) At[m][k] = *(const LAS bf16x8*)(lds + G1_SA(b) + aoff + m * 2048 + k * 1024);
#pragma unroll
            for (int n = 0; n < 2; ++n)
#pragma unroll
                for (int k = 0; k < 2; ++k) Bf[n][k] = *(const LAS bf16x8*)(lds + G1_SB(b) + boff + n * 2048 + k * 1024);
            asm volatile("s_waitcnt lgkmcnt(0)" ::: "memory");
#pragma unroll
            for (int m = 0; m < 4; ++m)
#pragma unroll
                for (int n = 0; n < 2; ++n)
#pragma unroll
                    for (int k = 0; k < 2; ++k) acc[0][0][m][n] = __builtin_amdgcn_mfma_f32_16x16x32_bf16(Bf[n][k], At[m][k], acc[0][0][m][n], 0, 0, 0);
            __builtin_amdgcn_s_barrier();
        }
        E.end128(acc, rowbase, colbase, wr, wc, fr, fq);
    }
    asm volatile("s_waitcnt vmcnt(0)" ::: "memory"); __builtin_amdgcn_s_barrier();
#undef G1_SA
#undef G1_SB
#undef G1_STAGE
}
}

struct EpiG1 {
    static constexpr bool PERM = true, HOOK = false;
    bf16_t* P; const float* sb; LAS unsigned char* ldsc; int skip;
    __device__ __forceinline__ void mid(f32x4 (&)[2][2][4][2], const pg8::Unit&, int, int, int, int) const {}
    __device__ __forceinline__ void operator()(const f32x4 (&acc)[2][2][4][2], const pg8::Unit& u, int wr, int wc, int fr, int fq) const {
        if (skip == 2) { if (acc[0][0][0][0][0] == 12345.678f) P[0] = 1; return; }
        asm volatile("" : "+v"(fr), "+v"(fq));
        const bool latent = u.pm < 128;
        const int bidx = latent ? (u.pm >> 3) : 16;
        const int col8 = u.pn * 256 + wc * 32 + 8 * fq;
        const float* sbr = sb + bidx * NIN + col8;
        f32x4 bv[2][2];
#pragma unroll
        for (int bj = 0; bj < 2; ++bj)
#pragma unroll
            for (int n = 0; n < 2; ++n) bv[bj][n] = *(const f32x4*)(sbr + bj * 128 + n * 4);
        const bool isq = (u.pn == 8 || u.pn == 9), isk = (u.pn == 10);
        const bool anyrope = latent && (isq || isk);
        const float sc = isq ? QSCALE : 1.0f;
        float rinv[8];
        {   const LAS float* rt = (const LAS float*)(ldsc + LDS_RINV_OFF) + u.idx * 256 + wr * 64 + fr;
#pragma unroll
            for (int i = 0; i < 8; ++i) rinv[i] = rt[(i >> 2) * 128 + (i & 3) * 16]; }
        bf16_t* pb = P + (size_t)u.pm * 256 * NCOL;
        if (u.pn < 8) {
            const bool iscu = u.pn < 4;
            const unsigned lo2 = (unsigned)((wr * 64 + fr) * NCOL + (iscu ? C_CU + u.pn * 128 : C_BZ + (u.pn - 4) * 128) + wc * 32 + 8 * fq);
#pragma unroll
            for (int ai = 0; ai < 2; ++ai)
#pragma unroll
                for (int m = 0; m < 4; ++m) {
                    const float ri = rinv[ai * 4 + m];
                    bf16_t* rowp = pb + (size_t)(ai * 128 + m * 16) * NCOL;
                    const f32x4 a0 = acc[ai][0][m][0] * ri + bv[0][0], a1 = acc[ai][0][m][1] * ri + bv[0][1];
                    const f32x4 b0 = acc[ai][1][m][0] * ri + bv[1][0], b1 = acc[ai][1][m][1] * ri + bv[1][1];
                    f32x4 o0, o1;
                    if (iscu) { o0 = a0 * b0; o1 = a1 * b1; }
                    else {
#pragma unroll
                        for (int e = 0; e < 4; ++e) { o0[e] = a0[e] * siluf_(b0[e]); o1[e] = a1[e] * siluf_(b1[e]); } }
                    u32x4 w; w.x = cvt_pk_bf16(o0[0], o0[1]); w.y = cvt_pk_bf16(o0[2], o0[3]); w.z = cvt_pk_bf16(o1[0], o1[1]); w.w = cvt_pk_bf16(o1[2], o1[3]);
                    *(u32x4*)(rowp + lo2) = w;
                }
            return;
        }
        if (u.pn >= 13) {
            const unsigned lo3 = (unsigned)((wr * 64 + fr) * NCOL + (u.pn - 13) * 128 + wc * 32 + 8 * fq);
#pragma unroll
            for (int ai = 0; ai < 2; ++ai)
#pragma unroll
                for (int m = 0; m < 4; ++m) {
                    const float ri = rinv[ai * 4 + m];
                    bf16_t* rowp = pb + (size_t)(ai * 128 + m * 16) * NCOL;
                    const f32x4 a0 = acc[ai][0][m][0] * ri + bv[0][0], a1 = acc[ai][0][m][1] * ri + bv[0][1];
                    const f32x4 b0 = acc[ai][1][m][0] * ri + bv[1][0], b1 = acc[ai][1][m][1] * ri + bv[1][1];
                    f32x4 r0, r1, s0, s1;
#pragma unroll
                    for (int e = 0; e < 4; ++e) {
                        const float ea0 = 1.0f + fast_exp(-a0[e]), eb0 = 1.0f + fast_exp(-b0[e]), ea1 = 1.0f + fast_exp(-a1[e]), eb1 = 1.0f + fast_exp(-b1[e]);
                        r0[e] = eb0 * __builtin_amdgcn_rcpf(ea0); s0[e] = __builtin_amdgcn_rcpf(eb0); r1[e] = eb1 * __builtin_amdgcn_rcpf(ea1); s1[e] = __builtin_amdgcn_rcpf(eb1); }
                    u32x4 wr_, ws_;
                    wr_.x = cvt_pk_bf16(r0[0], r0[1]); wr_.y = cvt_pk_bf16(r0[2], r0[3]); wr_.z = cvt_pk_bf16(r1[0], r1[1]); wr_.w = cvt_pk_bf16(r1[2], r1[3]);
                    ws_.x = cvt_pk_bf16(s0[0], s0[1]); ws_.y = cvt_pk_bf16(s0[2], s0[3]); ws_.z = cvt_pk_bf16(s1[0], s1[1]); ws_.w = cvt_pk_bf16(s1[2], s1[3]);
                    *(u32x4*)(rowp + (lo3 + (unsigned)C_GA)) = wr_; *(u32x4*)(rowp + (lo3 + (unsigned)C_GB)) = ws_;
                }
            return;
        }
        const unsigned lo = (unsigned)((wr * 64 + fr) * NCOL + C_Q + (u.pn - 8) * 256 + wc * 32 + 8 * fq);
        if (!anyrope) {
#pragma unroll
            for (int ai = 0; ai < 2; ++ai)
#pragma unroll
                for (int m = 0; m < 4; ++m) {
                    const float ri = rinv[ai * 4 + m];
                    bf16_t* rowp = pb + (size_t)(ai * 128 + m * 16) * NCOL;
#pragma unroll
                    for (int bj = 0; bj < 2; ++bj) {
                        const f32x4 v0 = (acc[ai][bj][m][0] * ri + bv[bj][0]) * sc, v1 = (acc[ai][bj][m][1] * ri + bv[bj][1]) * sc;
                        u32x4 w; w.x = cvt_pk_bf16(v0[0], v0[1]); w.y = cvt_pk_bf16(v0[2], v0[3]); w.z = cvt_pk_bf16(v1[0], v1[1]); w.w = cvt_pk_bf16(v1[2], v1[3]);
                        *(u32x4*)(rowp + (lo + (unsigned)(bj * 128))) = w;
                    }
                }
        } else {
            const LAS f32x4* tc4 = (const LAS f32x4*)(ldsc + LDS_ROPE_OFF);
            const LAS f32x4* ts4 = tc4 + 256;
            const float sgn = (fq < 2) ? -1.0f : 1.0f;
            const bool oddw = (wc & 1) != 0;
#pragma unroll
            for (int ai = 0; ai < 2; ++ai)
#pragma unroll
                for (int m = 0; m < 4; ++m) {
                    const int t = (u.pm * 256 + ai * 128 + wr * 64 + m * 16 + fr) & 2047;
                    const int pos = oddw ? (t & 63) : (t >> 6);
                    const int ti = pos * 4 + (fq & 1) * 2;
                    const f32x4 c0 = tc4[ti], c1 = tc4[ti + 1], s0 = ts4[ti], s1 = ts4[ti + 1];
                    const float ri = rinv[ai * 4 + m];
                    bf16_t* rowp = pb + (size_t)(ai * 128 + m * 16) * NCOL;
#pragma unroll
                    for (int bj = 0; bj < 2; ++bj) {
                        f32x4 v0 = acc[ai][bj][m][0] * ri + bv[bj][0], v1 = acc[ai][bj][m][1] * ri + bv[bj][1];
                        if (isq || bj == 0) {
                            f32x4 p0, p1;
#pragma unroll
                            for (int e = 0; e < 4; ++e) { p0[e] = shx(v0[e], fq * 16 + fr, 32); p1[e] = shx(v1[e], fq * 16 + fr, 32); }
                            v0 = v0 * c0 + (p0 * s0) * sgn; v1 = v1 * c1 + (p1 * s1) * sgn;
                        }
                        v0 = v0 * sc; v1 = v1 * sc;
                        u32x4 w; w.x = cvt_pk_bf16(v0[0], v0[1]); w.y = cvt_pk_bf16(v0[2], v0[3]); w.z = cvt_pk_bf16(v1[0], v1[1]); w.w = cvt_pk_bf16(v1[2], v1[3]);
                        *(u32x4*)(rowp + (lo + (unsigned)(bj * 128))) = w;
                    }
                }
        }
    }
};

struct EpiG2 {
    static constexpr bool PERM = true, HOOK = true; static constexpr int NST = 16;
    const bf16_t* P; bf16_t* Mout; int ldm, mcol;
    template <int NAI, int NBJ> __device__ __forceinline__ void mid_t(f32x4 (&acc)[NAI][NBJ][4][2], int rowbase, int colbase, int wr, int wc, int fr, int fq) const {
        int col8 = colbase + wc * 32 + 8 * fq, rbase = rowbase + wr * 64 + fr;
        asm volatile("" : "+v"(col8), "+v"(rbase));
        u32x4 rr[NAI][4][NBJ];
#pragma unroll
        for (int ai = 0; ai < NAI; ++ai)
#pragma unroll
            for (int m = 0; m < 4; ++m) { const bf16_t* rowp = P + (size_t)(rbase + ai * 128 + m * 16) * NCOL + col8;
#pragma unroll
                for (int bj = 0; bj < NBJ; ++bj) rr[ai][m][bj] = *(const u32x4*)(rowp + C_GA + bj * 128); }
#pragma unroll
        for (int ai = 0; ai < NAI; ++ai)
#pragma unroll
            for (int m = 0; m < 4; ++m)
#pragma unroll
                for (int bj = 0; bj < NBJ; ++bj)
#pragma unroll
                    for (int w = 0; w < 4; ++w) { acc[ai][bj][m][w >> 1][(w & 1) * 2] *= bf_lo(rr[ai][m][bj][w]); acc[ai][bj][m][w >> 1][(w & 1) * 2 + 1] *= bf_hi(rr[ai][m][bj][w]); }
    }
    template <int NAI, int NBJ> __device__ __forceinline__ void end_t(const f32x4 (&acc)[NAI][NBJ][4][2], int rowbase, int colbase, int wr, int wc, int fr, int fq) const {
        asm volatile("" : "+v"(fr), "+v"(fq));
        const int col8 = colbase + wc * 32 + 8 * fq, rbase = rowbase + wr * 64 + fr;
        u32x4 gb[NAI][4][NBJ];
#pragma unroll
        for (int ai = 0; ai < NAI; ++ai)
#pragma unroll
            for (int m = 0; m < 4; ++m) { const bf16_t* rowp = P + (size_t)(rbase + ai * 128 + m * 16) * NCOL + col8;
#pragma unroll
                for (int bj = 0; bj < NBJ; ++bj) gb[ai][m][bj] = *(const u32x4*)(rowp + C_GB + bj * 128); }
#pragma unroll
        for (int ai = 0; ai < NAI; ++ai)
#pragma unroll
            for (int m = 0; m < 4; ++m) {
                bf16_t* mrow = Mout + (size_t)(rbase + ai * 128 + m * 16) * ldm + mcol + col8;
#pragma unroll
                for (int bj = 0; bj < NBJ; ++bj) {
                    u32x4 o;
#pragma unroll
                    for (int w = 0; w < 4; ++w)
                        o[w] = cvt_pk_bf16(acc[ai][bj][m][w >> 1][(w & 1) * 2] * bf_lo(gb[ai][m][bj][w]), acc[ai][bj][m][w >> 1][(w & 1) * 2 + 1] * bf_hi(gb[ai][m][bj][w]));
                    *(u32x4*)(mrow + bj * 128) = o;
                }
            }
    }
    __device__ __forceinline__ void mid(f32x4 (&acc)[2][2][4][2], const pg8::Unit& u, int wr, int wc, int fr, int fq) const { mid_t<2, 2>(acc, u.pm * 256, u.pn * 256, wr, wc, fr, fq); }
    __device__ __forceinline__ void operator()(const f32x4 (&acc)[2][2][4][2], const pg8::Unit& u, int wr, int wc, int fr, int fq) const { end_t<2, 2>(acc, u.pm * 256, u.pn * 256, wr, wc, fr, fq); }
    __device__ __forceinline__ void mid128(f32x4 (&acc)[1][1][4][2], int rowbase, int colbase, int wr, int wc, int fr, int fq) const { mid_t<1, 1>(acc, rowbase, colbase, wr, wc, fr, fq); }
    __device__ __forceinline__ void end128(const f32x4 (&acc)[1][1][4][2], int rowbase, int colbase, int wr, int wc, int fr, int fq) const { end_t<1, 1>(acc, rowbase, colbase, wr, wc, fr, fq); }
};

#if RESID_BF16
typedef bf16_t resid_t;
#else
typedef float resid_t;
#endif
struct EpiG3 {
    static constexpr bool PERM = true, HOOK = false;
    const resid_t* xin_lat; const resid_t* xin_ctx; resid_t* xout_lat; resid_t* xout_ctx; const float* gate; const float* nw; bf16_t* xs; float* ssp; LAS unsigned char* ldsc;
    __device__ __forceinline__ void mid(f32x4 (&)[2][2][4][2], const pg8::Unit&, int, int, int, int) const {}
    template <int NAI, int NBJ> __device__ __forceinline__ void end_t(f32x4 (&acc)[NAI][NBJ][4][2], int rowbase, int colbase, int wr, int wc, int fr, int fq) const {
        asm volatile("" : "+v"(fr), "+v"(fq));
        const bool latent = rowbase < TL;
        const int bidx = latent ? (rowbase >> 11) : 16;
        const int col8 = colbase + wc * 32 + 8 * fq;
        {
            f32x4 gv[NBJ][2];
#pragma unroll
            for (int bj = 0; bj < NBJ; ++bj)
#pragma unroll
                for (int n = 0; n < 2; ++n) gv[bj][n] = gate ? *(const f32x4*)(gate + bidx * 3072 + col8 + bj * 128 + n * 4) : (f32x4){0.f, 0.f, 0.f, 0.f};
#pragma unroll
            for (int ai = 0; ai < NAI; ++ai)
#pragma unroll
                for (int bj = 0; bj < NBJ; ++bj)
#pragma unroll
                    for (int m = 0; m < 4; ++m)
#pragma unroll
                        for (int n = 0; n < 2; ++n) acc[ai][bj][m][n] = acc[ai][bj][m][n] * gv[bj][n];
        }
        LAS f32x4* nvl = (LAS f32x4*)(ldsc + LDS_EPI_OFF + (wr * 4 + wc) * 256);
        if (nw) { const int ln = fq * 16 + fr; if (ln < 8 * NBJ) nvl[ln] = *(const f32x4*)(nw + bidx * 1024 + colbase + wc * 32 + (ln >> 3) * 128 + ((ln >> 1) & 3) * 8 + (ln & 1) * 4); }
        unsigned lo = (unsigned)((wr * 64 + fr) * DM + col8); asm volatile("" : "+v"(lo));
        const resid_t* xib = latent ? xin_lat + (size_t)rowbase * DM : xin_ctx + (size_t)(rowbase - TL) * DM;
        resid_t* xob = latent ? xout_lat + (size_t)rowbase * DM : xout_ctx + (size_t)(rowbase - TL) * DM;
        bf16_t* xsb = xs + (size_t)rowbase * DM;
        float* sspb = ssp + (size_t)rowbase * NSS + (colbase >> 5) + wc;
#if RESID_BF16
#pragma unroll
        for (int ai = 0; ai < NAI; ++ai) {
            u32x4 xv[4][NBJ];
#pragma unroll
            for (int m = 0; m < 4; ++m)
#pragma unroll
                for (int bj = 0; bj < NBJ; ++bj) xv[m][bj] = *(const u32x4*)(xib + (size_t)(ai * 128 + m * 16) * DM + (lo + (unsigned)(bj * 128)));
#pragma unroll
            for (int m = 0; m < 4; ++m) {
#else
#pragma unroll
        for (int ai = 0; ai < NAI; ++ai)
#pragma unroll
        for (int mh = 0; mh < 2; ++mh) {
            f32x4 xv[2][NBJ][2];
#pragma unroll
            for (int m2 = 0; m2 < 2; ++m2)
#pragma unroll
                for (int bj = 0; bj < NBJ; ++bj)
#pragma unroll
                    for (int n = 0; n < 2; ++n) xv[m2][bj][n] = *(const f32x4*)(xib + (size_t)(ai * 128 + (mh * 2 + m2) * 16) * DM + (lo + (unsigned)(bj * 128 + n * 4)));
#pragma unroll
            for (int m2 = 0; m2 < 2; ++m2) { const int m = mh * 2 + m2;
#endif
                resid_t* xo = xob + (size_t)(ai * 128 + m * 16) * DM; bf16_t* xsr = xsb + (size_t)(ai * 128 + m * 16) * DM;
#pragma unroll
                for (int bj = 0; bj < NBJ; ++bj) {
                    const unsigned off = lo + (unsigned)(bj * 128);
#if RESID_BF16
                    const u32x4 xr = xv[m][bj];
                    const f32x4 x0 = (f32x4){r16_lo(xr[0]), r16_hi(xr[0]), r16_lo(xr[1]), r16_hi(xr[1])} + acc[ai][bj][m][0];
                    const f32x4 x1 = (f32x4){r16_lo(xr[2]), r16_hi(xr[2]), r16_lo(xr[3]), r16_hi(xr[3])} + acc[ai][bj][m][1];
                    u32x4 w; w.x = r16_pk(x0[0], x0[1]); w.y = r16_pk(x0[2], x0[3]); w.z = r16_pk(x1[0], x1[1]); w.w = r16_pk(x1[2], x1[3]);
                    *(u32x4*)(xo + off) = w;
#else
                    const f32x4 x0 = xv[m2][bj][0] + acc[ai][bj][m][0], x1 = xv[m2][bj][1] + acc[ai][bj][m][1];
                    *(f32x4*)(xo + off) = x0; *(f32x4*)(xo + off + 4) = x1;
#endif
                    float q = ((x0[0] * x0[0] + x0[1] * x0[1]) + (x0[2] * x0[2] + x0[3] * x0[3])) + ((x1[0] * x1[0] + x1[1] * x1[1]) + (x1[2] * x1[2] + x1[3] * x1[3]));
                    q += shx(q, fq * 16 + fr, 16); q += shx(q, fq * 16 + fr, 32);
                    if (fq == 0) sspb[(unsigned)((ai * 128 + wr * 64 + m * 16 + fr) * NSS + bj * 4)] = q;
                    if (nw) { const f32x4 h0 = x0 * nvl[bj * 8 + fq * 2], h1 = x1 * nvl[bj * 8 + fq * 2 + 1];
                        u32x4 ws_; ws_.x = cvt_pk_bf16(h0[0], h0[1]); ws_.y = cvt_pk_bf16(h0[2], h0[3]); ws_.z = cvt_pk_bf16(h1[0], h1[1]); ws_.w = cvt_pk_bf16(h1[2], h1[3]);
                        *(u32x4*)(xsr + off) = ws_; }
                }
            }
            asm volatile("" ::: "memory");
        }
    }
    __device__ __forceinline__ void operator()(f32x4 (&acc)[2][2][4][2], const pg8::Unit& u, int wr, int wc, int fr, int fq) const { end_t<2, 2>(acc, u.pm * 256, u.pn * 256, wr, wc, fr, fq); }
    __device__ __forceinline__ void end128(f32x4 (&acc)[1][1][4][2], int rowbase, int colbase, int wr, int wc, int fr, int fq) const { end_t<1, 1>(acc, rowbase, colbase, wr, wc, fr, fq); }
};

__device__ __forceinline__ s16x4 vtr(const LAS unsigned char* p) { return __builtin_bit_cast(s16x4, __builtin_amdgcn_ds_read_tr16_b64_v4i16((LAS v4i16_t*)p)); }

struct AUnit { int rowQ0, h, kh, qq0, nloc, jlo, kr_loc0, kr_ctx0; };
__device__ __forceinline__ AUnit aunit(int ua, int wave, int nlat) {
    AUnit D;
    if (ua < nlat) { const int b = ua >> 6, rem = ua & 63, qblk = rem >> 2, kh = (rem >> 1) & 1, hp = rem & 1;
        D.h = kh * 4 + hp * 2 + (wave >> 2); D.kh = kh; D.qq0 = (wave & 3) * 32; D.rowQ0 = b * SEQ + qblk * 128 + D.qq0;
        D.jlo = (qblk == 0) ? 2 : 0; D.nloc = ((qblk == 15) ? 4 : 6) - D.jlo; D.kr_loc0 = b * SEQ + qblk * 128 - 128; D.kr_ctx0 = TL + b * CTXL;
    } else { const int uc = ua - nlat, b = uc >> 3, h = uc & 7;
        D.h = h; D.kh = h >> 2; D.qq0 = 0; D.rowQ0 = TL + b * CTXL + wave * 32; D.jlo = 0; D.nloc = 0; D.kr_loc0 = 0; D.kr_ctx0 = TL + b * CTXL; }
    return D;
}
__device__ __forceinline__ void wait_vm_n(int n) {
    switch (n) {
        case 2: asm volatile("s_waitcnt vmcnt(2)" ::: "memory"); break;
        case 8: asm volatile("s_waitcnt vmcnt(8)" ::: "memory"); break;
        case 10: asm volatile("s_waitcnt vmcnt(10)" ::: "memory"); break;
        case 12: asm volatile("s_waitcnt vmcnt(12)" ::: "memory"); break;
        case 14: asm volatile("s_waitcnt vmcnt(14)" ::: "memory"); break;
        case 16: asm volatile("s_waitcnt vmcnt(16)" ::: "memory"); break;
        case 18: asm volatile("s_waitcnt vmcnt(18)" ::: "memory"); break;
        case 20: asm volatile("s_waitcnt vmcnt(20)" ::: "memory"); break;
        case 22: asm volatile("s_waitcnt vmcnt(22)" ::: "memory"); break;
        default: asm volatile("s_waitcnt vmcnt(0)" ::: "memory"); break;
    }
}
__device__ __forceinline__ void attn_phase2(LAS unsigned char* lds, int tid, const bf16_t* P, bf16_t* Oout, int opitch, int ocol, const float* sink, int bx, int G, int nlat, int ntot, int variant = 0) {
    const int lane = tid & 63, r32 = lane & 31, hi = lane >> 5;
    const int wid = __builtin_amdgcn_readfirstlane(tid >> 6);
    if (bx >= ntot) return;
    const size_t kofl = (size_t)lane * NCOL + C_K + wid * 8;
    const size_t vofl = (size_t)(16 * (wid & 3) + (lane >> 2)) * NCOL + C_V + (wid >> 2) * 32 + (lane & 3) * 8;
    int ua_c = bx, ua_s = bx;
    AUnit Dc = aunit(ua_c, wid, nlat), Ds = Dc, Dn = Dc;
    int ts = 0, NTs = Ds.nloc + 4, tc = 0, NTc = NTs, sslot = 0, cslot = 0;
    bf16x8 qr[4], qn[4]; u32x2 zb[8];
#pragma unroll
    for (int i = 0; i < 4; ++i) qn[i] = (bf16x8){0, 0, 0, 0, 0, 0, 0, 0};
#pragma unroll
    for (int i = 0; i < 8; ++i) zb[i] = (u32x2){0u, 0u};
    {   const bf16_t* qp = P + (size_t)(Dc.rowQ0 + r32) * NCOL + C_Q + Dc.h * 64 + hi * 8;
#pragma unroll
        for (int d0 = 0; d0 < 4; ++d0) qr[d0] = *(const bf16x8*)(qp + d0 * 16); }
    int nx = 0;
#define AT2_STAGE_NEXT() do { nx = 0; if (ua_s < ntot) { \
        if (ts == NTs - 1) {     \
            const bf16_t* zp_ = P + (size_t)(Ds.rowQ0 + r32) * NCOL + C_ZB + Ds.h * 64 + 4 * hi; \
            _Pragma("unroll") for (int i_ = 0; i_ < 8; ++i_) zb[i_] = *(const u32x2*)(zp_ + (i_ >> 2) * 32 + (i_ & 3) * 8); \
            nx += 8; \
            if (ua_s + G < ntot) { Dn = aunit(ua_s + G, wid, nlat); const bf16_t* qp_ = P + (size_t)(Dn.rowQ0 + r32) * NCOL + C_Q + Dn.h * 64 + hi * 8; \
                _Pragma("unroll") for (int d0_ = 0; d0_ < 4; ++d0_) qn[d0_] = *(const bf16x8*)(qp_ + d0_ * 16); nx += 4; } } \
        const int kr0_ = (ts < Ds.nloc) ? Ds.kr_loc0 + 64 * (Ds.jlo + ts) : Ds.kr_ctx0 + 64 * (ts - Ds.nloc); const bf16_t* tb_ = P + (size_t)kr0_ * NCOL + Ds.kh * 64; \
        if (variant != 2) { __builtin_amdgcn_global_load_lds((const unsigned*)(tb_ + kofl), (LAS unsigned*)(lds + sslot * 16384 + wid * 1024), 16, 0, 0); \
        __builtin_amdgcn_global_load_lds((const unsigned*)(tb_ + vofl), (LAS unsigned*)(lds + sslot * 16384 + 8192 + wid * 1024), 16, 0, 0); \
        nx += 2; } sslot = (sslot == 2) ? 0 : sslot + 1; ++ts; \
        if (ts == NTs) { ua_s += G; if (ua_s < ntot) { Ds = Dn; ts = 0; NTs = Ds.nloc + 4; } } } } while (0)
    AT2_STAGE_NEXT(); AT2_STAGE_NEXT();
    asm volatile("s_waitcnt vmcnt(2)" ::: "memory"); __builtin_amdgcn_s_barrier(); asm volatile("" ::: "memory");
    f32x16 o0, o1;
#pragma unroll
    for (int i = 0; i < 16; ++i) { o0[i] = 0.f; o1[i] = 0.f; }
    float mrun = sink[Dc.h] * LOG2E, lrun = hi ? 0.f : 1.f;
    int nst = 0;
    for (;;) {
        AT2_STAGE_NEXT();
        const bool local = tc < Dc.nloc; const int j = Dc.jlo + tc;
        const bool need = (variant != 1) && (!local || !((j == 0 && Dc.qq0 >= 64) || (j == 5 && Dc.qq0 < 64)));
        if (need) {
            const int qq = Dc.qq0 + r32;
            const LAS unsigned char* kb = lds + cslot * 16384 + hi * 1024 + r32 * 16;
            f32x16 p0, p1;
#pragma unroll
            for (int i = 0; i < 16; ++i) { p0[i] = 0.f; p1[i] = 0.f; }
#pragma unroll
            for (int d0 = 0; d0 < 4; ++d0) {
                const bf16x8 b0 = *(const LAS bf16x8*)(kb + d0 * 2048);
                const bf16x8 b1 = *(const LAS bf16x8*)(kb + d0 * 2048 + 512);
                p0 = __builtin_amdgcn_mfma_f32_32x32x16_bf16(b0, qr[d0], p0, 0, 0, 0);
                p1 = __builtin_amdgcn_mfma_f32_32x32x16_bf16(b1, qr[d0], p1, 0, 0, 0);
            }
            if (local) {
                if (j < 2) { const int lim = qq - 64 * j;
#pragma unroll
                    for (int i = 0; i < 16; ++i) { const int kk = (i & 3) + 8 * (i >> 2) + 4 * hi; if (kk < lim) p0[i] = -1e30f; if (kk + 32 < lim) p1[i] = -1e30f; }
                } else if (j >= 4) { const int lim = qq - 64 * (j - 4);
#pragma unroll
                    for (int i = 0; i < 16; ++i) { const int kk = (i & 3) + 8 * (i >> 2) + 4 * hi; if (kk > lim) p0[i] = -1e30f; if (kk + 32 > lim) p1[i] = -1e30f; }
                }
            }
            float rm = fmaxf(p0[0], p1[0]);
#pragma unroll
            for (int i = 1; i < 16; ++i) rm = fmaxf(rm, fmaxf(p0[i], p1[i]));
            rm = fmaxf(rm, shx(rm, lane, 32));
            const float mn = fmaxf(mrun, rm);
            if (__any(mn > mrun)) {
                const float f = __builtin_amdgcn_exp2f(mrun - mn);
                lrun *= f;
#pragma unroll
                for (int i = 0; i < 16; ++i) { o0[i] *= f; o1[i] *= f; }
                mrun = mn;
            }
            float ps = 0.f;
#pragma unroll
            for (int i = 0; i < 16; ++i) { p0[i] = __builtin_amdgcn_exp2f(p0[i] - mrun); p1[i] = __builtin_amdgcn_exp2f(p1[i] - mrun); ps += p0[i] + p1[i]; }
            lrun += ps;
            u32x4 pw[4];
#pragma unroll
            for (int w = 0; w < 4; ++w) { pw[0][w] = cvt_pk_bf16(p0[2 * w], p0[2 * w + 1]); pw[1][w] = cvt_pk_bf16(p0[8 + 2 * w], p0[8 + 2 * w + 1]);
                pw[2][w] = cvt_pk_bf16(p1[2 * w], p1[2 * w + 1]); pw[3][w] = cvt_pk_bf16(p1[8 + 2 * w], p1[8 + 2 * w + 1]); }
            const LAS unsigned char* vp = lds + cslot * 16384 + 8192 + ((lane >> 4) & 1) * 32 + (lane & 3) * 8 + (4 * hi + ((lane & 15) >> 2)) * 64;
#pragma unroll
            for (int s = 0; s < 4; ++s) {
                const s16x4 l0 = vtr(vp + s * 1024), h0 = vtr(vp + s * 1024 + 512);
                const s16x4 l1 = vtr(vp + 4096 + s * 1024), h1 = vtr(vp + 4096 + s * 1024 + 512);
                const bf16x8 v0 = (bf16x8){l0[0], l0[1], l0[2], l0[3], h0[0], h0[1], h0[2], h0[3]};
                const bf16x8 v1 = (bf16x8){l1[0], l1[1], l1[2], l1[3], h1[0], h1[1], h1[2], h1[3]};
                const bf16x8 pa = __builtin_bit_cast(bf16x8, pw[s]);
                o0 = __builtin_amdgcn_mfma_f32_32x32x16_bf16(v0, pa, o0, 0, 0, 0);
                o1 = __builtin_amdgcn_mfma_f32_32x32x16_bf16(v1, pa, o1, 0, 0, 0);
            }
        }
        wait_vm_n(nx + nst); nst = 0;
        asm volatile("s_waitcnt lgkmcnt(0)" ::: "memory"); __builtin_amdgcn_s_barrier(); asm volatile("" ::: "memory");
        cslot = (cslot == 2) ? 0 : cslot + 1; ++tc;
        if (tc == NTc) {
            lrun += shx(lrun, lane, 32);
            const float inv = 1.0f / lrun;
            bf16_t* oo = Oout + (size_t)(Dc.rowQ0 + r32) * opitch + ocol + Dc.h * 64 + 4 * hi;
#pragma unroll
            for (int d0 = 0; d0 < 2; ++d0)
#pragma unroll
                for (int gq = 0; gq < 4; ++gq) {
                    const u32x2 z = zb[d0 * 4 + gq];
                    const float a0 = (d0 ? o1[4 * gq + 0] : o0[4 * gq + 0]) * inv * siluf_(bf_lo(z.x));
                    const float a1 = (d0 ? o1[4 * gq + 1] : o0[4 * gq + 1]) * inv * siluf_(bf_hi(z.x));
                    const float a2 = (d0 ? o1[4 * gq + 2] : o0[4 * gq + 2]) * inv * siluf_(bf_lo(z.y));
                    const float a3 = (d0 ? o1[4 * gq + 3] : o0[4 * gq + 3]) * inv * siluf_(bf_hi(z.y));
                    u32x2 w; w.x = cvt_pk_bf16(a0, a1); w.y = cvt_pk_bf16(a2, a3);
                    *(u32x2*)(oo + d0 * 32 + gq * 8) = w;
                }
            nst = 8;
            ua_c += G; if (ua_c >= ntot) break;
            Dc = aunit(ua_c, wid, nlat); tc = 0; NTc = Dc.nloc + 4;
#pragma unroll
            for (int d0 = 0; d0 < 4; ++d0) qr[d0] = qn[d0];
#pragma unroll
            for (int i = 0; i < 16; ++i) { o0[i] = 0.f; o1[i] = 0.f; }
            mrun = sink[Dc.h] * LOG2E; lrun = hi ? 0.f : 1.f;
        }
    }
#undef AT2_STAGE_NEXT
    asm volatile("s_waitcnt vmcnt(0) lgkmcnt(0)" ::: "memory"); __builtin_amdgcn_s_barrier(); asm volatile("" ::: "memory");
}

namespace at3 {
constexpr int NSLOT = 3, SLOTB = 8192;
constexpr int LDS_K = 0, LDS_V = NSLOT * SLOTB, LDS_WS = 2 * NSLOT * SLOTB, LDS_OST = LDS_WS + 8 * 64 * 4, LDS_Z = LDS_OST + 8 * 4096, LDS_Q = LDS_Z + 8 * 4096, LDS_TOTAL = LDS_Q + 8 * 4096;
__device__ __forceinline__ int crow(int r, int hi) { return (r & 3) + 8 * (r >> 2) + 4 * hi; }
#define SBAR() __builtin_amdgcn_sched_barrier(0)
__device__ __forceinline__ void glds16(const void* sbase, unsigned voff, unsigned lds_dst) { unsigned keep;
    asm volatile("s_mov_b32 %0, m0\n\ts_mov_b32 m0, %3\n\ts_nop 4\n\tglobal_load_lds_dwordx4 %1, %2\n\ts_mov_b32 m0, %0" : "=&s"(keep) : "v"(voff), "s"(sbase), "s"(lds_dst) : "memory"); }
__device__ __forceinline__ float max3f(float a, float b, float c) { float r; asm("v_max3_f32 %0, %1, %2, %3" : "=v"(r) : "v"(a), "v"(b), "v"(c)); return r; }
__device__ __forceinline__ float max2f(float a, float b) { float r; asm("v_max_f32_e32 %0, %1, %2" : "=v"(r) : "v"(a), "v"(b)); return r; }
__device__ __forceinline__ float fadd_s(float a, float b) { float r; asm("v_add_f32_e32 %0, %1, %2" : "=v"(r) : "v"(a), "v"(b)); return r; }
__device__ __forceinline__ float fsub_s(float a, float b) { float r; asm("v_sub_f32_e32 %0, %1, %2" : "=v"(r) : "v"(a), "v"(b)); return r; }
typedef float f32x2_t __attribute__((ext_vector_type(2))); typedef __bf16 bf16x2_t __attribute__((ext_vector_type(2)));
__device__ __forceinline__ unsigned cvtpk_s(float lo, float hi) { f32x2_t v = {lo, hi}; bf16x2_t b = __builtin_convertvector(v, bf16x2_t); return __builtin_bit_cast(unsigned, b); }
#define WAIT_BAR(N) asm volatile("s_waitcnt vmcnt(" #N ") lgkmcnt(0)\n\ts_barrier" ::: "memory")
typedef const LAS char* lds_cptr;
__device__ __forceinline__ void qkt(f32x16& p0, f32x16& p1, lds_cptr Kslot, lds_cptr qls, int r32, int hi) {
    const f32x16 negm = f32x16{};
    bf16x8 qr[4];
#pragma unroll
    for (int d0 = 0; d0 < 4; ++d0) qr[d0] = *(const LAS bf16x8*)(qls + d0 * 1024);
    lds_cptr kb = Kslot + hi * 1024 + r32 * 16;
#pragma unroll
    for (int d0 = 0; d0 < 4; ++d0) {
        const bf16x8 b0 = *(const LAS bf16x8*)(kb + d0 * 2048);
        const bf16x8 b1 = *(const LAS bf16x8*)(kb + d0 * 2048 + 512);
        if (d0 == 0) { p0 = __builtin_amdgcn_mfma_f32_32x32x16_bf16(b0, qr[0], negm, 0, 0, 0); p1 = __builtin_amdgcn_mfma_f32_32x32x16_bf16(b1, qr[0], negm, 0, 0, 0); }
        else { p0 = __builtin_amdgcn_mfma_f32_32x32x16_bf16(b0, qr[d0], p0, 0, 0, 0); p1 = __builtin_amdgcn_mfma_f32_32x32x16_bf16(b1, qr[d0], p1, 0, 0, 0); } }
}
__device__ __forceinline__ void kload8(bf16x8* kf, lds_cptr kp) {
    kf[0] = *(const LAS bf16x8*)(kp);        kf[1] = *(const LAS bf16x8*)(kp + 512);
    kf[2] = *(const LAS bf16x8*)(kp + 2048); kf[3] = *(const LAS bf16x8*)(kp + 2560);
    kf[4] = *(const LAS bf16x8*)(kp + 4096); kf[5] = *(const LAS bf16x8*)(kp + 4608);
    kf[6] = *(const LAS bf16x8*)(kp + 6144); kf[7] = *(const LAS bf16x8*)(kp + 6656);
}
__device__ __forceinline__ void kload2(bf16x8* kf, lds_cptr kp, int j) { kf[2 * j] = *(const LAS bf16x8*)(kp + j * 2048); kf[2 * j + 1] = *(const LAS bf16x8*)(kp + j * 2048 + 512); }
__device__ __forceinline__ s16x4 vtr3(lds_cptr p) { return __builtin_bit_cast(s16x4, __builtin_amdgcn_ds_read_tr16_b64_v4i16((LAS v4i16_t*)p)); }
__device__ __forceinline__ float rowmax(const f32x16& p0, const f32x16& p1) {
    float a = max3f(p0[0], p0[1], p1[0]), b = max3f(p0[2], p0[3], p1[1]); a = max3f(a, p1[2], p1[3]);
#pragma unroll
    for (int r = 4; r < 16; r += 4) { a = max3f(a, p0[r], p0[r + 1]); b = max3f(b, p0[r + 2], p0[r + 3]); a = max3f(a, p1[r], p1[r + 1]); b = max3f(b, p1[r + 2], p1[r + 3]); }
    const float m = max2f(a, b);
    auto rr = __builtin_amdgcn_permlane32_swap(__float_as_uint(m), __float_as_uint(m), false, false);
    return max2f(__uint_as_float(rr[0]), __uint_as_float(rr[1]));
}
__device__ __forceinline__ void pv(f32x16* o, int vb, bf16x8 pa0, bf16x8 pa1, bf16x8 pa2, bf16x8 pa3) {
#pragma unroll
    for (int d0 = 0; d0 < 2; ++d0) { s16x4 lo[4], hi[4];
#pragma unroll
        for (int ks = 0; ks < 4; ++ks) {
            asm volatile("ds_read_b64_tr_b16 %0,%1 offset:%c2" : "=&v"(lo[ks]) : "v"(vb), "i"(d0 * 4096 + ks * 1024) : "memory");
            asm volatile("ds_read_b64_tr_b16 %0,%1 offset:%c2" : "=&v"(hi[ks]) : "v"(vb), "i"(d0 * 4096 + ks * 1024 + 512) : "memory"); }
        asm volatile("s_waitcnt lgkmcnt(0)" ::: "memory"); SBAR();
#define PK(k) (bf16x8){lo[k][0], lo[k][1], lo[k][2], lo[k][3], hi[k][0], hi[k][1], hi[k][2], hi[k][3]}
        o[d0] = __builtin_amdgcn_mfma_f32_32x32x16_bf16(pa0, PK(0), o[d0], 0, 0, 0);
        o[d0] = __builtin_amdgcn_mfma_f32_32x32x16_bf16(pa1, PK(1), o[d0], 0, 0, 0);
        o[d0] = __builtin_amdgcn_mfma_f32_32x32x16_bf16(pa2, PK(2), o[d0], 0, 0, 0);
        o[d0] = __builtin_amdgcn_mfma_f32_32x32x16_bf16(pa3, PK(3), o[d0], 0, 0, 0);
#undef PK
    }
}
__device__ __forceinline__ void wmask(f32x16& p0, f32x16& p1, int j, int qq, int hi) {
    const float NEG = -INFINITY;
    if (j < 2) { const int lim = qq - 64 * j;
#pragma unroll
        for (int r = 0; r < 16; ++r) { const int kk = (r & 3) + 8 * (r >> 2) + 4 * hi; if (kk < lim) p0[r] = NEG; if (kk + 32 < lim) p1[r] = NEG; }
    } else if (j >= 4) { const int lim = qq - 64 * (j - 4);
#pragma unroll
        for (int r = 0; r < 16; ++r) { const int kk = (r & 3) + 8 * (r >> 2) + 4 * hi; if (kk > lim) p0[r] = NEG; if (kk + 32 > lim) p1[r] = NEG; }
    }
}
__device__ __forceinline__ bool unit_at(int i, int bx, int G, int wave, int nlat, int ntot, bool lastl, AUnit& D) {
    int ua;
    if (G == 256) { const int xg = bx & 7, j = bx >> 3;
        if (i < 4) ua = (2 * xg + (i >> 1)) * 64 + (i & 1) * 32 + j;
        else { if (i > 4 || lastl || j >= 16) return false; ua = nlat + (2 * xg + (j >> 3)) * 8 + (j & 7); } }
    else { ua = bx + i * G; }
    if (ua >= ntot) return false;
    D = aunit(ua, wave, nlat); return true;
}
template <int THRL> __device__ __forceinline__ void attn_run(int tid_in, LAS unsigned char* shm3u, const bf16_t* P, bf16_t* Oout, int opitch, int ocol, const float* sink, int bx, int G, int nlat, int ntot, bool lastl, int pvar = 0) {
    int tid = tid_in; asm volatile("" : "+v"(tid));
    const int lane = tid & 63, r32 = lane & 31, hi = lane >> 5; const int wid = __builtin_amdgcn_readfirstlane(tid >> 6);
    const lds_cptr shm3 = (lds_cptr)shm3u;
    const unsigned lds0 = (unsigned)(uintptr_t)shm3u;
    LAS float* wsf = (LAS float*)(shm3u + LDS_WS) + wid * 64;
    const unsigned koff0 = (unsigned)(lane * NCOL + C_K + wid * 8) * 2u;
    const unsigned voff0 = (unsigned)((16 * (wid & 3) + (lane >> 2)) * NCOL + C_V + (wid >> 2) * 32 + (lane & 3) * 8) * 2u;
    const unsigned qoff0 = (unsigned)(r32 * NCOL + hi * 8) * 2u;
    const unsigned zoff0 = (unsigned)((lane >> 3) * NCOL + (lane & 7) * 8) * 2u;
    const unsigned kdst = lds0 + LDS_K + wid * 1024, vdst = lds0 + LDS_V + wid * 1024;
#define NXS(s_) (((s_) == (NSLOT - 1) * SLOTB) ? 0 : (s_) + SLOTB)
#define KROWD(D_, t) (((t) < (D_).nloc) ? (D_).kr_loc0 + 64 * ((D_).jlo + (t)) : (D_).kr_ctx0 + 64 * ((t) - (D_).nloc))
#define DMA_KD(D_, t, slot) glds16(P + (size_t)KROWD(D_, t) * NCOL + (D_).kh * 64, koff0, (unsigned)__builtin_amdgcn_readfirstlane(kdst + (slot)))
#define DMA_VD(D_, t, slot) glds16(P + (size_t)KROWD(D_, t) * NCOL + (D_).kh * 64, voff0, (unsigned)__builtin_amdgcn_readfirstlane(vdst + (slot)))
#define DMA_K(t, slot) DMA_KD(Dc, t, slot)
#define DMA_V(t, slot) DMA_VD(Dc, t, slot)
#define PREFETCH(D_, rb_) do { const int s1_ = NXS(rb_), s2_ = NXS(s1_); DMA_KD(D_, 0, rb_); DMA_VD(D_, 0, rb_); DMA_KD(D_, 1, s1_); DMA_KD(D_, 2, s2_); \
        const bf16_t* qb_ = P + (size_t)(D_).rowQ0 * NCOL + C_Q + (D_).h * 64; \
        _Pragma("unroll") for (int d0_ = 0; d0_ < 4; ++d0_) glds16(qb_ + d0_ * 16, qoff0, (unsigned)__builtin_amdgcn_readfirstlane(lds0 + LDS_Q + wid * 4096 + d0_ * 1024)); } while (0)
#define ZDMA(D_) do { const bf16_t* zb_ = P + (size_t)(D_).rowQ0 * NCOL + C_ZB + (D_).h * 64; \
        _Pragma("unroll") for (int i_ = 0; i_ < 4; ++i_) glds16(zb_ + (size_t)(i_ * 8) * NCOL, zoff0, (unsigned)__builtin_amdgcn_readfirstlane(lds0 + LDS_Z + wid * 4096 + i_ * 1024)); } while (0)
    AUnit Dc, Dn; Dn = AUnit{};
    if (!unit_at(0, bx, G, wid, nlat, ntot, lastl, Dc)) return;
    int rb = 0; bool first = true;
    PREFETCH(Dc, rb); ZDMA(Dc);
    const lds_cptr qls = shm3 + LDS_Q + wid * 4096 + lane * 16;
#define QLD(d) (*(const LAS bf16x8*)(qls + (d) * 1024))
  for (int ui = 0;; ++ui) {
    const bool has_next = unit_at(ui + 1, bx, G, wid, nlat, ntot, lastl, Dn);
    const int nloc = Dc.nloc, jlo = Dc.jlo; const float sink_l2 = sink[Dc.h] * LOG2E;
    bf16x8 kf[8];
    const lds_cptr kp0 = shm3 + LDS_K + hi * 1024 + r32 * 16; const lds_cptr vp0 = shm3 + LDS_V + ((lane >> 4) & 1) * 32 + (lane & 3) * 8 + (4 * hi + ((lane & 15) >> 2)) * 64;
    const int NT = nloc + 4;
    float mhat = 0.f, l_reg = 0.f; f32x16 o[2]; o[0] = f32x16{}; o[1] = f32x16{};
    const int qrel = Dc.qq0 + r32;
#define CMASK(P0, P1, t) do { if ((t) < nloc) wmask(P0, P1, jlo + (t), qrel, hi); } while (0)
    bool resc = false;
#define START(P0, P1) do { const float rm = max2f(rowmax(P0, P1), sink_l2); resc = false; \
    { const float dl = rm; mhat = fadd_s(mhat, dl); \
      _Pragma("unroll") for (int r = 0; r < 16; ++r) { P0[r] = fsub_s(P0[r], dl); P1[r] = fsub_s(P1[r], dl); } } \
    l_reg = hi ? 0.f : __builtin_amdgcn_exp2f(sink_l2 - mhat); \
    _Pragma("unroll") for (int r = 0; r < 16; ++r) P0[r] = __builtin_amdgcn_exp2f(P0[r]); } while (0)
#define RESC() do { if (resc) { asm volatile("s_waitcnt lgkmcnt(0)" ::: "memory"); \
      _Pragma("unroll") for (int r = 0; r < 16; ++r) { const float f_ = wsf[crow(r, hi)]; o[0][r] *= f_; o[1][r] *= f_; if ((r & 3) == 3) asm volatile("" ::: "memory"); } } } while (0)
    f32x16 pA0, pA1, pB0, pB1;
    int sl_prev = rb, sl_cur = rb, sl_next = NXS(rb);
#define ROT() do { sl_prev = sl_cur; sl_cur = sl_next; sl_next = NXS(sl_next); } while (0)
    if (first) { WAIT_BAR(4); } else { WAIT_BAR(8); }
    qkt(pA0, pA1, shm3 + LDS_K + rb, qls, r32, hi); asm volatile("s_nop 15\n\ts_nop 7" : "+v"(pA0), "+v"(pA1)); CMASK(pA0, pA1, 0);
    START(pA0, pA1);
    _Pragma("unroll") for (int r = 0; r < 16; ++r) pA1[r] = __builtin_amdgcn_exp2f(pA1[r]);
    WAIT_BAR(8);
    DMA_K(3, rb); DMA_V(1, NXS(rb));
    ROT();
    kload8(kf, kp0 + sl_cur);
    WAIT_BAR(2);
    s16x4 vlo[8], vhi[8]; u32x4 pw0, pw1, pw2, pw3;
#define PKW(P, B) cvtpk_s(P[B], P[B + 1])
#define PAF(k) __builtin_bit_cast(bf16x8, pw##k)
#define VFR(i) (bf16x8){vlo[i][0], vlo[i][1], vlo[i][2], vlo[i][3], vhi[i][0], vhi[i][1], vhi[i][2], vhi[i][3]}
#define PIN(x) asm volatile("" : "+v"(x))
#define MX3(a, b, c) __builtin_fmaxf(__builtin_fmaxf((a), (b)), (c))
#define GAPA(MF, A0, A1, A2, A3, W0, W1, PW) do { MF; sacc += A0; sacc += A1; sacc += A2; sacc += A3; PIN(sacc); W0; W1; PIN(PW); SBAR(); } while (0)
#define EX(v) __builtin_amdgcn_exp2f(v)
#define GAPB(MF, X, B) do { MF; X[B] = EX(X[B] - mhat); X[B + 1] = EX(X[B + 1] - mhat); X[B + 2] = EX(X[B + 2] - mhat); X[B + 3] = EX(X[B + 3] - mhat); PIN(X); SBAR(); } while (0)
#define VRD(i) do { vlo[i] = vtr3(vp_ + (((i) >> 2) * 4096 + ((i) & 3) * 1024)); vhi[i] = vtr3(vp_ + (((i) >> 2) * 4096 + ((i) & 3) * 1024 + 512)); } while (0)
#define KRD(G, j) do { if (G) { kload2(kf, kp0 + sl_next, j); SBAR(); } } while (0)
#define MF3(A_, B_, C_) __builtin_amdgcn_mfma_f32_32x32x16_bf16(A_, B_, C_, 0, 0, 0)
#define STEP(C0, C1, P0, P1, t, GK, GV, GL) do { SBAR(); \
    const lds_cptr vp_ = vp0 + sl_prev; const f32x16 zero16 = f32x16{}; \
    const bf16x8 qd0 = QLD(0), qd1 = QLD(1); VRD(0); SBAR(); float sacc = (P0[0] + P0[1]); \
    GAPA(C0 = MF3(kf[0], qd0, zero16), P0[2], P0[3], P0[4], P0[5],     pw0[0] = PKW(P0, 0), pw0[1] = PKW(P0, 2), pw0); \
    VRD(4); SBAR(); GAPA(C1 = MF3(kf[1], qd0, zero16), P0[6], P0[7], P0[8], P0[9],     pw0[2] = PKW(P0, 4), pw0[3] = PKW(P0, 6), pw0); \
    const bf16x8 qd2 = QLD(2), qd3 = QLD(3); VRD(1); SBAR(); GAPA(C0 = MF3(kf[2], qd1, C0),   P0[10], P0[11], P0[12], P0[13], pw1[0] = PKW(P0, 8), pw1[1] = PKW(P0, 10), pw1); \
    VRD(5); SBAR(); GAPA(C1 = MF3(kf[3], qd1, C1),   P0[14], P0[15], P1[0], P1[1],   pw1[2] = PKW(P0, 12), pw1[3] = PKW(P0, 14), pw1); \
    VRD(2); SBAR(); GAPA(C0 = MF3(kf[4], qd2, C0),   P1[2], P1[3], P1[4], P1[5],     pw2[0] = PKW(P1, 0), pw2[1] = PKW(P1, 2), pw2); \
    VRD(6); SBAR(); GAPA(C1 = MF3(kf[5], qd2, C1),   P1[6], P1[7], P1[8], P1[9],     pw2[2] = PKW(P1, 4), pw2[3] = PKW(P1, 6), pw2); \
    VRD(3); SBAR(); GAPA(C0 = MF3(kf[6], qd3, C0),   P1[10], P1[11], P1[12], P1[13], pw3[0] = PKW(P1, 8), pw3[1] = PKW(P1, 10), pw3); \
    VRD(7); SBAR(); GAPA(C1 = MF3(kf[7], qd3, C1),   P1[14], P1[15], 0.f, 0.f,       pw3[2] = PKW(P1, 12), pw3[3] = PKW(P1, 14), pw3); \
    l_reg += sacc; \
    if (GK) { DMA_K((t) + 3, sl_cur); } if (GV) { DMA_V((t) + 1, sl_next); } \
    CMASK(C0, C1, t); \
    { float a = MX3(C0[0], C0[1], C1[0]), b = MX3(C0[2], C0[3], C1[1]); a = MX3(a, C1[2], C1[3]); \
      _Pragma("unroll") for (int r = 4; r < 16; r += 4) { a = MX3(a, C0[r], C0[r + 1]); b = MX3(b, C0[r + 2], C0[r + 3]); a = MX3(a, C1[r], C1[r + 1]); b = MX3(b, C1[r + 2], C1[r + 3]); } \
      float rm = __builtin_fmaxf(a, b); { auto rr = __builtin_amdgcn_permlane32_swap(__float_as_uint(rm), __float_as_uint(rm), false, false); rm = __builtin_fmaxf(__uint_as_float(rr[0]), __uint_as_float(rr[1])); } \
      resc = false; rm -= mhat; \
      if (__builtin_expect(__any(rm > (float)THRL), 0)) { const float dl = __builtin_fmaxf(rm, 0.f); mhat += dl; \
        const float f = __builtin_amdgcn_exp2f(-dl); l_reg *= f; if (hi == 0) wsf[r32] = f; resc = true; } } \
    SBAR(); \
    GAPB(o[0] = MF3(PAF(0), VFR(0), o[0]), C0, 0); \
    GAPB(o[1] = MF3(PAF(0), VFR(4), o[1]), C0, 4); \
    KRD(GL, 0); GAPB(o[0] = MF3(PAF(1), VFR(1), o[0]), C0, 8); \
    KRD(GL, 1); GAPB(o[1] = MF3(PAF(1), VFR(5), o[1]), C0, 12); \
    KRD(GL, 2); GAPB(o[0] = MF3(PAF(2), VFR(2), o[0]), C1, 0); \
    KRD(GL, 3); GAPB(o[1] = MF3(PAF(2), VFR(6), o[1]), C1, 4); \
    GAPB(o[0] = MF3(PAF(3), VFR(3), o[0]), C1, 8); \
    GAPB(o[1] = MF3(PAF(3), VFR(7), o[1]), C1, 12); \
    } while (0)
    int t = 1;
#define ENDW(tt) do { if ((tt) + 3 < NT) { WAIT_BAR(2); } else if ((tt) + 2 < NT) { WAIT_BAR(1); } else { WAIT_BAR(0); } } while (0)
    for (; t + 1 < NT; t += 2) {
        STEP(pB0, pB1, pA0, pA1, t, (t + 3 < NT), (t + 1 < NT), (t + 1 < NT));       ENDW(t);     RESC(); ROT();
        STEP(pA0, pA1, pB0, pB1, t + 1, (t + 4 < NT), (t + 2 < NT), (t + 2 < NT));   ENDW(t + 1); RESC(); ROT();
    }
    STEP(pB0, pB1, pA0, pA1, NT - 1, false, false, false); RESC();
    const int rn = sl_next;
    if (has_next) PREFETCH(Dn, rn);
    { float sacc = pB0[0] + pB0[1]; _Pragma("unroll") for (int r = 2; r < 16; ++r) sacc += pB0[r]; _Pragma("unroll") for (int r = 0; r < 16; ++r) sacc += pB1[r]; l_reg += sacc;
      pw0 = (u32x4){PKW(pB0, 0), PKW(pB0, 2), PKW(pB0, 4), PKW(pB0, 6)}; pw1 = (u32x4){PKW(pB0, 8), PKW(pB0, 10), PKW(pB0, 12), PKW(pB0, 14)}; pw2 = (u32x4){PKW(pB1, 0), PKW(pB1, 2), PKW(pB1, 4), PKW(pB1, 6)}; pw3 = (u32x4){PKW(pB1, 8), PKW(pB1, 10), PKW(pB1, 12), PKW(pB1, 14)};
      SBAR(); int ln2 = lane_id_(); asm volatile("" : "+v"(ln2)); const int hi2 = ln2 >> 5;
      const int vb0 = (int)(lds0 + LDS_V) + ((ln2 >> 4) & 1) * 32 + (ln2 & 3) * 8 + (4 * hi2 + ((ln2 & 15) >> 2)) * 64;
      pv(o, vb0 + sl_cur, PAF(0), PAF(1), PAF(2), PAF(3)); }
#undef PKW
#undef PAF
#undef VFR
#undef PIN
#undef MX3
#undef GAPA
#undef GAPB
#undef EX
#undef VRD
#undef KRD
#undef STEP
#undef ENDW
    { auto rr = __builtin_amdgcn_permlane32_swap(__float_as_uint(l_reg), __float_as_uint(l_reg), false, false); l_reg = __uint_as_float(rr[0]) + __uint_as_float(rr[1]); }
    int lane_e = lane_id_(); asm volatile("" : "+v"(lane_e));
    const int r32_e = lane_e & 31, hi_e = lane_e >> 5;
    if (hi_e == 0) wsf[32 + r32_e] = l_reg; asm volatile("s_waitcnt lgkmcnt(0)" ::: "memory");
    float rli[16];
#pragma unroll
    for (int r = 0; r < 16; ++r) rli[r] = __builtin_amdgcn_rcpf(wsf[32 + crow(r, hi_e)]);
    {   LAS bf16_t* stg = (LAS bf16_t*)(shm3u + LDS_OST) + wid * 2048;
        u32x4 zv[4];
#pragma unroll
        for (int i = 0; i < 4; ++i) zv[i] = *(const LAS u32x4*)(shm3u + LDS_Z + wid * 4096 + i * 1024 + lane_e * 16);
        asm volatile("s_waitcnt lgkmcnt(0)" : "+v"(zv[0]), "+v"(zv[1]), "+v"(zv[2]), "+v"(zv[3]) :: "memory");
        if (has_next) ZDMA(Dn);
#pragma unroll
        for (int r = 0; r < 16; ++r) { const int orow = crow(r, hi_e);
#pragma unroll
            for (int d0 = 0; d0 < 2; ++d0) { const unsigned short b = (unsigned short)(cvtpk_s(o[d0][r] * rli[r], 0.f) & 0xffffu); stg[orow * 64 + d0 * 32 + r32_e] = b; } }
        asm volatile("s_waitcnt lgkmcnt(0)" ::: "memory");
        bf16_t* orow_p = Oout + (size_t)Dc.rowQ0 * opitch + ocol + Dc.h * 64;
#pragma unroll
        for (int i = 0; i < 4; ++i) { const int row = i * 8 + (lane_e >> 3), ch = lane_e & 7; const u32x4 v = *(const LAS u32x4*)(stg + row * 64 + ch * 8);
            u32x4 w;
#pragma unroll
            for (int e = 0; e < 4; ++e) { w[e] = cvt_pk_bf16(bf_lo(v[e]) * siluf_(bf_lo(zv[i][e])), bf_hi(v[e]) * siluf_(bf_hi(zv[i][e]))); }
            *(u32x4*)(orow_p + (size_t)row * opitch + ch * 8) = w; } }
    asm volatile("s_waitcnt lgkmcnt(0)\n\ts_barrier" ::: "memory");
    if (!has_next) break;
    Dc = Dn; rb = rn; first = false;
  }
    asm volatile("s_waitcnt vmcnt(0)" ::: "memory");
#undef DMA_K
#undef DMA_V
#undef KROWD
#undef DMA_KD
#undef DMA_VD
#undef PREFETCH
#undef ZDMA
#undef NXS
#undef CMASK
#undef START
#undef RESC
#undef ROT
#undef QLD
}
#undef SBAR
#undef WAIT_BAR
}

__device__ __forceinline__ void conv_run8(const bf16_t* P, bf16_t* Yout, int ypitch, int ycol, const float* cw, int run, int lane) {
    const int row0 = run * 8;
    int s0, s1; if (row0 < TL) { s0 = row0 & ~2047; s1 = s0 + 2048; } else { s0 = TL + ((row0 - TL) & ~255); s1 = s0 + 256; }
    const int c0 = lane * 8;
    const bf16_t* base = P + (size_t)row0 * NCOL + c0;
    u32x4 rc[10], rb[8];
    const u32x4 z4u = (u32x4){0u, 0u, 0u, 0u};
    rc[0] = z4u; rc[9] = z4u;
    if (row0 - 1 >= s0) rc[0] = *(const u32x4*)(base - NCOL + C_CU);
#pragma unroll
    for (int i = 0; i < 8; ++i) { rc[i + 1] = *(const u32x4*)(base + (size_t)i * NCOL + C_CU); rb[i] = *(const u32x4*)(base + (size_t)i * NCOL + C_BZ); }
    if (row0 + 8 < s1) rc[9] = *(const u32x4*)(base + (size_t)8 * NCOL + C_CU);
    const f32x4 w0a = *(const f32x4*)(cw + c0), w0b = *(const f32x4*)(cw + c0 + 4);
    const f32x4 w1a = *(const f32x4*)(cw + 512 + c0), w1b = *(const f32x4*)(cw + 512 + c0 + 4);
    const f32x4 w2a = *(const f32x4*)(cw + 1024 + c0), w2b = *(const f32x4*)(cw + 1024 + c0 + 4);
#define CV_A(q_) ((f32x4){bf_lo((q_)[0]), bf_hi((q_)[0]), bf_lo((q_)[1]), bf_hi((q_)[1])})
#define CV_B(q_) ((f32x4){bf_lo((q_)[2]), bf_hi((q_)[2]), bf_lo((q_)[3]), bf_hi((q_)[3])})
    f32x4 pa = CV_A(rc[0]), pb = CV_B(rc[0]), ca = CV_A(rc[1]), cb = CV_B(rc[1]);
#pragma unroll
    for (int i = 0; i < 8; ++i) {
        const f32x4 na = CV_A(rc[i + 2]), nb = CV_B(rc[i + 2]);
        const f32x4 ya = CV_A(rb[i]) * (w0a * pa + w1a * ca + w2a * na), yb = CV_B(rb[i]) * (w0b * pb + w1b * cb + w2b * nb);
        u32x4 w; w.x = cvt_pk_bf16(ya[0], ya[1]); w.y = cvt_pk_bf16(ya[2], ya[3]); w.z = cvt_pk_bf16(yb[0], yb[1]); w.w = cvt_pk_bf16(yb[2], yb[3]);
        *(u32x4*)(Yout + (size_t)(row0 + i) * ypitch + ycol + c0) = w;
        pa = ca; pb = cb; ca = na; cb = nb;
    }
#undef CV_A
#undef CV_B
}

__device__ __forceinline__ void transpose_item(const float* W, int ldw, bf16_t* WT, int ldo, int koff, int nblk, LAS float* scr, int item, int lane, bool perm = false) {
    const int kb = item / nblk, nb = item % nblk, k0 = 64 * kb, n0 = 32 * nb, n0s = perm ? orig_col(n0) : n0;
#pragma unroll 8
    for (int i = 0; i < 32; ++i) { const int kk = 2 * i + (lane >> 5); scr[kk * 33 + (lane & 31)] = W[(size_t)(k0 + kk) * ldw + n0s + (lane & 31)]; }
    LDS_WAIT(); asm volatile("" ::: "memory");
    const int c = lane & 7;
#pragma unroll
    for (int j = 0; j < 4; ++j) { const int n = (lane >> 3) + 8 * j; const LAS float* s = scr + (8 * c) * 33 + n;
        u32x4 o; o.x = cvt_pk_bf16(s[0 * 33], s[1 * 33]); o.y = cvt_pk_bf16(s[2 * 33], s[3 * 33]); o.z = cvt_pk_bf16(s[4 * 33], s[5 * 33]); o.w = cvt_pk_bf16(s[6 * 33], s[7 * 33]);
        *(u32x4*)(WT + (size_t)(n0 + n) * ldo + koff + k0 + 8 * c) = o; }
    LDS_WAIT(); asm volatile("" ::: "memory");
}

__device__ __forceinline__ void rowmat17_item(int tid, LAS unsigned char* lds, const float* W, int ldw, int col0, const float* bias, float* out, int ldo, int scol0 = -1) {
    if (scol0 < 0) scol0 = col0;
    const int lane = tid & 63, wid = tid >> 6;
    const LAS float* tab = (const LAS float*)lds;
    LAS float* part = (LAS float*)(lds + 17 * 1024 * 4);
    float acc[17];
#pragma unroll
    for (int r = 0; r < 17; ++r) acc[r] = 0.f;
    const float* wp = W + (size_t)(wid * 128) * ldw + scol0 + lane;
#pragma unroll 2
    for (int k = 0; k < 128; k += 8) {
        float wv[8];
#pragma unroll
        for (int i = 0; i < 8; ++i) wv[i] = wp[(size_t)(k + i) * ldw];
#pragma unroll
        for (int q = 0; q < 2; ++q)
#pragma unroll
            for (int r = 0; r < 17; ++r) { const f32x4 t = *(const LAS f32x4*)(tab + r * 1024 + wid * 128 + k + 4 * q); acc[r] += (t[0] * wv[4 * q] + t[1] * wv[4 * q + 1]) + (t[2] * wv[4 * q + 2] + t[3] * wv[4 * q + 3]); }
    }
#pragma unroll
    for (int r = 0; r < 17; ++r) part[(wid * 17 + r) * 64 + lane] = acc[r];
    __syncthreads();
    for (int idx = tid; idx < 17 * 64; idx += 512) { const int r = idx >> 6, e = idx & 63; float s = 0.f;
#pragma unroll
        for (int w = 0; w < 8; ++w) s += part[(w * 17 + r) * 64 + e];
        if (bias) s += bias[col0 + e];
        out[(size_t)r * ldo + col0 + e] = s; }
    __syncthreads();
}


#define XB_TMO      128
#define XB_XCNT(j)  (256  + 64 * (j))
#define XB_XSUB(j)  (1280 + 64 * (j))
#define XB_XGEN(j)  (2304 + 64 * (j))
#define XB_TOP      3328
#define XB_TOPGEN   3392
#define XCD_BAR_WORDS 3456
#define XB_SPIN_CAP (1u << 18)
__device__ __forceinline__ unsigned xb_ld(unsigned* p)              { return __hip_atomic_load(p, __ATOMIC_RELAXED, __HIP_MEMORY_SCOPE_AGENT); }
__device__ __forceinline__ unsigned xb_add(unsigned* p, unsigned v) { return __hip_atomic_fetch_add(p, v, __ATOMIC_RELAXED, __HIP_MEMORY_SCOPE_AGENT); }
__device__ __forceinline__ unsigned xb_xcc_id() { return (unsigned)__builtin_amdgcn_s_getreg((3 << 11) | 20) & 0xFu; }
#define XB_SPIN(cond, bar) do { unsigned _sp = 0; while (cond) { __builtin_amdgcn_s_sleep(1); \
    if ((++_sp & 255u) == 0u) { if (xb_ld(&(bar)[XB_TMO])) break; if (_sp > XB_SPIN_CAP) { atomicAdd(&(bar)[XB_TMO], 1u); break; } } } } while (0)
struct XcdBarrier { unsigned* bar; unsigned x; volatile LAS unsigned* st; };
__device__ __forceinline__ XcdBarrier xcd_barrier_post(unsigned* bar, volatile LAS unsigned* st, int tid) {
    XcdBarrier b; b.bar = bar; b.x = xb_xcc_id(); b.st = st;
    if (tid == 0) (void)xb_add(&bar[XB_XCNT(b.x)], 1u);
    return b;
}
__device__ __forceinline__ void xcd_barrier_complete(unsigned* bar, unsigned x, unsigned& nloc, unsigned& nx) {
    const unsigned G = gridDim.x * gridDim.y * gridDim.z;
    unsigned sum, cnt, mine, sp = 0u;
    for (;;) {
        sum = 0u; cnt = 0u; mine = 0u;
#pragma unroll
        for (unsigned j = 0; j < 16; ++j) { const unsigned c = xb_ld(&bar[XB_XCNT(j)]); sum += c; cnt += (c > 0u) ? 1u : 0u; mine = (j == x) ? c : mine; }
        if (sum == G) break;
        __builtin_amdgcn_s_sleep(1);
        if ((++sp & 255u) == 0u) { if (xb_ld(&bar[XB_TMO])) break; if (sp > XB_SPIN_CAP) { atomicAdd(&bar[XB_TMO], 1u); break; } }
    }
    nloc = mine > 0u ? mine : 1u; nx = cnt > 0u ? cnt : 1u;
}
__device__ __forceinline__ void xcd_barrier(const XcdBarrier& b, int tid) {
    asm volatile("s_waitcnt vmcnt(0)" ::: "memory");
    __syncthreads();
    if (tid == 0) {
        unsigned* bar = b.bar;
        __builtin_amdgcn_s_waitcnt(0);
        unsigned nloc = b.st[0], nx = b.st[1];
        if (nloc == 0u) { xcd_barrier_complete(bar, b.x, nloc, nx); b.st[0] = nloc; b.st[1] = nx; }
        const unsigned old = xb_add(&bar[XB_XSUB(b.x)], 1u);
        const unsigned gen = old / nloc;
        if (old + 1u == (gen + 1u) * nloc) {
            __builtin_amdgcn_fence(__ATOMIC_RELEASE, "agent");
            asm volatile("s_waitcnt vmcnt(0)" ::: "memory");
            const unsigned og = xb_add(&bar[XB_TOP], 1u);
            const unsigned tg = og / nx;
            if (og + 1u == (tg + 1u) * nx) xb_add(&bar[XB_TOPGEN], 1u);
            else XB_SPIN(xb_ld(&bar[XB_TOPGEN]) == tg, bar);
            __builtin_amdgcn_fence(__ATOMIC_ACQUIRE, "agent");
            xb_add(&bar[XB_XGEN(b.x)], 1u);
            asm volatile("s_waitcnt vmcnt(0)" ::: "memory");
        } else {
            XB_SPIN(xb_ld(&bar[XB_XGEN(b.x)]) == gen, bar);
            __builtin_amdgcn_fence(__ATOMIC_ACQUIRE, "agent");
            asm volatile("s_waitcnt vmcnt(0)" ::: "memory");
        }
    }
    __syncthreads();
}

__global__ void __launch_bounds__(512, 2) fwd_kernel(Args a) {
    extern __shared__ __attribute__((aligned(16))) unsigned char lds_raw[];
    LAS unsigned char* lds = (LAS unsigned char*)lds_raw;
    unsigned char* ws0 = a.ws;
    volatile LAS unsigned* MISC = (volatile LAS unsigned*)(lds + LDS_AUX);
    const int wave0 = __builtin_amdgcn_readfirstlane((int)threadIdx.x >> 6);
#define MYTID() (wave0 * 64 + lane_id_())
    if (MYTID() < 64) MISC[MYTID()] = 0u;
    __syncthreads();
    XcdBarrier xbar; xbar.bar = (unsigned*)(ws0 + WS_CTL); xbar.x = 0; xbar.st = nullptr;
    if (a.coop) xbar = xcd_barrier_post((unsigned*)(ws0 + WS_CTL), MISC + 8, MYTID());

#define PH_PROLOG const __attribute__((address_space(4))) Args* ap = (const __attribute__((address_space(4))) Args*)__builtin_amdgcn_kernarg_segment_ptr(); asm volatile("" : "+s"(ap)); const float* x_in = ap->in[0]; const float* c_in = ap->in[1]; const float* ctx_in = ap->in[2]; const float* cctx_in = ap->in[3]; const float* norm_w = ap->in[4]; const float* w_mod = ap->in[5]; const float* b_mod = ap->in[6]; const float* w_in = ap->in[7]; const float* conv_w = ap->in[8]; const float* w_a_out = ap->in[9]; const float* w_b_out = ap->in[10]; const float* attn_sink = ap->in[11]; const float* w_o = ap->in[12]; const float* fnorm_w = ap->in[13]; unsigned char* ws = ap->ws; bf16_t* WIN_T = (bf16_t*)(ws + WS_WIN_T); bf16_t* WAB_T = (bf16_t*)(ws + WS_WAB_T); bf16_t* WO_T = (bf16_t*)(ws + WS_WO_T); float* MOD = (float*)(ws + WS_MOD); float* NW1 = (float*)(ws + WS_NW1); float* SB = (float*)(ws + WS_SB); float* ROPEC = (float*)(ws + WS_ROPE); float* ROPES = ROPEC + 64 * 16; float* SSP = (float*)(ws + WS_SSP); resid_t* XCTX = (resid_t*)(ws + WS_XCTX); bf16_t* XS = (bf16_t*)(ws + WS_XS); bf16_t* P = (bf16_t*)(ws + WS_P); float* OUT = ap->out; (void)x_in; (void)c_in; (void)ctx_in; (void)cctx_in; (void)norm_w; (void)w_mod; (void)b_mod; (void)w_in; (void)conv_w; (void)w_a_out; (void)w_b_out; (void)attn_sink; (void)w_o; (void)fnorm_w; (void)WIN_T; (void)WAB_T; (void)WO_T; (void)MOD; (void)NW1; (void)SB; (void)ROPEC; (void)ROPES; (void)SSP; (void)XCTX; (void)XS; (void)P; (void)OUT; int tid = MYTID(), bx = blockIdx.x; asm volatile("" : "+v"(tid), "+s"(bx)); const int lane = tid & 63, wave = __builtin_amdgcn_readfirstlane(tid >> 6); const int G = gridDim.x; const int gw = bx * 8 + wave, NGW = G * 8; (void)lane; (void)gw; (void)NGW;
#define DUP_ON(k) ((DUP_MASK >> (k)) & 1)
#if MK_COOP
#define SEAM_SYNC() do { if (a.coop) xcd_barrier(xbar, MYTID()); __syncthreads(); } while (0)
#else
#define SEAM_SYNC() do { } while (0)
#endif
    if (a.ph_lo == 0 && (PHMASK & 1)) { PH_PROLOG
          for (int rep = DUP_ON(0) ? 0 : 1; rep < 2; ++rep) {
            constexpr int NMOD = DEPTH * 48;
            if (bx < NMOD) {
                LAS float* tab = (LAS float*)lds;
#pragma clang loop vectorize(disable) interleave(disable) unroll(disable)
                for (int idx = tid; idx < 17 * 1024; idx += 512) { const int r = idx >> 10, k = idx & 1023; const float v = (r < 16) ? c_in[r * 1024 + k] : cctx_in[k]; tab[idx] = siluf_(v); }
                __syncthreads();
                for (int it = bx; it < NMOD; it += G) { const int l = it / 48, ec = it % 48;
                    rowmat17_item(tid, lds, w_mod + (size_t)l * 1024 * 3072, 3072, ec * 64, b_mod + l * 3072, MOD + (size_t)l * 17 * 3072, 3072); }
            }
            __syncthreads();
            if (bx == G - 1) { for (int idx = tid; idx < 64 * 16; idx += 512) { const int pos = idx >> 4, f = idx & 15; const float invf = powf(10000.0f, -(float)f / 16.0f); const float ang = (float)pos * invf;
                    ROPEC[idx] = cosf(ang); ROPES[idx] = sinf(ang); } }
            LAS float* scr = (LAS float*)(lds + wave * 16384);
            constexpr int I_IN = 16 * 168, I_A = 8 * 32, I_O = 16 * 32;
            constexpr int NITEMS = DEPTH * (I_IN + 2 * I_A + I_O);
            for (int it = gw; it < NITEMS; it += NGW) {
                int r = it;
                const int l = r / (I_IN + 2 * I_A + I_O); r -= l * (I_IN + 2 * I_A + I_O);
                if (r < I_IN) { transpose_item(w_in + (size_t)l * 1024 * NIN, NIN, WIN_T + (size_t)l * NIN * 1024, 1024, 0, 168, scr, r, lane, true); continue; } r -= I_IN;
                if (r < I_A) { transpose_item(w_a_out + (size_t)l * 512 * 1024, 1024, WAB_T + (size_t)l * 1024 * 1024, 1024, 0, 32, scr, r, lane); continue; } r -= I_A;
                if (r < I_A) { transpose_item(w_b_out + (size_t)l * 512 * 1024, 1024, WAB_T + (size_t)l * 1024 * 1024, 1024, 512, 32, scr, r, lane); continue; } r -= I_A;
                transpose_item(w_o + (size_t)l * 1024 * 1024, 1024, WO_T + (size_t)l * 1024 * 1024, 1024, 0, 32, scr, r, lane);
            }
            if (rep == 0) SEAM_SYNC();
          }
    }
    if (a.ph_lo == 0 && a.ph_hi > 1) {
#if MK_COOP
        if (a.coop) cg::this_grid().sync();
#endif
        __syncthreads();
    }
    for (int ph = (a.ph_lo == 0 ? 1 : a.ph_lo); ph < a.ph_hi; ++ph) {
        if (ph == 1 && (PHMASK & 2)) { PH_PROLOG
          for (int rep = DUP_ON(1) ? 0 : 1; rep < 2; ++rep) {
            constexpr int NSB = DEPTH * 84;
            { int curl = -1;
              for (int it = bx; it < NSB; it += G) { const int l = it / 84, nc = it % 84;
                if (l != curl) { __syncthreads(); LAS float* tab = (LAS float*)lds;
#pragma clang loop vectorize(disable) interleave(disable) unroll(disable)
                    for (int idx = tid; idx < 17 * 1024; idx += 512) { const int r = idx >> 10, k = idx & 1023; tab[idx] = MOD[((size_t)l * 17 + r) * 3072 + k]; }
                    __syncthreads(); curl = l; }
                rowmat17_item(tid, lds, w_in + (size_t)l * 1024 * NIN, NIN, nc * 64, nullptr, SB + (size_t)l * 17 * NIN, NIN, orig_col(nc * 64)); } }
            for (int idx = bx * 512 + tid; idx < DEPTH * 17 * 1024; idx += G * 512) { const int k = idx & 1023, lr = idx >> 10, l = lr / 17;
                NW1[idx] = norm_w[l * 1024 + k] * (1.0f + MOD[(size_t)lr * 3072 + 1024 + k]); }
            for (int row0 = gw * 3; row0 < TT; row0 += NGW * 3) {
                f32x4 v[3][4]; float ss[3];
#pragma unroll
                for (int q = 0; q < 3; ++q) { const int row = row0 + q; const bool lat = row < TL;
                    const f32x4* xr = (const f32x4*)(lat ? x_in + (size_t)row * DM : ctx_in + (size_t)(row - TL) * DM) + lane;
#pragma unroll
                    for (int j = 0; j < 4; ++j) v[q][j] = xr[64 * j]; }
#pragma unroll
                for (int q = 0; q < 3; ++q) { float s_ = 0.f;
#pragma unroll
                    for (int j = 0; j < 4; ++j) s_ += (v[q][j][0] * v[q][j][0] + v[q][j][1] * v[q][j][1]) + (v[q][j][2] * v[q][j][2] + v[q][j][3] * v[q][j][3]);
                    ss[q] = wave_sum(s_, lane); }
#pragma unroll
                for (int q = 0; q < 3; ++q) { const int row = row0 + q; const bool lat = row < TL; const int b = lat ? (row >> 11) : 16;
                    const f32x4* nwp = (const f32x4*)norm_w + lane; const f32x4* scp = (const f32x4*)(MOD + (size_t)b * 3072 + 1024) + lane;
                    u32x2* o8 = (u32x2*)(XS + (size_t)row * DM) + lane;
#if RESID_BF16
                    u32x2* x8 = (u32x2*)(lat ? (bf16_t*)OUT + (size_t)row * DM : XCTX + (size_t)(row - TL) * DM) + lane;
#endif
#pragma unroll
                    for (int j = 0; j < 4; ++j) { const f32x4 hh = v[q][j] * (nwp[64 * j] * (scp[64 * j] + 1.0f)); u32x2 w; w.x = cvt_pk_bf16(hh[0], hh[1]); w.y = cvt_pk_bf16(hh[2], hh[3]); o8[64 * j] = w;
#if RESID_BF16
                        u32x2 wx; wx.x = r16_pk(v[q][j][0], v[q][j][1]); wx.y = r16_pk(v[q][j][2], v[q][j][3]); x8[64 * j] = wx;
#endif
                    }
                    if (lane < NSS) SSP[(size_t)row * NSS + lane] = (lane == 0) ? ss[q] : 0.f; }
            }
            if (rep == 0) SEAM_SYNC();
          }
        } else if (ph == NPHASE - 1 && (PHMASK & 4)) { PH_PROLOG
            for (int row = gw; row < TL; row += NGW) {
                float s = SSP[(size_t)row * NSS + (lane & 31)];
                s += shx(s, lane, 1); s += shx(s, lane, 2); s += shx(s, lane, 4); s += shx(s, lane, 8); s += shx(s, lane, 16);
                const float rinv = 1.0f / sqrtf(s * (1.0f / 1024.0f) + RMS_EPS);
                f32x4* xr = (f32x4*)(OUT + (size_t)row * DM) + lane; const f32x4* fw = (const f32x4*)fnorm_w + lane;
#if RESID_BF16
                const u32x2* xb = (const u32x2*)(XS + (size_t)row * DM) + lane;
#pragma unroll
                for (int j = 0; j < 4; ++j) { const u32x2 w = xb[64 * j]; const f32x4 v = (f32x4){r16_lo(w.x), r16_hi(w.x), r16_lo(w.y), r16_hi(w.y)}; xr[64 * j] = v * rinv * fw[64 * j]; }
#else
#pragma unroll
                for (int j = 0; j < 4; ++j) { const f32x4 v = xr[64 * j]; xr[64 * j] = v * rinv * fw[64 * j]; }
#endif
            }
        } else {
            const int l = (ph - 2) >> 2, sub = (ph - 2) & 3;
            const bool lastl = (l == DEPTH - 1);
            if (sub == 0 && (PHMASK & 8)) { PH_PROLOG
                pg8::Gemm g{XS, WIN_T + (size_t)l * NIN * 1024, DM, DM};
                pg8::Order S; if (!lastl) S.init(TT / 256, NIN / 256, G, bx); else S.init(TL / 256, NIN / 256, G, bx, NB, TL / 256, 10);
                { LAS float* rt = (LAS float*)(lds + LDS_ROPE_OFF); for (int idx = tid; idx < 2048; idx += 512) rt[idx] = ROPEC[idx]; }
                {
                    LAS float* rv = (LAS float*)(lds + LDS_RINV_OFF);
                    int nun = 0; { pg8::Unit uu; while (nun < 12 && S.next(nun, uu)) ++nun; }
#pragma unroll 2
                    for (int rr = tid; rr < nun * 256; rr += 512) { pg8::Unit uu; S.next(rr >> 8, uu);
                        const f32x4* sp = (const f32x4*)(SSP + (size_t)(uu.pm * 256 + (rr & 255)) * NSS);
                        f32x4 a4 = (sp[0] + sp[1]) + (sp[2] + sp[3]); a4 = a4 + ((sp[4] + sp[5]) + (sp[6] + sp[7]));
                        rv[rr] = 1.0f / sqrtf(((a4[0] + a4[1]) + (a4[2] + a4[3])) * (1.0f / 1024.0f) + RMS_EPS); }
                    __syncthreads(); }
                for (int rep = DUP_ON(3) ? 0 : 1; rep < 2; ++rep) { EpiG1 E{P, SB + (size_t)l * 17 * NIN, lds, rep == 0 ? PROBE_SKIP : 0};
                    pg8::gemm_phase<EpiG1, pg8::Order, true>(tid, lds, g, S, E, rep == 0 ? (unsigned)(((bx >> 3) & 31) * PROBE_STAGGER) : 0u); if (rep == 0) SEAM_SYNC(); }
            } else if (sub == 1 && (PHMASK & 16)) { PH_PROLOG
                const float* sink = attn_sink + l * 8;
                const int nlat = 1024, nctx = lastl ? 0 : 128;
              for (int rep = DUP_ON(4) ? 0 : 1; rep < 2; ++rep) {
                bf16_t* Oo = rep ? P : XS; const int opitch = rep ? NCOL : 1024, ocol = rep ? C_Q : 512, ycol = rep ? C_BZ : 0;
                if (!(ap->probe && PROBE_AT == 2)) {
#if ATTN_V3
                    at3::attn_run<8>(tid, lds, P, Oo, opitch, ocol, sink, bx, G, nlat, nlat + nctx, lastl);
#else
                    attn_phase2(lds, tid, P, Oo, opitch, ocol, sink, bx, G, nlat, nlat + nctx, rep == 0 ? PROBE_ATV : 0);
#endif
                }
                __syncthreads();
                const int nruns = (lastl ? TL : TT) / 8;
                for (int it = (NGW - 1 - gw); it < nruns && !(ap->probe && PROBE_AT == 1); it += NGW) conv_run8(P, Oo, opitch, ycol, conv_w + (size_t)l * 3 * 512, it, lane);
                if (rep == 0) SEAM_SYNC();
              }
            } else if (sub == 2 && (PHMASK & 32)) { PH_PROLOG
                pg8::Gemm g{P + C_BZ, WAB_T + (size_t)l * 1024 * 1024, NCOL, DM};
                pg8::Order S; S.init(TL / 256, 4, G, bx);
                { EpiG2 E{P, P, NCOL, C_GA};
                    pg8::gemm_phase<EpiG2, pg8::Order, true>(tid, lds, g, S, E);
                    if (!lastl) pg8::gemm128_phase<EpiG2>(MYTID(), lds, P + C_BZ, NCOL, WAB_T + (size_t)l * 1024 * 1024, DM, TL, TC / 128, 8, G, bx, E); }
            } else if (PHMASK & 64) { PH_PROLOG
                pg8::Gemm g{P + C_GA, WO_T + (size_t)l * 1024 * 1024, NCOL, DM};
                pg8::Order S; S.init(TL / 256, 4, G, bx);
                {
                    #if RESID_BF16
                    EpiG3 E{(const bf16_t*)OUT, XCTX, lastl ? XS : (bf16_t*)OUT, XCTX, MOD + (size_t)l * 17 * 3072 + 2048, lastl ? nullptr : NW1 + (size_t)(l + 1) * 17 * 1024, XS, SSP, lds};
#else
                    EpiG3 E{(l == 0 && !ap->probe) ? x_in : OUT, (l == 0 && !ap->probe) ? ctx_in : XCTX, OUT, XCTX, ap->probe ? nullptr : MOD + (size_t)l * 17 * 3072 + 2048, lastl ? nullptr : NW1 + (size_t)(l + 1) * 17 * 1024, XS, SSP, lds};
#endif
                    pg8::gemm_phase<EpiG3, pg8::Order, true>(tid, lds, g, S, E);
                    if (!lastl) pg8::gemm128_phase<EpiG3>(MYTID(), lds, P + C_GA, NCOL, WO_T + (size_t)l * 1024 * 1024, DM, TL, TC / 128, 8, G, bx, E); }
            }
        }
        if (ph + 1 < a.ph_hi) {
#if MK_COOP
            if (a.coop) xcd_barrier(xbar, MYTID());
#endif
            __syncthreads();
        }
    }
}

extern "C" void kernel_launch(void* const* d_in, const int* in_sizes, int n_in, void* d_out, int out_size, void* d_ws, size_t ws_size, hipStream_t stream) {
    static int grid = 0;
    if (grid == 0) {
        if (n_in != 14 || in_sizes[0] != TL * DM || out_size != TL * DM || ws_size < WS_END) {
            fprintf(stderr, "kernel_launch: unexpected shapes (n_in %d, in0 %d, out %d, ws %zu need %zu); nothing launched\n", n_in, n_in > 0 ? in_sizes[0] : -1, out_size, ws_size, (size_t)WS_END); grid = -1; return; }
        int dev = 0, cus = 0;
        if (hipGetDevice(&dev) != hipSuccess || hipDeviceGetAttribute(&cus, hipDeviceAttributeMultiprocessorCount, dev) != hipSuccess || cus <= 0) cus = 256;
        if (hipFuncSetAttribute((const void*)fwd_kernel, hipFuncAttributeMaxDynamicSharedMemorySize, LDS_BYTES) != hipSuccess) { fprintf(stderr, "kernel_launch: hipFuncSetAttribute failed\n"); grid = -1; return; }
        int per_cu = 0;
        if (hipOccupancyMaxActiveBlocksPerMultiprocessor(&per_cu, (const void*)fwd_kernel, 512, LDS_BYTES) != hipSuccess || per_cu < 1) { fprintf(stderr, "kernel_launch: occupancy query says %d\n", per_cu); (void)hipGetLastError(); }
        grid = cus;
    }
    if (grid < 0) return;
    Args a{};
    for (int i = 0; i < 14; ++i) a.in[i] = (const float*)d_in[i];
    a.out = (float*)d_out; a.ws = (unsigned char*)d_ws;
#if MK_COOP
    if (hipMemsetAsync((char*)d_ws + WS_CTL, 0, CTL_ZERO_BYTES, stream) != hipSuccess) { fprintf(stderr, "kernel_launch: memset failed\n"); return; }
    a.ph_lo = 0; a.ph_hi = NPHASE; a.coop = 1;
    void* args[] = {&a};
    hipError_t e = hipLaunchCooperativeKernel((const void*)fwd_kernel, dim3(grid), dim3(512), args, LDS_BYTES, stream);
    if (e != hipSuccess) fprintf(stderr, "cooperative launch failed: %s (grid %d)\n", hipGetErrorString(e), grid);
#if PROBE_PHASE >= 0
    { Args b = a; b.ph_lo = PROBE_PHASE; b.ph_hi = PROBE_PHASE + 1; b.coop = 0; b.probe = 1;
      for (int r_ = 0; r_ < PROBE_REPS; ++r_) hipLaunchKernelGGL(fwd_kernel, dim3(grid), dim3(512), LDS_BYTES, stream, b); }
#endif
#else
    for (int ph = 0; ph < NPHASE; ++ph) {
        a.ph_lo = ph; a.ph_hi = ph + 1; a.coop = 0;
        hipLaunchKernelGGL(fwd_kernel, dim3(grid), dim3(512), LDS_BYTES, stream, a);
    }
#endif
}
```
